# Optimizing an MI355X kernel written in HIP

```python
import jax, jax.numpy as jnp
from jax import lax
import numpy as np

D_MODEL = 1024
BATCH = 16
SEQ = 256
DEPTH = 1
DEC_BATCH = 8
DEC_SEQ = 2048
PAST_LEN = 256

GRID_W = 64
D_MIX = D_MODEL
D_A = D_MIX // 2
HEAD_A = 64
H_A = D_A // HEAD_A
D_B = D_MIX - D_A
BLK_B = 64
NB_B = D_B // BLK_B
R_W = 64
R_A = 64
R_G = 128
CONV_W = 4
CONV_PAD_L = 2
LRU_C = 8.0
D_FF = 4 * D_MODEL
N_DIR = 2
EPS = 1e-6
LNX_EPS = 64e-5
SPLIT_SIZES = (D_A, D_A, D_A, N_DIR * R_W, N_DIR * R_A, R_G, D_B, D_B)
D_IN = sum(SPLIT_SIZES)

kernel_name = "hymba_rwkv7_rglru_diffusion_step"


def rms_norm(x, g):
    xf = x.astype(jnp.float32)
    y = xf * lax.rsqrt(jnp.mean(xf * xf, axis=-1, keepdims=True) + EPS)
    return (y * g.astype(jnp.float32)).astype(x.dtype)


def sincos_1d(pos, dim):
    omega = 1.0 / (10000.0 ** (jnp.arange(dim // 2, dtype=jnp.float32) / (dim // 2)))
    ang = pos.astype(jnp.float32)[:, None] * omega[None, :]
    return jnp.concatenate([jnp.sin(ang), jnp.cos(ang)], axis=-1)


def grid_pos_embed(n_tokens):
    rows = n_tokens // GRID_W
    half = D_MODEL // 2
    e_row = sincos_1d(jnp.arange(rows), half)
    e_col = sincos_1d(jnp.arange(GRID_W), half)
    emb = jnp.concatenate([jnp.broadcast_to(e_row[:, None, :], (rows, GRID_W, half)),
                           jnp.broadcast_to(e_col[None, :, :], (rows, GRID_W, half))], axis=-1)
    return emb.reshape(rows * GRID_W, D_MODEL)


def split_proj(z):
    idx = np.cumsum(np.array(SPLIT_SIZES))[:-1].tolist()
    return jnp.split(z, idx, axis=-1)


def rwkv7_scan(r, w, k, v, kk, ka, s0, reverse):
    def step(S, inp):
        r_t, w_t, k_t, v_t, kk_t, ka_t = inp
        sa = jnp.einsum('bhvk,bhk->bhv', S, -kk_t)
        S = (S * w_t[:, :, None, :] + sa[..., :, None] * ka_t[..., None, :]
             + v_t[..., :, None] * k_t[..., None, :])
        y = jnp.einsum('bhvk,bhk->bhv', S, r_t)
        return S, y
    xs = tuple(jnp.moveaxis(a, 1, 0) for a in (r, w, k, v, kk, ka))
    s_fin, ys = lax.scan(step, s0, xs, reverse=reverse)
    return jnp.moveaxis(ys, 0, 1), s_fin


def rwkv7_group(r, k, v, xw, xa, xg, s0, lp):
    B, T, _ = r.shape
    f32 = jnp.float32
    heads = lambda t: t.reshape(B, T, H_A, HEAD_A)
    r, k, v = r.astype(f32), k.astype(f32), v.astype(f32)
    xw = xw.astype(f32).reshape(B, T, N_DIR, R_W)
    xa = xa.astype(f32).reshape(B, T, N_DIR, R_A)
    g = jnp.einsum('btr,rd->btd', jax.nn.sigmoid(xg.astype(f32)), lp['g_up'].astype(f32))
    w_log = -jax.nn.softplus(-(lp['w0'].astype(f32)
                               + jnp.einsum('btnr,nrd->btnd', jnp.tanh(xw), lp['w_up'].astype(f32)))) - 0.5
    decay = jnp.exp(-jnp.exp(w_log))
    a = jax.nn.sigmoid(lp['a0'].astype(f32) + jnp.einsum('btnr,nrd->btnd', xa, lp['a_up'].astype(f32)))
    kk = heads(k * lp['k_k'].astype(f32))
    kk = kk / jnp.maximum(jnp.sqrt(jnp.sum(kk * kk, axis=-1, keepdims=True)), 1e-12)
    r_h, v_h = heads(r), heads(v)
    y_sum = 0.0
    bonus = 0.0
    finals = []
    for d, rev in ((0, False), (1, True)):
        a_d = a[:, :, d]
        k_d = heads(k * (1.0 + (a_d - 1.0) * lp['k_a'].astype(f32)))
        y_d, s_d = rwkv7_scan(r_h, heads(decay[:, :, d]), k_d, v_h, kk, kk * heads(a_d), s0[:, d].astype(f32), rev)
        y_sum = y_sum + y_d
        bonus = bonus + jnp.sum(r_h * k_d * lp['r_k'].astype(f32), axis=-1, keepdims=True) * v_h
        finals.append(s_d)
    mu = jnp.mean(y_sum, axis=-1, keepdims=True)
    var = jnp.mean(jnp.square(y_sum - mu), axis=-1, keepdims=True)
    yn = ((y_sum - mu) * lax.rsqrt(var + LNX_EPS)).reshape(B, T, D_A)
    yn = yn * lp['lnx_g'].astype(f32) + lp['lnx_b'].astype(f32)
    out = (yn + bonus.reshape(B, T, D_A)) * g
    return out, jnp.stack(finals, axis=1)


def conv_centred(x, w, b):
    T = x.shape[1]
    xp = jnp.pad(x, ((0, 0), (CONV_PAD_L, CONV_W - 1 - CONV_PAD_L), (0, 0)))
    out = b
    for j in range(CONV_W):
        out = out + xp[:, j:j + T] * w[j]
    return out


def block_diag(x, w, b):
    B, T, _ = x.shape
    return jnp.einsum('btnc,ncd->btnd', x.reshape(B, T, NB_B, BLK_B), w).reshape(B, T, D_B) + b


def lin_scan(a, bx, h0, reverse):
    def comb(e1, e2):
        a1, b1 = e1
        a2, b2 = e2
        return a1 * a2, a2 * b1 + b2
    a_cum, b_cum = lax.associative_scan(comb, (a, bx), reverse=reverse, axis=1)
    return b_cum + a_cum * h0[:, None, :]


def rglru_group(xb, gb, h0, lp):
    f32 = jnp.float32
    xc = conv_centred(xb.astype(f32), lp['conv_w'].astype(f32), lp['conv_b'].astype(f32))
    gate = jax.nn.gelu(gb.astype(f32), approximate=True)
    y_sum = 0.0
    finals = []
    for d, rev in ((0, False), (1, True)):
        rg = jax.nn.sigmoid(block_diag(xc, lp['wa'][d].astype(f32), lp['ba'][d].astype(f32)))
        ig = jax.nn.sigmoid(block_diag(xc, lp['wx'][d].astype(f32), lp['bx'][d].astype(f32)))
        log_a = -LRU_C * rg * jax.nn.softplus(-lp['lam'][d].astype(f32))
        a_t = jnp.exp(log_a)
        bx = jnp.sqrt(-jnp.expm1(2.0 * log_a)) * (ig * xc)
        h = lin_scan(a_t, bx, h0[:, d].astype(f32), rev)
        y_sum = y_sum + h
        finals.append(h[:, 0] if rev else h[:, -1])
    return y_sum * gate, jnp.stack(finals, axis=1)


def trunk_layer(x, mod, s_rwkv0, s_lru0, lp):
    shift1, scale1, gate1, shift2, scale2, gate2 = jnp.split(mod, 6, axis=-1)
    h = rms_norm(x, lp['g_pre_mix']) * (1.0 + scale1) + shift1
    z = jnp.einsum('btd,de->bte', h, lp['w_in'])
    r, k, v, xw, xa, xg, xb, gb = split_proj(z)
    y_a, s_a = rwkv7_group(r, k, v, xw, xa, xg, s_rwkv0, lp)
    y_b, s_b = rglru_group(xb, gb, s_lru0, lp)
    y = jnp.einsum('bte,ed->btd', jnp.concatenate([y_a, y_b], axis=-1).astype(x.dtype), lp['w_out'])
    x = x + gate1 * rms_norm(y, lp['g_post_mix'])
    h = rms_norm(x, lp['g_pre_mlp']) * (1.0 + scale2) + shift2
    f = jnp.square(jax.nn.relu(jnp.einsum('btd,df->btf', h, lp['w_mlp1'])))
    f = jnp.einsum('btf,fd->btd', f, lp['w_mlp2'])
    x = x + gate2 * rms_norm(f, lp['g_post_mlp'])
    return x, s_a, s_b


def setup_inputs(seed: int = 0) -> dict:
    key = jax.random.key(seed)
    ks = jax.random.split(key, 40)
    nrm = lambda i, shape, s: jax.random.normal(ks[i], shape, jnp.float32) * s
    u = jax.random.uniform(ks[30], (DEPTH, N_DIR, D_B), jnp.float32, 0.9, 0.999)
    p = u ** (1.0 / LRU_C)
    lam = jnp.log(p) - jnp.log1p(-p)
    return {
        "x_prompt": nrm(0, (BATCH, SEQ, D_MODEL), 1.0),
        "x_sample": nrm(1, (DEC_BATCH, DEC_SEQ, D_MODEL), 1.0),
        "c": nrm(2, (DEC_BATCH, D_MODEL), 1.0),
        "state_rwkv": nrm(3, (DEC_BATCH, DEPTH, N_DIR, H_A, HEAD_A, HEAD_A), 0.3),
        "state_lru": nrm(4, (DEC_BATCH, DEPTH, N_DIR, D_B), 0.5),
        "c_ctx": nrm(5, (D_MODEL,), 1.0),
        "w_mod": nrm(6, (DEPTH, D_MODEL, 6 * D_MODEL), 0.5 * D_MODEL ** -0.5),
        "b_mod": nrm(7, (DEPTH, 6 * D_MODEL), 0.01),
        "g_pre_mix": 1.0 + nrm(8, (DEPTH, D_MODEL), 0.02),
        "g_post_mix": 1.0 + nrm(9, (DEPTH, D_MODEL), 0.02),
        "g_pre_mlp": 1.0 + nrm(10, (DEPTH, D_MODEL), 0.02),
        "g_post_mlp": 1.0 + nrm(11, (DEPTH, D_MODEL), 0.02),
        "w_in": nrm(12, (DEPTH, D_MODEL, D_IN), D_MODEL ** -0.5),
        "rwkv_w0": jax.random.uniform(ks[13], (DEPTH, N_DIR, D_A), jnp.float32, -6.0, 1.0),
        "rwkv_w_up": nrm(14, (DEPTH, N_DIR, R_W, D_A), 0.1),
        "rwkv_a0": nrm(15, (DEPTH, N_DIR, D_A), 0.1),
        "rwkv_a_up": nrm(16, (DEPTH, N_DIR, R_A, D_A), 0.1),
        "rwkv_g_up": nrm(17, (DEPTH, R_G, D_A), R_G ** -0.5),
        "rwkv_k_k": 0.85 + nrm(18, (DEPTH, D_A), 0.02),
        "rwkv_k_a": 1.0 + nrm(19, (DEPTH, D_A), 0.02),
        "rwkv_r_k": nrm(20, (DEPTH, H_A, HEAD_A), 0.1),
        "rwkv_lnx_g": 1.0 + nrm(21, (DEPTH, D_A), 0.02),
        "rwkv_lnx_b": nrm(22, (DEPTH, D_A), 0.01),
        "lru_conv_w": nrm(23, (DEPTH, CONV_W, D_B), CONV_W ** -0.5),
        "lru_conv_b": nrm(24, (DEPTH, D_B), 0.01),
        "lru_wa": nrm(25, (DEPTH, N_DIR, NB_B, BLK_B, BLK_B), BLK_B ** -0.5),
        "lru_ba": nrm(26, (DEPTH, N_DIR, D_B), 0.01),
        "lru_wx": nrm(27, (DEPTH, N_DIR, NB_B, BLK_B, BLK_B), BLK_B ** -0.5),
        "lru_bx": nrm(28, (DEPTH, N_DIR, D_B), 0.01),
        "lru_lambda": lam,
        "w_out": nrm(31, (DEPTH, D_MIX, D_MODEL), D_MIX ** -0.5),
        "w_mlp1": nrm(32, (DEPTH, D_MODEL, D_FF), D_MODEL ** -0.5),
        "w_mlp2": nrm(33, (DEPTH, D_FF, D_MODEL), D_FF ** -0.5),
    }


def reference(x_prompt, x_sample, c, state_rwkv, state_lru, c_ctx, w_mod, b_mod,
              g_pre_mix, g_post_mix, g_pre_mlp, g_post_mlp, w_in,
              rwkv_w0, rwkv_w_up, rwkv_a0, rwkv_a_up, rwkv_g_up, rwkv_k_k, rwkv_k_a, rwkv_r_k,
              rwkv_lnx_g, rwkv_lnx_b, lru_conv_w, lru_conv_b, lru_wa, lru_ba, lru_wx, lru_bx,
              lru_lambda, w_out, w_mlp1, w_mlp2):
    n_ctx = x_prompt.shape[0]
    xp = x_prompt
    xs = x_sample + grid_pos_embed(x_sample.shape[1]).astype(x_sample.dtype)[None]
    zero_rwkv = jnp.zeros((n_ctx, N_DIR, H_A, HEAD_A, HEAD_A), jnp.float32)
    zero_lru = jnp.zeros((n_ctx, N_DIR, D_B), jnp.float32)
    new_rwkv, new_lru = [], []
    for l in range(DEPTH):
        lp = {
            'g_pre_mix': g_pre_mix[l], 'g_post_mix': g_post_mix[l],
            'g_pre_mlp': g_pre_mlp[l], 'g_post_mlp': g_post_mlp[l],
            'w_in': w_in[l], 'w_out': w_out[l], 'w_mlp1': w_mlp1[l], 'w_mlp2': w_mlp2[l],
            'w0': rwkv_w0[l], 'w_up': rwkv_w_up[l], 'a0': rwkv_a0[l], 'a_up': rwkv_a_up[l],
            'g_up': rwkv_g_up[l], 'k_k': rwkv_k_k[l], 'k_a': rwkv_k_a[l], 'r_k': rwkv_r_k[l],
            'lnx_g': rwkv_lnx_g[l], 'lnx_b': rwkv_lnx_b[l],
            'conv_w': lru_conv_w[l], 'conv_b': lru_conv_b[l],
            'wa': lru_wa[l], 'ba': lru_ba[l], 'wx': lru_wx[l], 'bx': lru_bx[l], 'lam': lru_lambda[l],
        }
        mod_ctx = (jax.nn.silu(c_ctx) @ w_mod[l] + b_mod[l])[None, None, :]
        mod_lat = (jax.nn.silu(c) @ w_mod[l] + b_mod[l])[:, None, :]
        xp, s_r, s_l = trunk_layer(xp, mod_ctx, zero_rwkv, zero_lru, lp)
        new_rwkv.append(s_r.astype(x_prompt.dtype))
        new_lru.append(s_l.astype(x_prompt.dtype))
        xs, _, _ = trunk_layer(xs, mod_lat, state_rwkv[:, l], state_lru[:, l], lp)
    new_state_rwkv = jnp.stack(new_rwkv, axis=1)
    new_state_lru = jnp.stack(new_lru, axis=1)
    return (xp, xs, new_state_rwkv, new_state_lru)
```

```cpp
#include <hip/hip_runtime.h>
#include <hip/hip_cooperative_groups.h>
#include <cstdio>
namespace cg = cooperative_groups;
#ifndef MK_LAUNCHES
#define MK_LAUNCHES 11
#endif
namespace pg8 {
#define PG8_LAS __attribute__((address_space(3)))
typedef unsigned short bf16_t;
typedef short bf16x8 __attribute__((ext_vector_type(8)));
typedef float f32x4 __attribute__((ext_vector_type(4)));
typedef unsigned u32x4 __attribute__((ext_vector_type(4)));
constexpr int BM = 256, BK = 64, HALF = 128, HTB = HALF * BK * 2  , STAGE_BYTES = 8 * HTB, NXCD = 8, WGM = 8;

__host__ __device__ __forceinline__ int lds_byte(int r, int c) { const int st = (r >> 4) * 2 + (c >> 5), rr = r & 15, cc = c & 31, ob = rr * 64 + cc * 2; return st * 1024 + (ob ^ (((ob >> 9) & 1) << 5)); }
__host__ __device__ __forceinline__ void stage_rc(int b, int& R, int& C) { const int st = b / 1024, sb = b % 1024, swz = sb ^ (((sb >> 9) & 1) << 5); R = (st >> 1) * 16 + swz / 64; C = (st & 1) * 32 + (swz % 64) / 2; }
__host__ __device__ __forceinline__ int perm32(int rho) { const int n = rho >> 4, i = rho & 15; return 8 * (i >> 2) + 4 * n + (i & 3); }

struct Unit { int pm, pn; };
struct Gemm { const bf16_t* A; const bf16_t* Bt; int M, N, K; };

struct StaticOrder {
    int nM, nN, nwg, G, c;
    __host__ __device__ void init(int M, int N, int G_, int c_) { nM = M / BM; nN = N / BM; nwg = nM * nN; G = G_; c = c_; }
    __host__ __device__ bool next(int i, Unit& u) const {
        const long L = (long)i * G + c; if (L >= nwg) return false;
        int wgid = (int)L; { const int q = nwg / NXCD, r = nwg % NXCD, xcd = wgid % NXCD, off = wgid / NXCD; wgid = (xcd < r ? xcd * (q + 1) : r * (q + 1) + (xcd - r) * q) + off; }
        const int nig = WGM * nN, gid = wgid / nig, fm = gid * WGM, gsz = (nM - fm) < WGM ? (nM - fm) : WGM;
        u.pm = fm + ((wgid % nig) % gsz); u.pn = (wgid % nig) / gsz; return true;
    }
    __device__ __forceinline__ void a_ready(const Unit&) const {}
    __device__ __forceinline__ void done(const Unit&) const {}
};
__device__ __forceinline__ unsigned cvt_pk_bf16(float lo, float hi) { unsigned r; asm volatile("v_cvt_pk_bf16_f32 %0, %1, %2" : "=v"(r) : "v"(lo), "v"(hi)); return r; }
template <class Epi, class Sched>
__device__ __forceinline__ void gemm_phase(PG8_LAS unsigned char* lds, const Gemm g, const Sched& S, const Epi& E) {
    const int tid = threadIdx.x, wid = __builtin_amdgcn_readfirstlane(tid >> 6), lane = tid & 63, wr = wid >> 2, wc = wid & 3, fr = lane & 15, fq = lane >> 4;
    const int K = g.K, nt = K / BK;
    unsigned voffA[2], voffB[2];
#pragma unroll
    for (int i = 0; i < 2; ++i) { int R, C; stage_rc(tid * 16 + i * 8192, R, C); const int Rb = Epi::PERM ? ((R & ~31) + perm32(R & 31)) : R;
        voffA[i] = (unsigned)(R * K + C) * 2u; voffB[i] = (unsigned)(Rb * K + C) * 2u; }
    const size_t kstep = (size_t)(BK * 2);
    const size_t hstep = (size_t)HALF * K * 2;
    const size_t tstep = 2 * hstep;
    const unsigned ldsw = (unsigned)wid * 1024u;
    const int aoff = lds_byte(wr * 64 + fr, fq * 8), boff = lds_byte(wc * 32 + fr, fq * 8);
#define PG8_SA(b, h) (((b) * 2 + (h)) * HTB)
#define PG8_SB(b, h) ((4 + (b) * 2 + (h)) * HTB)
#define PG8_STAGE(bufoff, gbase, voff) do { _Pragma("unroll") for (int _i = 0; _i < 2; ++_i) \
        __builtin_amdgcn_global_load_lds((const unsigned*)((const char*)(gbase) + (voff)[_i]), (PG8_LAS unsigned*)(lds + (bufoff) + ldsw + _i * 8192), 16, 0, 0); } while (0)
#define PG8_LDA(dst, b, h) do { _Pragma("unroll") for (int m = 0; m < 4; ++m) _Pragma("unroll") for (int k = 0; k < 2; ++k) dst[m][k] = *(const PG8_LAS bf16x8*)(lds + PG8_SA(b, h) + aoff + m * 2048 + k * 1024); } while (0)
#define PG8_LDB(dst, b, h) do { _Pragma("unroll") for (int n = 0; n < 2; ++n) _Pragma("unroll") for (int k = 0; k < 2; ++k) dst[n][k] = *(const PG8_LAS bf16x8*)(lds + PG8_SB(b, h) + boff + n * 2048 + k * 1024); } while (0)
#define PG8_MMA(ai, bj, At, Bt) do { __builtin_amdgcn_s_setprio(1); _Pragma("unroll") for (int m = 0; m < 4; ++m) _Pragma("unroll") for (int n = 0; n < 2; ++n) _Pragma("unroll") for (int k = 0; k < 2; ++k) \
        acc[ai][bj][m][n] = __builtin_amdgcn_mfma_f32_16x16x32_bf16(Bt[n][k], At[m][k], acc[ai][bj][m][n], 0, 0, 0); __builtin_amdgcn_s_setprio(0); } while (0)
#define PG8_WAIT_V(n) asm volatile("s_waitcnt vmcnt(" #n ")" ::: "memory")
#define PG8_WAIT_L(n) asm volatile("s_waitcnt lgkmcnt(" #n ")" ::: "memory")
#define PG8_BAR __builtin_amdgcn_s_barrier()
#define PG8_SCHED __builtin_amdgcn_sched_barrier(0)
    Unit cur, nxt; int ui = 0;
    if (!S.next(0, cur)) return;
    f32x4 acc[2][2][4][2];
#pragma unroll
    for (int a = 0; a < 2; ++a)
#pragma unroll
        for (int b = 0; b < 2; ++b)
#pragma unroll
            for (int m = 0; m < 4; ++m)
#pragma unroll
                for (int n = 0; n < 2; ++n) acc[a][b][m][n] = (f32x4){0.f, 0.f, 0.f, 0.f};
    bf16x8 At[4][2], B0[2][2], B1[2][2];
    const char* cA = (const char*)g.A + (size_t)cur.pm * tstep; const char* cB = (const char*)g.Bt + (size_t)cur.pn * tstep;
    S.a_ready(cur);
    PG8_STAGE(PG8_SB(0, 0), cB, voffB); PG8_STAGE(PG8_SA(0, 0), cA, voffA); PG8_STAGE(PG8_SB(0, 1), cB + hstep, voffB); PG8_STAGE(PG8_SA(0, 1), cA + hstep, voffA);
    if (wr == 1) PG8_BAR;
    PG8_WAIT_V(4); PG8_BAR;
    PG8_STAGE(PG8_SB(1, 0), cB + kstep, voffB); PG8_STAGE(PG8_SA(1, 0), cA + kstep, voffA); PG8_STAGE(PG8_SB(1, 1), cB + hstep + kstep, voffB);
    PG8_WAIT_V(6); PG8_BAR;
    for (;;) {
        const bool has_next = S.next(ui + 1, nxt);
        const char* nA = has_next ? (const char*)g.A + (size_t)nxt.pm * tstep : cA; const char* nB = has_next ? (const char*)g.Bt + (size_t)nxt.pn * tstep : cB;
        for (int t = 0; t < nt; t += 2) {
            const bool last = (t == nt - 2);
            const char* a1 = cA + (size_t)(t + 1) * kstep;
            const char* a2 = last ? nA : cA + (size_t)(t + 2) * kstep; const char* b2 = last ? nB : cB + (size_t)(t + 2) * kstep;
            const char* a3 = a2 + kstep; const char* b3 = b2 + kstep;
            if (last && has_next) S.a_ready(nxt);
            PG8_LDB(B0, 0, 0); PG8_SCHED; PG8_LDA(At, 0, 0); PG8_STAGE(PG8_SA(1, 1), a1 + hstep, voffA);
            PG8_WAIT_L(8); PG8_BAR; PG8_WAIT_L(0); PG8_MMA(0, 0, At, B0); PG8_BAR; PG8_SCHED;
            PG8_LDB(B1, 0, 1); PG8_STAGE(PG8_SB(0, 0), b2, voffB);
            PG8_BAR; PG8_WAIT_L(0); PG8_MMA(0, 1, At, B1); PG8_BAR;
            PG8_LDA(At, 0, 1); PG8_STAGE(PG8_SA(0, 0), a2, voffA);
            PG8_BAR; PG8_WAIT_L(0); PG8_MMA(1, 0, At, B0); PG8_BAR; PG8_SCHED;
            PG8_STAGE(PG8_SB(0, 1), b2 + hstep, voffB);
            PG8_WAIT_V(6); PG8_BAR; PG8_MMA(1, 1, At, B1); PG8_BAR;
            PG8_LDB(B0, 1, 0); PG8_SCHED; PG8_LDA(At, 1, 0); PG8_STAGE(PG8_SA(0, 1), a2 + hstep, voffA);
            PG8_WAIT_L(8); PG8_BAR; PG8_WAIT_L(0); PG8_MMA(0, 0, At, B0); PG8_BAR; PG8_SCHED;
            PG8_LDB(B1, 1, 1); PG8_STAGE(PG8_SB(1, 0), b3, voffB);
            PG8_BAR; PG8_WAIT_L(0); PG8_MMA(0, 1, At, B1); PG8_BAR;
            PG8_LDA(At, 1, 1); PG8_STAGE(PG8_SA(1, 0), a3, voffA);
            PG8_BAR; PG8_WAIT_L(0); PG8_MMA(1, 0, At, B0); PG8_BAR; PG8_SCHED;
            PG8_STAGE(PG8_SB(1, 1), b3 + hstep, voffB);
            PG8_WAIT_V(6); PG8_BAR; PG8_MMA(1, 1, At, B1); PG8_BAR;
        }
        if constexpr (!Epi::AFTER_DRAIN) { E(acc, cur, wr, wc, fr, fq); S.done(cur); }
        if (!has_next) break;
#pragma unroll
        for (int a = 0; a < 2; ++a)
#pragma unroll
            for (int b = 0; b < 2; ++b)
#pragma unroll
                for (int m = 0; m < 4; ++m)
#pragma unroll
                    for (int n = 0; n < 2; ++n) acc[a][b][m][n] = (f32x4){0.f, 0.f, 0.f, 0.f};
        cur = nxt; cA = nA; cB = nB; ++ui;
    }
    PG8_WAIT_V(0);
    if (wr == 0) PG8_BAR;
    PG8_BAR;
    if constexpr (Epi::AFTER_DRAIN) { E.fused(acc, cur, wr, wc, fr, fq, lds, wid, lane); S.done(cur); }
#undef PG8_SA
#undef PG8_SB
#undef PG8_STAGE
#undef PG8_LDA
#undef PG8_LDB
#undef PG8_MMA
#undef PG8_WAIT_V
#undef PG8_WAIT_L
#undef PG8_BAR
#undef PG8_SCHED
}
}

namespace {
using pg8::bf16_t; using pg8::bf16x8; using pg8::f32x4; using pg8::u32x4;
typedef unsigned u32x2 __attribute__((ext_vector_type(2)));

constexpr int DM = 1024, NTOK = 20480, NPR = 4096, DIN = 2944, DINP = 3072, DFF = 4096;
constexpr int ZR = 0, ZK = 512, ZV = 1024, ZXW = 1536, ZXA = 1664, ZXG = 1792, ZXB = 1920, ZGB = 2432;
constexpr int NTILE = NTOK / 64;
constexpr size_t MiB = 1048576;
constexpr size_t WS_W2T = 0;
constexpr size_t WS_WUPT = 8 * MiB;
constexpr size_t WS_AUPT = WS_WUPT + 131072;
constexpr size_t WS_GUPT = WS_AUPT + 131072;
constexpr size_t WS_WAT = WS_GUPT + 131072;
constexpr size_t WS_WXT = WS_WAT + 131072;
constexpr size_t WS_ROWTAB = WS_WXT + 131072;
constexpr size_t WS_COLTAB = WS_ROWTAB + 65536;
constexpr size_t WS_MODPART = 9 * MiB;
constexpr size_t WS_F = 13 * MiB;
constexpr size_t WS_Z = WS_F;
constexpr size_t WS_YA = WS_F + 115 * MiB;
constexpr size_t WS_O1 = WS_F;
constexpr size_t WS_C = 173 * MiB;
constexpr size_t WS_WINT = WS_C;
constexpr size_t WS_WOUTT = WS_C + 6 * MiB;
constexpr size_t WS_W1T = WS_C + 8 * MiB;
constexpr size_t WS_ACT = WS_C + 16 * MiB;
constexpr size_t WS_G = WS_C + 56 * MiB;
constexpr size_t WS_INV = WS_C + 76 * MiB;
constexpr size_t WS_BON = WS_INV + 655360;
constexpr size_t WS_CAR = WS_BON + 655360;
constexpr size_t WS_O2 = WS_C;
constexpr size_t OUT_RWKV = (size_t)NTOK * DM;
constexpr size_t OUT_LRU = OUT_RWKV + 16 * 2 * 8 * 4096;

constexpr int LDS_BYTES = 140 * 1024;

struct Params {
    const float* in[33];
    float* out;
    unsigned char* ws;
};

__device__ __forceinline__ float bf2f(unsigned short b) { return __uint_as_float(((unsigned)b) << 16); }
__device__ __forceinline__ unsigned short f2bf(float f) { unsigned u = __float_as_uint(f); u += 0x7FFFu + ((u >> 16) & 1u); return (unsigned short)(u >> 16); }
__device__ __forceinline__ unsigned pk2(float lo, float hi) { return (unsigned)f2bf(lo) | ((unsigned)f2bf(hi) << 16); }
__device__ __forceinline__ void unpack8(const u32x4 w, float* f) {
    f[0] = __uint_as_float(w.x << 16); f[1] = __uint_as_float(w.x & 0xffff0000u);
    f[2] = __uint_as_float(w.y << 16); f[3] = __uint_as_float(w.y & 0xffff0000u);
    f[4] = __uint_as_float(w.z << 16); f[5] = __uint_as_float(w.z & 0xffff0000u);
    f[6] = __uint_as_float(w.w << 16); f[7] = __uint_as_float(w.w & 0xffff0000u);
}
__device__ __forceinline__ u32x4 pack8(const float* f) { u32x4 w; w.x = pk2(f[0], f[1]); w.y = pk2(f[2], f[3]); w.z = pk2(f[4], f[5]); w.w = pk2(f[6], f[7]); return w; }
__device__ __forceinline__ float sigmoidf_(float x) { return 1.0f / (1.0f + __expf(-x)); }
__device__ __forceinline__ float softplusf_(float y) {
    if (y > 15.0f) return y;
    const float e = __expf(y), u = 1.0f + e;
    return (u == 1.0f) ? e : __logf(u) * (e / (u - 1.0f));
}
__device__ __forceinline__ float tanhf_(float x) { const float xc = fminf(fmaxf(x, -15.0f), 15.0f); const float e = __expf(2.0f * xc); return (e - 1.0f) / (e + 1.0f); }
__device__ __forceinline__ float wave_sum(float v) {
#pragma unroll
    for (int o = 32; o > 0; o >>= 1) v += __shfl_xor(v, o);
    return v;
}
__device__ __forceinline__ float sum8(float v) { v += __shfl_xor(v, 1); v += __shfl_xor(v, 2); v += __shfl_xor(v, 4); return v; }

struct TileInfo { int row0; int mrow; int b; int t0; int T; int seqrow0; int sample; int tile0; int ntile; };
__device__ __forceinline__ TileInfo tile_info(int tile) {
    TileInfo ti; ti.row0 = tile * 64;
    if (tile < 64) { ti.sample = 0; ti.b = tile >> 2; ti.t0 = (tile & 3) * 64; ti.T = 256; ti.mrow = 8; ti.seqrow0 = ti.b * 256; ti.tile0 = ti.b * 4; ti.ntile = 4; }
    else { const int s = tile - 64; ti.sample = 1; ti.b = s >> 5; ti.t0 = (s & 31) * 64; ti.T = 2048; ti.mrow = ti.b; ti.seqrow0 = NPR + ti.b * 2048; ti.tile0 = 64 + ti.b * 32; ti.ntile = 32; }
    return ti;
}
__device__ __forceinline__ f32x4 load_x4(const Params& p, int row, int j) {
    if (row < NPR) return *(const f32x4*)(p.in[0] + (size_t)row * DM + j);
    const int r = row - NPR, t = r & 2047;
    f32x4 x = *(const f32x4*)(p.in[1] + (size_t)r * DM + j);
    const float* tab = (j < 512) ? (const float*)(p.ws + WS_ROWTAB) + (t >> 6) * 512 + j : (const float*)(p.ws + WS_COLTAB) + (t & 63) * 512 + (j - 512);
    const f32x4 e = *(const f32x4*)tab;
    return x + e;
}
__device__ __forceinline__ float mod_val(const Params& p, int mrow, int col) {
    const float* mp = (const float*)(p.ws + WS_MODPART);
    float s = p.in[7][col];
#pragma unroll
    for (int ks = 0; ks < 16; ++ks) s += mp[(size_t)(ks * 9 + mrow) * 6144 + col];
    return s;
}

__device__ __forceinline__ f32x4 mm16(const bf16_t* A, int lda, const bf16_t* BT, int ldb, int K, int lane) {
    const int fr = lane & 15, fq = lane >> 4;
    f32x4 acc = {0.f, 0.f, 0.f, 0.f};
    for (int kk = 0; kk < K; kk += 32) {
        const bf16x8 a = *(const bf16x8*)(A + fr * lda + kk + 8 * fq);
        const bf16x8 b = *(const bf16x8*)(BT + (size_t)fr * ldb + kk + 8 * fq);
        acc = __builtin_amdgcn_mfma_f32_16x16x32_bf16(a, b, acc, 0, 0, 0);
    }
    return acc;
}

template <int ACT> struct EpiB16 {
    static constexpr bool PERM = true, AFTER_DRAIN = false;
    bf16_t* O; int ldc; int ncols;
    __device__ __forceinline__ void operator()(const f32x4 (&acc)[2][2][4][2], const pg8::Unit& u, int wr, int wc, int fr, int fq) const {
        const int row0 = u.pm * 256 + wr * 64 + fr; const int col0 = u.pn * 256 + wc * 32 + 8 * fq;
#pragma unroll
        for (int ai = 0; ai < 2; ++ai)
#pragma unroll
            for (int m = 0; m < 4; ++m) { bf16_t* rowp = O + (size_t)(row0 + ai * 128 + m * 16) * ldc + col0;
#pragma unroll
                for (int bj = 0; bj < 2; ++bj) { f32x4 v0 = acc[ai][bj][m][0], v1 = acc[ai][bj][m][1];
                    if (ACT == 1) {
#pragma unroll
                        for (int j = 0; j < 4; ++j) { const float a = fmaxf(v0[j], 0.f), b = fmaxf(v1[j], 0.f); v0[j] = a * a; v1[j] = b * b; } }
                    u32x4 w; w.x = pg8::cvt_pk_bf16(v0[0], v0[1]); w.y = pg8::cvt_pk_bf16(v0[2], v0[3]); w.z = pg8::cvt_pk_bf16(v1[0], v1[1]); w.w = pg8::cvt_pk_bf16(v1[2], v1[3]);
                    if (col0 + bj * 128 < ncols) *(u32x4*)(rowp + bj * 128) = w; } }
    }
};
struct EpiF {
    static constexpr bool PERM = false, AFTER_DRAIN = false;
    float* C; int ldc;
    __device__ __forceinline__ void operator()(const f32x4 (&acc)[2][2][4][2], const pg8::Unit& u, int wr, int wc, int fr, int fq) const {
        const int row0 = u.pm * 256 + wr * 64 + fr, col0 = u.pn * 256 + wc * 32 + 4 * fq;
#pragma unroll
        for (int ai = 0; ai < 2; ++ai)
#pragma unroll
            for (int m = 0; m < 4; ++m) { float* rowp = C + (size_t)(row0 + ai * 128 + m * 16) * ldc + col0;
#pragma unroll
                for (int bj = 0; bj < 2; ++bj)
#pragma unroll
                    for (int n = 0; n < 2; ++n) *(f32x4*)(rowp + bj * 128 + n * 16) = acc[ai][bj][m][n]; }
    }
};

__device__ __forceinline__ void transpose_tile(const float* src, int N, int Nvalid, bf16_t* dst, int K, int n0, int k0, float* tile) {
    const int tid = threadIdx.x;
    {   const int r = tid >> 4, c4 = (tid & 15) * 4;
#pragma unroll
        for (int pss = 0; pss < 2; ++pss) { const int rr = r + pss * 32;
            f32x4 v = {0.f, 0.f, 0.f, 0.f};
            if (n0 < Nvalid) v = *(const f32x4*)(src + (size_t)(k0 + rr) * N + n0 + c4);
            tile[rr * 65 + c4 + 0] = v[0]; tile[rr * 65 + c4 + 1] = v[1]; tile[rr * 65 + c4 + 2] = v[2]; tile[rr * 65 + c4 + 3] = v[3]; } }
    __syncthreads();
    {   const int rr = tid >> 3, kc = (tid & 7) * 8; float f[8];
#pragma unroll
        for (int j = 0; j < 8; ++j) f[j] = tile[(kc + j) * 65 + rr];
        *(u32x4*)(dst + (size_t)(n0 + rr) * K + k0 + kc) = pack8(f); }
    __syncthreads();
}

__device__ __forceinline__ void phase0(const Params& p, unsigned char* shm) {
    float* tile = (float*)shm;
    const int tid = threadIdx.x;
    constexpr int N_TR = 3072, N_MOD = 192, N_SW = 160, N_TAB = 24;
    for (int it = blockIdx.x; it < N_TR + N_MOD + N_SW + N_TAB; it += gridDim.x) {
        if (it < N_TR) {
            if (it < 768) transpose_tile(p.in[12], DIN, DIN, (bf16_t*)(p.ws + WS_WINT), 1024, (it >> 4) * 64, (it & 15) * 64, tile);
            else if (it < 1024) { const int i = it - 768; transpose_tile(p.in[30], 1024, 1024, (bf16_t*)(p.ws + WS_WOUTT), 1024, (i >> 4) * 64, (i & 15) * 64, tile); }
            else if (it < 2048) { const int i = it - 1024; transpose_tile(p.in[31], 4096, 4096, (bf16_t*)(p.ws + WS_W1T), 1024, (i >> 4) * 64, (i & 15) * 64, tile); }
            else { const int i = it - 2048; transpose_tile(p.in[32], 1024, 1024, (bf16_t*)(p.ws + WS_W2T), 4096, (i >> 6) * 64, (i & 63) * 64, tile); }
        } else if (it < N_TR + N_MOD) {
            const int i = it - N_TR, cgp = i % 12, ks = i / 12, k0 = ks * 64;
            for (int e = tid; e < 576; e += 512) { const int b = e >> 6, kk = e & 63; const float cv = (b < 8) ? p.in[2][b * 1024 + k0 + kk] : p.in[5][k0 + kk]; tile[e] = cv / (1.0f + __expf(-cv)); }
            __syncthreads();
            const int col = cgp * 512 + tid;
            float a0 = 0, a1 = 0, a2 = 0, a3 = 0, a4 = 0, a5 = 0, a6 = 0, a7 = 0, a8 = 0;
            const float* wm = p.in[6] + (size_t)k0 * 6144 + col;
#pragma unroll 4
            for (int kk = 0; kk < 64; ++kk) { const float w = wm[(size_t)kk * 6144];
                a0 += tile[kk] * w; a1 += tile[64 + kk] * w; a2 += tile[128 + kk] * w; a3 += tile[192 + kk] * w; a4 += tile[256 + kk] * w;
                a5 += tile[320 + kk] * w; a6 += tile[384 + kk] * w; a7 += tile[448 + kk] * w; a8 += tile[512 + kk] * w; }
            float* mp = (float*)(p.ws + WS_MODPART) + (size_t)(ks * 9) * 6144 + col;
            mp[0] = a0; mp[6144] = a1; mp[2 * 6144] = a2; mp[3 * 6144] = a3; mp[4 * 6144] = a4; mp[5 * 6144] = a5; mp[6 * 6144] = a6; mp[7 * 6144] = a7; mp[8 * 6144] = a8;
            __syncthreads();
        } else if (it < N_TR + N_MOD + N_SW) {
            const int i = it - N_TR - N_MOD;
#pragma unroll
            for (int q = 0; q < 4; ++q) {
                const int e = i * 2048 + q * 512 + tid, which = e >> 16, r = e & 65535;
                float v; bf16_t* dst;
                if (which < 2) { const int d = r >> 15, n = (r >> 6) & 511, k = r & 63; v = p.in[which == 0 ? 14 : 16][d * 32768 + k * 512 + n]; dst = (bf16_t*)(p.ws + (which == 0 ? WS_WUPT : WS_AUPT)); }
                else if (which == 2) { const int n = r >> 7, k = r & 127; v = p.in[17][k * 512 + n]; dst = (bf16_t*)(p.ws + WS_GUPT); }
                else { const int dn = r >> 12, o = (r >> 6) & 63, c = r & 63; v = p.in[which == 3 ? 25 : 27][dn * 4096 + c * 64 + o]; dst = (bf16_t*)(p.ws + (which == 3 ? WS_WAT : WS_WXT)); }
                dst[r] = f2bf(v);
            }
        } else {
            const int i = it - N_TR - N_MOD - N_SW;
#pragma unroll
            for (int q = 0; q < 4; ++q) {
                const int e = i * 2048 + q * 512 + tid;
                const int isrow = e < 16384, e2 = isrow ? e : e - 16384, pos = e2 >> 9, j = e2 & 511, ii = j & 255;
                const float omega = 1.0f / powf(10000.0f, (float)ii / 256.0f);
                const float ang = (float)pos * omega;
                const float v = (j < 256) ? sinf(ang) : cosf(ang);
                ((float*)(p.ws + (isrow ? WS_ROWTAB : WS_COLTAB)))[e2] = v;
            }
        }
    }
}

__device__ __forceinline__ void phase_h1(const Params& p, unsigned char* shm) {
    float* sm = (float*)shm;
    const int tid = threadIdx.x, wid = tid >> 6, lane = tid & 63;
    bf16_t* H = (bf16_t*)(p.ws + WS_ACT);
    for (int tile = blockIdx.x; tile < NTILE; tile += gridDim.x) {
        const TileInfo ti = tile_info(tile);
        for (int i = tid; i < 2048; i += 512) sm[i] = mod_val(p, ti.mrow, i);
        __syncthreads();
        for (int rr = 0; rr < 8; ++rr) {
            const int row = ti.row0 + wid * 8 + rr;
            f32x4 x[4]; float ss = 0.f;
#pragma unroll
            for (int i = 0; i < 4; ++i) { x[i] = load_x4(p, row, 4 * lane + 256 * i); ss += x[i][0] * x[i][0] + x[i][1] * x[i][1] + x[i][2] * x[i][2] + x[i][3] * x[i][3]; }
            ss = wave_sum(ss);
            const float rstd = rsqrtf(ss * (1.0f / 1024.0f) + 1e-6f);
#pragma unroll
            for (int i = 0; i < 4; ++i) { const int j = 4 * lane + 256 * i;
                const f32x4 g = *(const f32x4*)(p.in[8] + j); float h[4];
#pragma unroll
                for (int e = 0; e < 4; ++e) h[e] = x[i][e] * rstd * g[e] * (1.0f + sm[1024 + j + e]) + sm[j + e];
                u32x2 w; w.x = pk2(h[0], h[1]); w.y = pk2(h[2], h[3]);
                *(u32x2*)(H + (size_t)row * DM + j) = w; }
        }
        __syncthreads();
    }
}

constexpr int LO_O = 0;
constexpr int LO_XA = 83200;
constexpr int LO_XBUF = 83200, LO_XCF = 83200 + 17408, LO_XCB = LO_XCF + 16640;

__device__ __forceinline__ void lru_common(const Params& p, unsigned char* shm, const TileInfo& ti, int j) {
    const int tid = threadIdx.x, wid = tid >> 6, lane = tid & 63;
    const bf16_t* Z = (const bf16_t*)(p.ws + WS_Z);
    float* O = (float*)(shm + LO_O);
    float* xbuf = (float*)(shm + LO_XBUF); float* xcf = (float*)(shm + LO_XCF); bf16_t* xcb = (bf16_t*)(shm + LO_XCB);
    for (int e = tid; e < 67 * 8; e += 512) { const int rr = e >> 3, cs = e & 7; const int t = ti.t0 - 2 + rr; float f[8];
        if (t >= 0 && t < ti.T) { const u32x4 w = *(const u32x4*)(Z + (size_t)(ti.seqrow0 + t) * DIN + ZXB + 64 * j + 8 * cs); unpack8(w, f); }
        else {
#pragma unroll
            for (int q = 0; q < 8; ++q) f[q] = 0.f; }
#pragma unroll
        for (int q = 0; q < 8; ++q) xbuf[rr * 64 + 8 * cs + q] = f[q]; }
    __syncthreads();
    {   const int t = tid >> 3, cs = tid & 7; float xc[8];
#pragma unroll
        for (int q = 0; q < 8; ++q) { const int ch = 64 * j + 8 * cs + q; float s = p.in[24][ch];
#pragma unroll
            for (int jj = 0; jj < 4; ++jj) s += xbuf[(t + jj) * 64 + 8 * cs + q] * p.in[23][jj * 512 + ch];
            xc[q] = s; }
        __syncthreads();
#pragma unroll
        for (int q = 0; q < 8; ++q) xcf[t * 65 + 8 * cs + q] = xc[q];
        *(u32x4*)(xcb + t * 72 + 8 * cs) = pack8(xc); }
    __syncthreads();
#pragma unroll 1
    for (int idx = wid; idx < 64; idx += 8) { const int o = idx >> 4, mt = (idx >> 2) & 3, nt = idx & 3, d = o >> 1, which = o & 1;
        const bf16_t* BT = (const bf16_t*)(p.ws + (which ? WS_WXT : WS_WAT)) + (size_t)((d * 8 + j) * 64 + 16 * nt) * 64;
        const f32x4 acc = mm16(xcb + 16 * mt * 72, 72, BT, 64, 64, lane);
        const int fr = lane & 15, fq = lane >> 4;
#pragma unroll
        for (int i = 0; i < 4; ++i) O[(o * 64 + 16 * mt + 4 * fq + i) * 65 + 16 * nt + fr] = acc[i]; }
    __syncthreads();
    {   const int t = tid >> 3, cs = tid & 7;
#pragma unroll 1
        for (int d = 0; d < 2; ++d)
#pragma unroll 2
            for (int q = 0; q < 8; ++q) { const int c = 8 * cs + q, ch = 64 * j + c;
                const float rg = sigmoidf_(O[((2 * d) * 64 + t) * 65 + c] + p.in[26][d * 512 + ch]);
                const float ig = sigmoidf_(O[((2 * d + 1) * 64 + t) * 65 + c] + p.in[28][d * 512 + ch]);
                const float la = -8.0f * rg * softplusf_(-p.in[29][d * 512 + ch]);
                const float a = __expf(la);
                const float bx = sqrtf(fmaxf(1.0f - a * a, 0.0f)) * (ig * xcf[t * 65 + c]);
                O[((2 * d) * 64 + t) * 65 + c] = a; O[((2 * d + 1) * 64 + t) * 65 + c] = bx; } }
    __syncthreads();
}

__device__ __forceinline__ void phase_prep(const Params& p, unsigned char* shm) {
    const int tid = threadIdx.x, wid = tid >> 6, lane = tid & 63;
    const bf16_t* Z = (const bf16_t*)(p.ws + WS_Z);
    float* O = (float*)(shm + LO_O);
    bf16_t* XW = (bf16_t*)(shm + LO_XA); bf16_t* XA = XW + 64 * 136; bf16_t* XG = XA + 64 * 136;
    bf16_t* SCAN = (bf16_t*)p.out;
    for (int it = blockIdx.x; it < NTILE * 8; it += gridDim.x) {
        const int tile = it >> 3, h = it & 7; const TileInfo ti = tile_info(tile);
        {   const int t = tid >> 3, seg = tid & 7; const size_t zr = (size_t)(ti.row0 + t) * DIN; float f[8];
#pragma unroll 1
            for (int hh = 0; hh < 2; ++hh) { const int c0 = seg * 16 + hh * 8;
                u32x4 w = *(const u32x4*)(Z + zr + ZXW + c0); unpack8(w, f);
#pragma unroll
                for (int q = 0; q < 8; ++q) f[q] = tanhf_(f[q]);
                *(u32x4*)(XW + t * 136 + c0) = pack8(f);
                w = *(const u32x4*)(Z + zr + ZXA + c0); *(u32x4*)(XA + t * 136 + c0) = w;
                w = *(const u32x4*)(Z + zr + ZXG + c0); unpack8(w, f);
#pragma unroll
                for (int q = 0; q < 8; ++q) f[q] = sigmoidf_(f[q]);
                *(u32x4*)(XG + t * 136 + c0) = pack8(f); } }
        __syncthreads();
#pragma unroll 1
        for (int idx = wid; idx < 80; idx += 8) { const int o = idx >> 4, mt = (idx >> 2) & 3, nt = idx & 3;
            const bf16_t* A; const bf16_t* BT; int ldb, K;
            if (o < 2) { A = XW + o * 64; BT = (const bf16_t*)(p.ws + WS_WUPT) + (size_t)(o * 512 + h * 64 + 16 * nt) * 64; ldb = 64; K = 64; }
            else if (o < 4) { A = XA + (o - 2) * 64; BT = (const bf16_t*)(p.ws + WS_AUPT) + (size_t)((o - 2) * 512 + h * 64 + 16 * nt) * 64; ldb = 64; K = 64; }
            else { A = XG; BT = (const bf16_t*)(p.ws + WS_GUPT) + (size_t)(h * 64 + 16 * nt) * 128; ldb = 128; K = 128; }
            const f32x4 acc = mm16(A + 16 * mt * 136, 136, BT, ldb, K, lane);
            const int fr = lane & 15, fq = lane >> 4;
#pragma unroll
            for (int i = 0; i < 4; ++i) O[(o * 64 + 16 * mt + 4 * fq + i) * 65 + 16 * nt + fr] = acc[i]; }
        __syncthreads();
        {   const int t = tid >> 3, cs = tid & 7, row = ti.row0 + t; const size_t zr = (size_t)row * DIN + h * 64 + 8 * cs;
            float ss = 0.f;
            {   float k[8]; unpack8(*(const u32x4*)(Z + zr + ZK), k);
#pragma unroll
                for (int q = 0; q < 8; ++q) { const float kk = k[q] * p.in[18][h * 64 + 8 * cs + q]; ss += kk * kk; } }
            ss = sum8(ss);
            const float inv = 1.0f / fmaxf(sqrtf(ss), 1e-12f);
            float bs = 0.f;
#pragma unroll 1
            for (int d = 0; d < 2; ++d) {
                bf16_t* sp = SCAN + ((size_t)(d * NTOK + row) * 8 + h) * 128 + 8 * cs;
#pragma unroll 1
                for (int qp = 0; qp < 4; ++qp) { const int c = 8 * cs + 2 * qp, hc = h * 64 + c;
                    const unsigned rw = *(const unsigned*)(Z + zr + ZR + 2 * qp), kw = *(const unsigned*)(Z + zr + ZK + 2 * qp);
                    const float r0 = __uint_as_float(rw << 16), r1 = __uint_as_float(rw & 0xffff0000u), k0 = __uint_as_float(kw << 16), k1 = __uint_as_float(kw & 0xffff0000u);
                    const float a0 = sigmoidf_(p.in[15][d * 512 + hc] + O[((2 + d) * 64 + t) * 65 + c]);
                    const float a1 = sigmoidf_(p.in[15][d * 512 + hc + 1] + O[((2 + d) * 64 + t) * 65 + c + 1]);
                    bs += r0 * (k0 * (1.0f + (a0 - 1.0f) * p.in[19][hc])) * p.in[20][hc] + r1 * (k1 * (1.0f + (a1 - 1.0f) * p.in[19][hc + 1])) * p.in[20][hc + 1];
                    const float x0 = p.in[13][d * 512 + hc] + O[(d * 64 + t) * 65 + c], x1 = p.in[13][d * 512 + hc + 1] + O[(d * 64 + t) * 65 + c + 1];
                    const float l0 = -__expf(-softplusf_(-x0) - 0.5f), l1 = -__expf(-softplusf_(-x1) - 0.5f);
                    *(unsigned*)(sp + 2 * qp) = pk2(l0, l1); *(unsigned*)(sp + 64 + 2 * qp) = pk2(a0, a1); } }
            bs = sum8(bs);
            if (cs == 0) { ((float*)(p.ws + WS_INV))[row * 8 + h] = inv; ((float*)(p.ws + WS_BON))[row * 8 + h] = bs; }
            float g[8];
#pragma unroll
            for (int q = 0; q < 8; ++q) g[q] = O[(4 * 64 + t) * 65 + 8 * cs + q];
            *(u32x4*)((bf16_t*)(p.ws + WS_G) + (size_t)row * 512 + h * 64 + 8 * cs) = pack8(g); }
        __syncthreads();
        lru_common(p, shm, ti, h);
        if (tid < 128) { const int d = tid >> 6, c = tid & 63; float P = 1.f, hh = 0.f;
            for (int s = 0; s < 64; ++s) { const int t = d ? 63 - s : s; const float a = O[((2 * d) * 64 + t) * 65 + c]; hh = a * hh + O[((2 * d + 1) * 64 + t) * 65 + c]; P *= a; }
            float* car = (float*)(p.ws + WS_CAR) + (size_t)((tile * 8 + h) * 2 + d) * 128;
            car[c] = P; car[64 + c] = hh; }
        __syncthreads();
    }
}

__device__ __forceinline__ void rwkv_scan_item(const Params& p, unsigned char* shm, int item) {
    const int tid = threadIdx.x;
    const bf16_t* Z = (const bf16_t*)(p.ws + WS_Z);
    const bf16_t* SCAN = (const bf16_t*)p.out;
    bf16_t* YA = (bf16_t*)(p.ws + WS_YA);
    float* Wt = (float*)shm; float* KKt = Wt + 4096; float* Bt = KKt + 4096; float* KDt = Bt + 4096; float* Rt = KDt + 4096; float* Vt = Rt + 4096; float* Yb = Vt + 4096;
    int sample, b, h, d;
    if (item < 128) { sample = 1; b = item >> 4; h = (item >> 1) & 7; d = item & 1; }
    else { const int ii = item - 128; sample = 0; b = ii >> 4; h = (ii >> 1) & 7; d = ii & 1; }
    const int T = sample ? 2048 : 256, seqrow0 = sample ? NPR + b * 2048 : b * 256, ntile = T / 64;
    const int v = tid >> 3, q = tid & 7;
    float S[8];
    if (sample) { const float* s0 = p.in[3] + ((size_t)((b * 2 + d) * 8 + h)) * 4096 + v * 64 + 8 * q;
#pragma unroll
        for (int i = 0; i < 8; ++i) S[i] = s0[i]; }
    else {
#pragma unroll
        for (int i = 0; i < 8; ++i) S[i] = 0.f; }
    for (int ti_ = 0; ti_ < ntile; ++ti_) {
        const int tt = d ? ntile - 1 - ti_ : ti_; const int base = seqrow0 + tt * 64;
        {   const int t = tid >> 3, cs = tid & 7, row = base + t; const size_t zr = (size_t)row * DIN + h * 64 + 8 * cs;
            float r[8], k[8], vv[8], lw[8], aa[8];
            unpack8(*(const u32x4*)(Z + zr + ZR), r); unpack8(*(const u32x4*)(Z + zr + ZK), k); unpack8(*(const u32x4*)(Z + zr + ZV), vv);
            const bf16_t* sp = SCAN + ((size_t)(d * NTOK + row) * 8 + h) * 128 + 8 * cs;
            unpack8(*(const u32x4*)sp, lw); unpack8(*(const u32x4*)(sp + 64), aa);
            const float inv = ((const float*)(p.ws + WS_INV))[row * 8 + h];
#pragma unroll
            for (int i = 0; i < 8; ++i) { const int c = 8 * cs + i, hc = h * 64 + c;
                const float kk = k[i] * p.in[18][hc] * inv;
                Wt[t * 64 + c] = __expf(lw[i]); KKt[t * 64 + c] = kk; Bt[t * 64 + c] = kk * aa[i];
                KDt[t * 64 + c] = k[i] * (1.0f + (aa[i] - 1.0f) * p.in[19][hc]); Rt[t * 64 + c] = r[i]; Vt[t * 64 + c] = vv[i]; } }
        __syncthreads();
        for (int s = 0; s < 64; ++s) {
            const int t = d ? 63 - s : s; const int o = t * 64 + 8 * q;
            const f32x4 k0 = *(const f32x4*)(KKt + o), k1 = *(const f32x4*)(KKt + o + 4);
            float part = S[0] * k0[0] + S[1] * k0[1] + S[2] * k0[2] + S[3] * k0[3] + S[4] * k1[0] + S[5] * k1[1] + S[6] * k1[2] + S[7] * k1[3];
            part = sum8(part);
            const float sa = -part, vv = Vt[t * 64 + v];
            const f32x4 w0 = *(const f32x4*)(Wt + o), w1 = *(const f32x4*)(Wt + o + 4), b0 = *(const f32x4*)(Bt + o), b1 = *(const f32x4*)(Bt + o + 4);
            const f32x4 d0 = *(const f32x4*)(KDt + o), d1 = *(const f32x4*)(KDt + o + 4), r0 = *(const f32x4*)(Rt + o), r1 = *(const f32x4*)(Rt + o + 4);
            float y = 0.f;
#pragma unroll
            for (int i = 0; i < 4; ++i) { S[i] = S[i] * w0[i] + sa * b0[i] + vv * d0[i]; y += S[i] * r0[i]; }
#pragma unroll
            for (int i = 0; i < 4; ++i) { S[4 + i] = S[4 + i] * w1[i] + sa * b1[i] + vv * d1[i]; y += S[4 + i] * r1[i]; }
            y = sum8(y);
            if (q == 0) Yb[t * 64 + v] = y;
        }
        __syncthreads();
        {   const int t = tid >> 3, cs = tid & 7, row = base + t; float f[8];
#pragma unroll
            for (int i = 0; i < 8; ++i) f[i] = Yb[t * 64 + 8 * cs + i];
            *(u32x4*)(YA + (size_t)(d * NTOK + row) * 512 + h * 64 + 8 * cs) = pack8(f); }
    }
    if (!sample) { float* so = p.out + OUT_RWKV + ((size_t)((b * 2 + d) * 8 + h)) * 4096 + v * 64 + 8 * q;
#pragma unroll
        for (int i = 0; i < 8; ++i) so[i] = S[i]; }
    __syncthreads();
}

__device__ __forceinline__ void lru_final_item(const Params& p, unsigned char* shm, int it) {
    const int tid = threadIdx.x;
    const bf16_t* Z = (const bf16_t*)(p.ws + WS_Z);
    float* O = (float*)(shm + LO_O);
    const int tile = it >> 3, j = it & 7; const TileInfo ti = tile_info(tile);
    lru_common(p, shm, ti, j);
    if (tid < 128) { const int d = tid >> 6, c = tid & 63, ch = 64 * j + c;
        float hh = ti.sample ? p.in[4][ti.b * 1024 + d * 512 + ch] : 0.f;
        const float* car = (const float*)(p.ws + WS_CAR);
        if (d == 0) { for (int tl = ti.tile0; tl < tile; ++tl) { const float* cc = car + (size_t)((tl * 8 + j) * 2 + 0) * 128; hh = cc[c] * hh + cc[64 + c]; } }
        else { for (int tl = ti.tile0 + ti.ntile - 1; tl > tile; --tl) { const float* cc = car + (size_t)((tl * 8 + j) * 2 + 1) * 128; hh = cc[c] * hh + cc[64 + c]; } }
        for (int s = 0; s < 64; ++s) { const int t = d ? 63 - s : s; hh = O[((2 * d) * 64 + t) * 65 + c] * hh + O[((2 * d + 1) * 64 + t) * 65 + c]; O[((2 * d + 1) * 64 + t) * 65 + c] = hh; }
        if (!ti.sample) { if ((d == 0 && tile == ti.tile0 + ti.ntile - 1) || (d == 1 && tile == ti.tile0)) p.out[OUT_LRU + ti.b * 1024 + d * 512 + ch] = hh; } }
    __syncthreads();
    {   const int t = tid >> 3, cs = tid & 7, row = ti.row0 + t; float gb[8], y[8];
        unpack8(*(const u32x4*)(Z + (size_t)row * DIN + ZGB + 64 * j + 8 * cs), gb);
#pragma unroll
        for (int q = 0; q < 8; ++q) { const int c = 8 * cs + q; const float x = gb[q];
            const float ge = 0.5f * x * (1.0f + tanhf_(0.7978845608028654f * (x + 0.044715f * x * x * x)));
            y[q] = (O[(64 + t) * 65 + c] + O[(3 * 64 + t) * 65 + c]) * ge; }
        *(u32x4*)((bf16_t*)(p.ws + WS_ACT) + (size_t)row * DM + 512 + 64 * j + 8 * cs) = pack8(y); }
    __syncthreads();
}

__device__ __forceinline__ void phase_scan(const Params& p, unsigned char* shm) {
    const int bid = blockIdx.x, G = gridDim.x;
    for (int item = bid; item < 384; item += G) rwkv_scan_item(p, shm, item);
    if (G > 128) { if (bid >= 128) for (int it = bid - 128; it < NTILE * 8; it += G - 128) lru_final_item(p, shm, it); }
    else for (int it = bid; it < NTILE * 8; it += G) lru_final_item(p, shm, it);
}

__device__ __forceinline__ void phase_combine(const Params& p) {
    const int tid = threadIdx.x;
    const bf16_t* Z = (const bf16_t*)(p.ws + WS_Z); const bf16_t* YA = (const bf16_t*)(p.ws + WS_YA); const bf16_t* G = (const bf16_t*)(p.ws + WS_G);
    bf16_t* Y = (bf16_t*)(p.ws + WS_ACT);
    for (int tile = blockIdx.x; tile < NTILE; tile += gridDim.x) {
        const int t = tid >> 3, h = tid & 7, row = tile * 64 + t;
        const bf16_t* y0 = YA + (size_t)row * 512 + h * 64; const bf16_t* y1 = y0 + (size_t)NTOK * 512;
        float s1 = 0.f;
#pragma unroll
        for (int c8 = 0; c8 < 8; ++c8) { float a[8], b[8]; unpack8(*(const u32x4*)(y0 + 8 * c8), a); unpack8(*(const u32x4*)(y1 + 8 * c8), b);
#pragma unroll
            for (int q = 0; q < 8; ++q) s1 += a[q] + b[q]; }
        const float mu = s1 * (1.0f / 64.0f);
        float s2 = 0.f;
#pragma unroll
        for (int c8 = 0; c8 < 8; ++c8) { float a[8], b[8]; unpack8(*(const u32x4*)(y0 + 8 * c8), a); unpack8(*(const u32x4*)(y1 + 8 * c8), b);
#pragma unroll
            for (int q = 0; q < 8; ++q) { const float dd = a[q] + b[q] - mu; s2 += dd * dd; } }
        const float rstd = rsqrtf(s2 * (1.0f / 64.0f) + 64e-5f);
        const float bon = ((const float*)(p.ws + WS_BON))[row * 8 + h];
#pragma unroll
        for (int c8 = 0; c8 < 8; ++c8) { float a[8], b[8], vv[8], g[8], o[8];
            unpack8(*(const u32x4*)(y0 + 8 * c8), a); unpack8(*(const u32x4*)(y1 + 8 * c8), b);
            unpack8(*(const u32x4*)(Z + (size_t)row * DIN + ZV + h * 64 + 8 * c8), vv); unpack8(*(const u32x4*)(G + (size_t)row * 512 + h * 64 + 8 * c8), g);
#pragma unroll
            for (int q = 0; q < 8; ++q) { const int hc = h * 64 + 8 * c8 + q;
                o[q] = ((a[q] + b[q] - mu) * rstd * p.in[21][hc] + p.in[22][hc] + bon * vv[q]) * g[q]; }
            *(u32x4*)(Y + (size_t)row * DM + h * 64 + 8 * c8) = pack8(o); }
    }
}

__device__ __forceinline__ void phase_res1(const Params& p, unsigned char* shm) {
    float* sm = (float*)shm;
    const int tid = threadIdx.x, wid = tid >> 6, lane = tid & 63;
    const float* O1 = (const float*)(p.ws + WS_O1); bf16_t* H = (bf16_t*)(p.ws + WS_ACT);
    for (int tile = blockIdx.x; tile < NTILE; tile += gridDim.x) {
        const TileInfo ti = tile_info(tile);
        for (int i = tid; i < 3072; i += 512) sm[i] = mod_val(p, ti.mrow, 2048 + i);
        __syncthreads();
        for (int rr = 0; rr < 8; ++rr) {
            const int row = ti.row0 + wid * 8 + rr;
            f32x4 o[4]; float ss = 0.f;
#pragma unroll
            for (int i = 0; i < 4; ++i) { o[i] = *(const f32x4*)(O1 + (size_t)row * DM + 4 * lane + 256 * i); ss += o[i][0] * o[i][0] + o[i][1] * o[i][1] + o[i][2] * o[i][2] + o[i][3] * o[i][3]; }
            ss = wave_sum(ss);
            const float rstd = rsqrtf(ss * (1.0f / 1024.0f) + 1e-6f);
            f32x4 x1[4]; float s2 = 0.f;
#pragma unroll
            for (int i = 0; i < 4; ++i) { const int j = 4 * lane + 256 * i; const f32x4 x = load_x4(p, row, j); const f32x4 g = *(const f32x4*)(p.in[9] + j);
#pragma unroll
                for (int e = 0; e < 4; ++e) { x1[i][e] = x[e] + sm[j + e] * (o[i][e] * rstd * g[e]); s2 += x1[i][e] * x1[i][e]; }
                *(f32x4*)(p.out + (size_t)row * DM + j) = x1[i]; }
            s2 = wave_sum(s2);
            const float rstd2 = rsqrtf(s2 * (1.0f / 1024.0f) + 1e-6f);
#pragma unroll
            for (int i = 0; i < 4; ++i) { const int j = 4 * lane + 256 * i; const f32x4 g = *(const f32x4*)(p.in[10] + j); float h[4];
#pragma unroll
                for (int e = 0; e < 4; ++e) h[e] = x1[i][e] * rstd2 * g[e] * (1.0f + sm[2048 + j + e]) + sm[1024 + j + e];
                u32x2 w; w.x = pk2(h[0], h[1]); w.y = pk2(h[2], h[3]);
                *(u32x2*)(H + (size_t)row * DM + j) = w; }
        }
        __syncthreads();
    }
}

__device__ __forceinline__ void phase_final(const Params& p, unsigned char* shm) {
    float* sm = (float*)shm;
    const int tid = threadIdx.x, wid = tid >> 6, lane = tid & 63;
    const float* O2 = (const float*)(p.ws + WS_O2);
    for (int tile = blockIdx.x; tile < NTILE; tile += gridDim.x) {
        const TileInfo ti = tile_info(tile);
        for (int i = tid; i < 1024; i += 512) sm[i] = mod_val(p, ti.mrow, 5120 + i);
        __syncthreads();
        for (int rr = 0; rr < 8; ++rr) {
            const int row = ti.row0 + wid * 8 + rr;
            f32x4 o[4]; float ss = 0.f;
#pragma unroll
            for (int i = 0; i < 4; ++i) { o[i] = *(const f32x4*)(O2 + (size_t)row * DM + 4 * lane + 256 * i); ss += o[i][0] * o[i][0] + o[i][1] * o[i][1] + o[i][2] * o[i][2] + o[i][3] * o[i][3]; }
            ss = wave_sum(ss);
            const float rstd = rsqrtf(ss * (1.0f / 1024.0f) + 1e-6f);
#pragma unroll
            for (int i = 0; i < 4; ++i) { const int j = 4 * lane + 256 * i; const f32x4 g = *(const f32x4*)(p.in[11] + j);
                f32x4 x1 = *(const f32x4*)(p.out + (size_t)row * DM + j);
#pragma unroll
                for (int e = 0; e < 4; ++e) x1[e] += sm[j + e] * (o[i][e] * rstd * g[e]);
                *(f32x4*)(p.out + (size_t)row * DM + j) = x1; }
        }
        __syncthreads();
    }
}

template <class Epi>
__device__ __forceinline__ void run_gemm(unsigned char* shm, const bf16_t* A, const bf16_t* Bt, int M, int N, int K, const Epi& E) {
    pg8::Gemm g; g.A = A; g.Bt = Bt; g.M = M; g.N = N; g.K = K;
    pg8::StaticOrder S; S.init(M, N, (int)gridDim.x, (int)blockIdx.x);
    pg8::gemm_phase<Epi, pg8::StaticOrder>((PG8_LAS unsigned char*)shm, g, S, E);
}

__global__ void __launch_bounds__(512, 2) fwd_megakernel(Params p, int ph_lo, int ph_hi, int coop) {
    extern __shared__ __attribute__((aligned(16))) unsigned char shm[];
    cg::grid_group grid = cg::this_grid();
#ifndef PH_MASK
#define PH_MASK 0x7ff
#endif
#define PH_ON(k) ((PH_MASK & (1 << (k))) && ph_lo <= (k) && (k) < ph_hi)
#define PH_SYNC(k) do { if (coop && (k) + 1 < ph_hi && ph_lo <= (k)) { __threadfence(); grid.sync(); } } while (0)
    if (PH_ON(0)) phase0(p, shm);
    PH_SYNC(0);
    if (PH_ON(1)) phase_h1(p, shm);
    PH_SYNC(1);
    if (PH_ON(2)) { EpiB16<0> E; E.O = (bf16_t*)(p.ws + WS_Z); E.ldc = DIN; E.ncols = DIN;
        run_gemm(shm, (const bf16_t*)(p.ws + WS_ACT), (const bf16_t*)(p.ws + WS_WINT), NTOK, DINP, 1024, E); }
    PH_SYNC(2);
    if (PH_ON(3)) phase_prep(p, shm);
    PH_SYNC(3);
    if (PH_ON(4)) phase_scan(p, shm);
    PH_SYNC(4);
    if (PH_ON(5)) phase_combine(p);
    PH_SYNC(5);
    if (PH_ON(6)) { EpiF E; E.C = (float*)(p.ws + WS_O1); E.ldc = DM;
        run_gemm(shm, (const bf16_t*)(p.ws + WS_ACT), (const bf16_t*)(p.ws + WS_WOUTT), NTOK, 1024, 1024, E); }
    PH_SYNC(6);
    if (PH_ON(7)) phase_res1(p, shm);
    PH_SYNC(7);
    if (PH_ON(8)) { EpiB16<1> E; E.O = (bf16_t*)(p.ws + WS_F); E.ldc = DFF; E.ncols = DFF;
        run_gemm(shm, (const bf16_t*)(p.ws + WS_ACT), (const bf16_t*)(p.ws + WS_W1T), NTOK, DFF, 1024, E); }
    PH_SYNC(8);
    if (PH_ON(9)) { EpiF E; E.C = (float*)(p.ws + WS_O2); E.ldc = DM;
        run_gemm(shm, (const bf16_t*)(p.ws + WS_F), (const bf16_t*)(p.ws + WS_W2T), NTOK, 1024, DFF, E); }
    PH_SYNC(9);
    if (PH_ON(10)) phase_final(p, shm);
}
}

extern "C" void kernel_launch(void* const* d_in, const int* in_sizes, int n_in, void* d_out, int out_size, void* d_ws, size_t ws_size, hipStream_t stream) {
    static int grid_blocks = 0;
    if (grid_blocks == 0) {
        int dev = 0, cus = 0, per_cu = 0;
        hipGetDevice(&dev);
        hipDeviceGetAttribute(&cus, hipDeviceAttributeMultiprocessorCount, dev);
        if (hipFuncSetAttribute((const void*)fwd_megakernel, hipFuncAttributeMaxDynamicSharedMemorySize, LDS_BYTES) != hipSuccess) { fprintf(stderr, "hipFuncSetAttribute failed\n"); }
        if (hipOccupancyMaxActiveBlocksPerMultiprocessor(&per_cu, (const void*)fwd_megakernel, 512, LDS_BYTES) != hipSuccess || per_cu < 1) { fprintf(stderr, "occupancy query: %d\n", per_cu); per_cu = 1; }
        (void)hipGetLastError();
        grid_blocks = cus * per_cu;
        if (n_in != 33 || ws_size < 256 * MiB) fprintf(stderr, "unexpected n_in %d / ws_size %zu\n", n_in, ws_size);
    }
    Params p{};
    for (int i = 0; i < 33; ++i) p.in[i] = (const float*)d_in[i];
    p.out = (float*)d_out; p.ws = (unsigned char*)d_ws;
#if MK_LAUNCHES == 1
    int lo = 0, hi = 11, coop = 1;
    void* args[] = {&p, &lo, &hi, &coop};
    hipError_t e = hipLaunchCooperativeKernel((const void*)fwd_megakernel, dim3(grid_blocks), dim3(512), args, LDS_BYTES, stream);
    if (e != hipSuccess) fprintf(stderr, "cooperative launch failed: %s (grid %d)\n", hipGetErrorString(e), grid_blocks);
#else
    for (int ph = 0; ph < 11; ++ph) hipLaunchKernelGGL(fwd_megakernel, dim3(grid_blocks), dim3(512), LDS_BYTES, stream, p, ph, ph + 1, 0);
#endif
}
```

```cpp
#include <hip/hip_runtime.h>
#include <hip/hip_cooperative_groups.h>
#include <cstdio>
#include <type_traits>
namespace cg = cooperative_groups;
#ifndef PH_REP
#define PH_REP 0
#endif
#define PH_R(k) ((PH_REP >> (k)) & 1)
#ifndef HOST_REP
#define HOST_REP 0
#endif
#ifndef LRU_LO
#define LRU_LO 3
#endif
#ifndef MK_LAUNCHES
#define MK_LAUNCHES 1
#endif
namespace pg8 {
#define PG8_LAS __attribute__((address_space(3)))
typedef unsigned short bf16_t;
typedef short bf16x8 __attribute__((ext_vector_type(8)));
typedef float f32x4 __attribute__((ext_vector_type(4)));
typedef unsigned u32x4 __attribute__((ext_vector_type(4)));
constexpr int BM = 256, BK = 64, HALF = 128, HTB = HALF * BK * 2  , STAGE_BYTES = 8 * HTB, NXCD = 8, WGM = 8;

__host__ __device__ __forceinline__ int lds_byte(int r, int c) { const int st = (r >> 4) * 2 + (c >> 5), rr = r & 15, cc = c & 31, ob = rr * 64 + cc * 2; return st * 1024 + (ob ^ (((ob >> 9) & 1) << 5)); }
__host__ __device__ __forceinline__ void stage_rc(int b, int& R, int& C) { const int st = b / 1024, sb = b % 1024, swz = sb ^ (((sb >> 9) & 1) << 5); R = (st >> 1) * 16 + swz / 64; C = (st & 1) * 32 + (swz % 64) / 2; }
__host__ __device__ __forceinline__ int perm32(int rho) { const int n = rho >> 4, i = rho & 15; return 8 * (i >> 2) + 4 * n + (i & 3); }

struct Unit { int pm, pn, k0, nk, part; };
struct Gemm { const bf16_t* A; const bf16_t* Bt; int M, N, K; };

struct StaticOrder {
    int nM, nN, nwg, G, c;
    int nkt;
    __host__ __device__ void init(int M, int N, int G_, int c_, int K_) { nM = M / BM; nN = N / BM; nwg = nM * nN; G = G_; c = c_; nkt = K_ / BK; }
    __host__ __device__ bool next(int i, Unit& u) const {
        const long L = (long)i * G + c; if (L >= nwg) return false;
        int wgid = (int)L; { const int q = nwg / NXCD, r = nwg % NXCD, xcd = wgid % NXCD, off = wgid / NXCD; wgid = (xcd < r ? xcd * (q + 1) : r * (q + 1) + (xcd - r) * q) + off; }
        const int nig = WGM * nN, gid = wgid / nig, fm = gid * WGM, gsz = (nM - fm) < WGM ? (nM - fm) : WGM;
        u.pm = fm + ((wgid % nig) % gsz); u.pn = (wgid % nig) / gsz; u.k0 = 0; u.nk = nkt; u.part = -1; return true;
    }
    __device__ __forceinline__ void a_ready(const Unit&) const {}
    __device__ __forceinline__ void done(const Unit&) const {}
};
typedef __bf16 bf16v2_t __attribute__((ext_vector_type(2)));
__device__ __forceinline__ unsigned cvt_pk_bf16(float lo, float hi) { bf16v2_t v; v.x = (__bf16)lo; v.y = (__bf16)hi; return __builtin_bit_cast(unsigned, v); }
struct SplitTailOrder {
    int c, nkt;
    __host__ __device__ void init(int c_, int K_) { c = c_; nkt = K_ / BK; }
    __host__ __device__ bool next(int i, Unit& u) const {
        const int x = c & 7, idx = c >> 3;
        if (i == 0) { const int w = x * 32 + idx; u.pm = w >> 2; u.pn = w & 3; u.k0 = 0; u.nk = nkt; u.part = -1; return true; }
        if (i == 1) { const int t = x * 8 + (idx >> 2), part = idx & 3; u.pm = 64 + (t >> 2); u.pn = t & 3; u.nk = nkt / 4; u.k0 = part * (nkt / 4) * BK; u.part = part; return true; }
        return false;
    }
    __device__ __forceinline__ void a_ready(const Unit&) const {}
    __device__ __forceinline__ void done(const Unit&) const {}
};
template <class Epi, class Sched>
__device__ __forceinline__ void gemm_phase(PG8_LAS unsigned char* lds, const Gemm g, const Sched& S, const Epi& E) {
    const int tid = threadIdx.x, wid = __builtin_amdgcn_readfirstlane(tid >> 6), lane = tid & 63, wr = wid >> 2, wc = wid & 3, fr = lane & 15, fq = lane >> 4;
    const int K = g.K;
    unsigned voffA[2], voffB[2];
#pragma unroll
    for (int i = 0; i < 2; ++i) { int R, C; stage_rc(tid * 16 + i * 8192, R, C); const int Rb = Epi::PERM ? ((R & ~31) + perm32(R & 31)) : R;
        voffA[i] = (unsigned)(R * K + C) * 2u; voffB[i] = (unsigned)(Rb * K + C) * 2u; }
    const size_t kstep = (size_t)(BK * 2);
    const size_t hstep = (size_t)HALF * K * 2;
    const size_t tstep = 2 * hstep;
    const unsigned ldsw = (unsigned)wid * 1024u;
    const int aoff = lds_byte(wr * 64 + fr, fq * 8), boff = lds_byte(wc * 32 + fr, fq * 8);
#define PG8_SA(b, h) (((b) * 2 + (h)) * HTB)
#define PG8_SB(b, h) ((4 + (b) * 2 + (h)) * HTB)
#define PG8_STAGE(bufoff, gbase, voff) do { _Pragma("unroll") for (int _i = 0; _i < 2; ++_i) \
        __builtin_amdgcn_global_load_lds((const unsigned*)((const char*)(gbase) + (voff)[_i]), (PG8_LAS unsigned*)(lds + (bufoff) + ldsw + _i * 8192), 16, 0, 0); } while (0)
#define PG8_LDA(dst, b, h) do { _Pragma("unroll") for (int m = 0; m < 4; ++m) _Pragma("unroll") for (int k = 0; k < 2; ++k) dst[m][k] = *(const PG8_LAS bf16x8*)(lds + PG8_SA(b, h) + aoff + m * 2048 + k * 1024); } while (0)
#define PG8_LDB(dst, b, h) do { _Pragma("unroll") for (int n = 0; n < 2; ++n) _Pragma("unroll") for (int k = 0; k < 2; ++k) dst[n][k] = *(const PG8_LAS bf16x8*)(lds + PG8_SB(b, h) + boff + n * 2048 + k * 1024); } while (0)
#define PG8_MMA(ai, bj, At, Bt) do { __builtin_amdgcn_s_setprio(1); _Pragma("unroll") for (int m = 0; m < 4; ++m) _Pragma("unroll") for (int n = 0; n < 2; ++n) _Pragma("unroll") for (int k = 0; k < 2; ++k) \
        acc[ai][bj][m][n] = __builtin_amdgcn_mfma_f32_16x16x32_bf16(Bt[n][k], At[m][k], acc[ai][bj][m][n], 0, 0, 0); __builtin_amdgcn_s_setprio(0); } while (0)
#define PG8_WAIT_V(n) asm volatile("s_waitcnt vmcnt(" #n ")" ::: "memory")
#define PG8_WAIT_L(n) asm volatile("s_waitcnt lgkmcnt(" #n ")" ::: "memory")
#define PG8_BAR __builtin_amdgcn_s_barrier()
#define PG8_SCHED __builtin_amdgcn_sched_barrier(0)
    Unit cur, nxt; int ui = 0;
    if (!S.next(0, cur)) return;
    f32x4 acc[2][2][4][2];
#pragma unroll
    for (int a = 0; a < 2; ++a)
#pragma unroll
        for (int b = 0; b < 2; ++b)
#pragma unroll
            for (int m = 0; m < 4; ++m)
#pragma unroll
                for (int n = 0; n < 2; ++n) acc[a][b][m][n] = (f32x4){0.f, 0.f, 0.f, 0.f};
    bf16x8 At[4][2], B0[2][2], B1[2][2];
    const char* cA = (const char*)g.A + (size_t)cur.pm * tstep + (size_t)cur.k0 * 2; const char* cB = (const char*)g.Bt + (size_t)cur.pn * tstep + (size_t)cur.k0 * 2;
    S.a_ready(cur);
    PG8_STAGE(PG8_SB(0, 0), cB, voffB); PG8_STAGE(PG8_SA(0, 0), cA, voffA); PG8_STAGE(PG8_SB(0, 1), cB + hstep, voffB); PG8_STAGE(PG8_SA(0, 1), cA + hstep, voffA);
    if (wr == 1) PG8_BAR;
    PG8_WAIT_V(4); PG8_BAR;
    PG8_STAGE(PG8_SB(1, 0), cB + kstep, voffB); PG8_STAGE(PG8_SA(1, 0), cA + kstep, voffA); PG8_STAGE(PG8_SB(1, 1), cB + hstep + kstep, voffB);
    PG8_WAIT_V(6); PG8_BAR;
    for (;;) {
        const bool has_next = S.next(ui + 1, nxt);
        const char* nA = has_next ? (const char*)g.A + (size_t)nxt.pm * tstep + (size_t)nxt.k0 * 2 : cA; const char* nB = has_next ? (const char*)g.Bt + (size_t)nxt.pn * tstep + (size_t)nxt.k0 * 2 : cB;
        const int nt = cur.nk;
        for (int t = 0; t < nt; t += 2) {
            const bool last = (t == nt - 2);
            const char* a1 = cA + (size_t)(t + 1) * kstep;
            const char* a2 = last ? nA : cA + (size_t)(t + 2) * kstep; const char* b2 = last ? nB : cB + (size_t)(t + 2) * kstep;
            const char* a3 = a2 + kstep; const char* b3 = b2 + kstep;
            if (last && has_next) S.a_ready(nxt);
            PG8_LDB(B0, 0, 0); PG8_SCHED; PG8_LDA(At, 0, 0); PG8_STAGE(PG8_SA(1, 1), a1 + hstep, voffA);
            PG8_WAIT_L(8); PG8_BAR; PG8_WAIT_L(0); PG8_MMA(0, 0, At, B0); PG8_BAR; PG8_SCHED;
            PG8_LDB(B1, 0, 1); PG8_STAGE(PG8_SB(0, 0), b2, voffB);
            PG8_BAR; PG8_WAIT_L(0); PG8_MMA(0, 1, At, B1); PG8_BAR;
            PG8_LDA(At, 0, 1); PG8_STAGE(PG8_SA(0, 0), a2, voffA);
            PG8_BAR; PG8_WAIT_L(0); PG8_MMA(1, 0, At, B0); PG8_BAR; PG8_SCHED;
            PG8_STAGE(PG8_SB(0, 1), b2 + hstep, voffB);
            PG8_WAIT_V(6); PG8_BAR; PG8_MMA(1, 1, At, B1); PG8_BAR;
            PG8_LDB(B0, 1, 0); PG8_SCHED; PG8_LDA(At, 1, 0); PG8_STAGE(PG8_SA(0, 1), a2 + hstep, voffA);
            PG8_WAIT_L(8); PG8_BAR; PG8_WAIT_L(0); PG8_MMA(0, 0, At, B0); PG8_BAR; PG8_SCHED;
            PG8_LDB(B1, 1, 1); PG8_STAGE(PG8_SB(1, 0), b3, voffB);
            PG8_BAR; PG8_WAIT_L(0); PG8_MMA(0, 1, At, B1); PG8_BAR;
            PG8_LDA(At, 1, 1); PG8_STAGE(PG8_SA(1, 0), a3, voffA);
            PG8_BAR; PG8_WAIT_L(0); PG8_MMA(1, 0, At, B0); PG8_BAR; PG8_SCHED;
            PG8_STAGE(PG8_SB(1, 1), b3 + hstep, voffB);
            PG8_WAIT_V(6); PG8_BAR; PG8_MMA(1, 1, At, B1); PG8_BAR;
        }
        if constexpr (!Epi::AFTER_DRAIN) { E(acc, cur, wr, wc, fr, fq); S.done(cur); }
        if (!has_next) break;
#pragma unroll
        for (int a = 0; a < 2; ++a)
#pragma unroll
            for (int b = 0; b < 2; ++b)
#pragma unroll
                for (int m = 0; m < 4; ++m)
#pragma unroll
                    for (int n = 0; n < 2; ++n) acc[a][b][m][n] = (f32x4){0.f, 0.f, 0.f, 0.f};
        cur = nxt; cA = nA; cB = nB; ++ui;
    }
    PG8_WAIT_V(0);
    if (wr == 0) PG8_BAR;
    PG8_BAR;
    if constexpr (Epi::AFTER_DRAIN) { E.fused(acc, cur, wr, wc, fr, fq, lds, wid, lane); S.done(cur); }
#undef PG8_SA
#undef PG8_SB
#undef PG8_STAGE
#undef PG8_LDA
#undef PG8_LDB
#undef PG8_MMA
#undef PG8_WAIT_V
#undef PG8_WAIT_L
#undef PG8_BAR
#undef PG8_SCHED
}
}

#define XB_TMO      128
#define XB_XCNT(j)  (256  + 64 * (j))
#define XB_XSUB(j)  (1280 + 64 * (j))
#define XB_XGEN(j)  (2304 + 64 * (j))
#define XB_TOP      3328
#define XB_TOPGEN   3392
#define XCD_BAR_WORDS 3456
#define XB_SPIN_CAP (1u << 18)
#define LAS __attribute__((address_space(3)))

__device__ __forceinline__ unsigned xb_ld(unsigned* p)              { return __hip_atomic_load(p, __ATOMIC_RELAXED, __HIP_MEMORY_SCOPE_AGENT); }
__device__ __forceinline__ unsigned xb_add(unsigned* p, unsigned v) { return __hip_atomic_fetch_add(p, v, __ATOMIC_RELAXED, __HIP_MEMORY_SCOPE_AGENT); }
__device__ __forceinline__ unsigned xb_xcc_id() { return (unsigned)__builtin_amdgcn_s_getreg((3 << 11) | 20) & 0xFu; }
#define XB_SPIN(cond, bar) do { unsigned _sp = 0; while (cond) { __builtin_amdgcn_s_sleep(1); \
    if ((++_sp & 255u) == 0u) { if (xb_ld(&(bar)[XB_TMO])) break; if (_sp > XB_SPIN_CAP) { atomicAdd(&(bar)[XB_TMO], 1u); break; } } } } while (0)

struct XcdBarrier {
    unsigned* bar; unsigned x;
    volatile LAS unsigned* st;
};

__device__ __forceinline__ XcdBarrier xcd_barrier_post(unsigned* bar, volatile LAS unsigned* st) {
    XcdBarrier b; b.bar = bar; b.x = xb_xcc_id(); b.st = st;
    if (threadIdx.x == 0) (void)xb_add(&bar[XB_XCNT(b.x)], 1u);
    return b;
}
__device__ __forceinline__ void xcd_barrier_complete(unsigned* bar, unsigned x, unsigned& nloc, unsigned& nx) {
    const unsigned G = gridDim.x * gridDim.y * gridDim.z;
    unsigned sum, cnt, mine, sp = 0u;
    for (;;) {
        sum = 0u; cnt = 0u; mine = 0u;
#pragma unroll
        for (unsigned j = 0; j < 16; ++j) { const unsigned c = xb_ld(&bar[XB_XCNT(j)]); sum += c; cnt += (c > 0u) ? 1u : 0u; mine = (j == x) ? c : mine; }
        if (sum == G) break;
        __builtin_amdgcn_s_sleep(1);
        if ((++sp & 255u) == 0u) { if (xb_ld(&bar[XB_TMO])) break; if (sp > XB_SPIN_CAP) { atomicAdd(&bar[XB_TMO], 1u); break; } }
    }
    nloc = mine > 0u ? mine : 1u; nx = cnt > 0u ? cnt : 1u;
}

__device__ __forceinline__ void xcd_barrier(const XcdBarrier& b) {
    asm volatile("s_waitcnt vmcnt(0)" ::: "memory");
    __syncthreads();
    if (threadIdx.x == 0) {
        unsigned* bar = b.bar;
        __builtin_amdgcn_s_waitcnt(0);
        unsigned nloc = b.st[0], nx = b.st[1];
        if (nloc == 0u) { xcd_barrier_complete(bar, b.x, nloc, nx); b.st[0] = nloc; b.st[1] = nx; }
        const unsigned old = xb_add(&bar[XB_XSUB(b.x)], 1u);
        const unsigned gen = old / nloc;
        if (old + 1u == (gen + 1u) * nloc) {
            __builtin_amdgcn_fence(__ATOMIC_RELEASE, "agent");
            asm volatile("s_waitcnt vmcnt(0)" ::: "memory");
            const unsigned og = xb_add(&bar[XB_TOP], 1u);
            const unsigned tg = og / nx;
            if (og + 1u == (tg + 1u) * nx) xb_add(&bar[XB_TOPGEN], 1u);
            else XB_SPIN(xb_ld(&bar[XB_TOPGEN]) == tg, bar);
            __builtin_amdgcn_fence(__ATOMIC_ACQUIRE, "agent");
            xb_add(&bar[XB_XGEN(b.x)], 1u);
            asm volatile("s_waitcnt vmcnt(0)" ::: "memory");
        } else {
            XB_SPIN(xb_ld(&bar[XB_XGEN(b.x)]) == gen, bar);
            __builtin_amdgcn_fence(__ATOMIC_ACQUIRE, "agent");
            asm volatile("s_waitcnt vmcnt(0)" ::: "memory");
        }
    }
    __syncthreads();
}

namespace {
using pg8::bf16_t; using pg8::bf16x8; using pg8::f32x4; using pg8::u32x4;
typedef unsigned u32x2 __attribute__((ext_vector_type(2)));

constexpr int DM = 1024, NTOK = 20480, NPR = 4096, DIN = 2944, DINP = 3072, DFF = 4096;
constexpr int ZR = 0, ZK = 512, ZV = 1024, ZXW = 1536, ZXA = 1664, ZXG = 1792, ZXB = 1920, ZGB = 2432;
constexpr int NTILE = NTOK / 64;
constexpr size_t MiB = 1048576;
constexpr size_t WS_W2T = 0;
constexpr size_t WS_WUPT = 8 * MiB;
constexpr size_t WS_AUPT = WS_WUPT + 131072;
constexpr size_t WS_GUPT = WS_AUPT + 131072;
constexpr size_t WS_WAT = WS_GUPT + 131072;
constexpr size_t WS_WXT = WS_WAT + 131072;
constexpr size_t WS_ROWTAB = WS_WXT + 131072;
constexpr size_t WS_COLTAB = WS_ROWTAB + 65536;
constexpr size_t WS_MODPART = 9 * MiB;
constexpr size_t WS_BAR = 12 * MiB + 512 * 1024;
constexpr size_t WS_MODF = WS_BAR + 65536;
constexpr size_t WS_F = 13 * MiB;
constexpr size_t WS_Z = WS_F;
constexpr size_t WS_YA = WS_F + 115 * MiB;
constexpr size_t WS_O1 = WS_F;
constexpr size_t WS_O1P = WS_F + 40 * MiB;
constexpr size_t WS_C = 173 * MiB;
constexpr size_t WS_WINT = WS_C;
constexpr size_t WS_WOUTT = WS_C + 6 * MiB;
constexpr size_t WS_W1T = WS_C + 8 * MiB;
constexpr size_t WS_ACT = WS_C + 16 * MiB;
constexpr size_t WS_G = WS_C + 56 * MiB;
constexpr size_t WS_INV = WS_C + 76 * MiB;
constexpr size_t WS_BON = WS_INV + 655360;
constexpr size_t WS_CAR = WS_BON + 655360;
constexpr size_t WS_O2 = WS_C;
constexpr size_t WS_O2P = WS_C + 40 * MiB;
constexpr size_t OUT_RWKV = (size_t)NTOK * DM;
constexpr size_t OUT_LRU = OUT_RWKV + 16 * 2 * 8 * 4096;

constexpr int LDS_BYTES = 154 * 1024;

struct Params {
    const float* in[33];
    float* out;
    unsigned char* ws;
};

__device__ __forceinline__ float bf2f(unsigned short b) { return __uint_as_float(((unsigned)b) << 16); }
__device__ __forceinline__ unsigned short f2bf(float f) { return __builtin_bit_cast(unsigned short, (__bf16)f); }
__device__ __forceinline__ unsigned pk2(float lo, float hi) { return pg8::cvt_pk_bf16(lo, hi); }
__device__ __forceinline__ void unpack8(const u32x4 w, float* f) {
    f[0] = __uint_as_float(w.x << 16); f[1] = __uint_as_float(w.x & 0xffff0000u);
    f[2] = __uint_as_float(w.y << 16); f[3] = __uint_as_float(w.y & 0xffff0000u);
    f[4] = __uint_as_float(w.z << 16); f[5] = __uint_as_float(w.z & 0xffff0000u);
    f[6] = __uint_as_float(w.w << 16); f[7] = __uint_as_float(w.w & 0xffff0000u);
}
__device__ __forceinline__ u32x4 pack8(const float* f) { u32x4 w; w.x = pk2(f[0], f[1]); w.y = pk2(f[2], f[3]); w.z = pk2(f[4], f[5]); w.w = pk2(f[6], f[7]); return w; }
__device__ __forceinline__ float sigmoidf_(float x) { return __builtin_amdgcn_rcpf(1.0f + __expf(-x)); }
__device__ __forceinline__ float softplusf_(float y) {
    if (y > 15.0f) return y;
    const float e = __expf(y), u = 1.0f + e;
    return (u == 1.0f) ? e : __logf(u) * (e * __builtin_amdgcn_rcpf(u - 1.0f));
}
__device__ __forceinline__ float tanhf_(float x) { const float e = __expf(2.0f * x); return 1.0f - 2.0f * __builtin_amdgcn_rcpf(e + 1.0f); }
__device__ __forceinline__ float wave_sum(float v) {
#pragma unroll
    for (int o = 32; o > 0; o >>= 1) v += __shfl_xor(v, o);
    return v;
}
__device__ __forceinline__ float sum8(float v) { v += __shfl_xor(v, 1); v += __shfl_xor(v, 2); v += __shfl_xor(v, 4); return v; }

struct TileInfo { int row0; int mrow; int b; int t0; int T; int seqrow0; int sample; int tile0; int ntile; };
__device__ __forceinline__ TileInfo tile_info(int tile) {
    TileInfo ti; ti.row0 = tile * 64;
    if (tile < 64) { ti.sample = 0; ti.b = tile >> 2; ti.t0 = (tile & 3) * 64; ti.T = 256; ti.mrow = 8; ti.seqrow0 = ti.b * 256; ti.tile0 = ti.b * 4; ti.ntile = 4; }
    else { const int s = tile - 64; ti.sample = 1; ti.b = s >> 5; ti.t0 = (s & 31) * 64; ti.T = 2048; ti.mrow = ti.b; ti.seqrow0 = NPR + ti.b * 2048; ti.tile0 = 64 + ti.b * 32; ti.ntile = 32; }
    return ti;
}
__device__ __forceinline__ f32x4 load_x4(const Params& p, int row, int j) {
    if (row < NPR) return *(const f32x4*)(p.in[0] + (size_t)row * DM + j);
    const int r = row - NPR, t = r & 2047;
    f32x4 x = *(const f32x4*)(p.in[1] + (size_t)r * DM + j);
    const float* tab = (j < 512) ? (const float*)(p.ws + WS_ROWTAB) + (t >> 6) * 512 + j : (const float*)(p.ws + WS_COLTAB) + (t & 63) * 512 + (j - 512);
    const f32x4 e = *(const f32x4*)tab;
    return x + e;
}
__device__ __forceinline__ float mod_val(const Params& p, int mrow, int col) {
    const float* mp = (const float*)(p.ws + WS_MODPART);
    float s = p.in[7][col];
#pragma unroll
    for (int ks = 0; ks < 16; ++ks) s += mp[(size_t)(ks * 9 + mrow) * 6144 + col];
    return s;
}

__device__ __forceinline__ f32x4 mm16(const bf16_t* A, int lda, const bf16_t* BT, int ldb, int K, int lane) {
    const int fr = lane & 15, fq = lane >> 4;
    f32x4 acc = {0.f, 0.f, 0.f, 0.f};
    for (int kk = 0; kk < K; kk += 32) {
        const bf16x8 a = *(const bf16x8*)(A + fr * lda + kk + 8 * fq);
        const bf16x8 b = *(const bf16x8*)(BT + (size_t)fr * ldb + kk + 8 * fq);
        acc = __builtin_amdgcn_mfma_f32_16x16x32_bf16(a, b, acc, 0, 0, 0);
    }
    return acc;
}

template <int ACT> struct EpiB16 {
    static constexpr bool PERM = true, AFTER_DRAIN = false;
    bf16_t* O; int ldc; int ncols;
    __device__ __forceinline__ void operator()(const f32x4 (&acc)[2][2][4][2], const pg8::Unit& u, int wr, int wc, int fr, int fq) const {
        const int row0 = u.pm * 256 + wr * 64 + fr; const int col0 = u.pn * 256 + wc * 32 + 8 * fq;
#pragma unroll
        for (int ai = 0; ai < 2; ++ai)
#pragma unroll
            for (int m = 0; m < 4; ++m) { bf16_t* rowp = O + (size_t)(row0 + ai * 128 + m * 16) * ldc + col0;
#pragma unroll
                for (int bj = 0; bj < 2; ++bj) { f32x4 v0 = acc[ai][bj][m][0], v1 = acc[ai][bj][m][1];
                    if (ACT == 1) {
#pragma unroll
                        for (int j = 0; j < 4; ++j) { const float a = fmaxf(v0[j], 0.f), b = fmaxf(v1[j], 0.f); v0[j] = a * a; v1[j] = b * b; } }
                    if (ACT == 2 && bj == 0) {
                        if (u.pn == 6) {
#pragma unroll
                            for (int j = 0; j < 4; ++j) { v0[j] = tanhf_(v0[j]); v1[j] = tanhf_(v1[j]); } }
                        if (u.pn == 7) {
#pragma unroll
                            for (int j = 0; j < 4; ++j) { v0[j] = sigmoidf_(v0[j]); v1[j] = sigmoidf_(v1[j]); } } }
                    u32x4 w; w.x = pg8::cvt_pk_bf16(v0[0], v0[1]); w.y = pg8::cvt_pk_bf16(v0[2], v0[3]); w.z = pg8::cvt_pk_bf16(v1[0], v1[1]); w.w = pg8::cvt_pk_bf16(v1[2], v1[3]);
                    if (col0 + bj * 128 < ncols) *(u32x4*)(rowp + bj * 128) = w; } }
    }
};
struct EpiSplitB16 {
    static constexpr bool PERM = true, AFTER_DRAIN = false;
    bf16_t* O; bf16_t* P;
    __device__ __forceinline__ void operator()(const f32x4 (&acc)[2][2][4][2], const pg8::Unit& u, int wr, int wc, int fr, int fq) const {
        const int row0 = u.pm * 256 + wr * 64 + fr; const int col0 = u.pn * 256 + wc * 32 + 8 * fq;
        bf16_t* base = (u.part < 0) ? O + (size_t)row0 * 1024 : P + ((size_t)u.part * 4096 + (row0 - 16384)) * 1024;
#pragma unroll
        for (int ai = 0; ai < 2; ++ai)
#pragma unroll
            for (int m = 0; m < 4; ++m) { bf16_t* rowp = base + (size_t)(ai * 128 + m * 16) * 1024 + col0;
#pragma unroll
                for (int bj = 0; bj < 2; ++bj) { const f32x4 v0 = acc[ai][bj][m][0], v1 = acc[ai][bj][m][1];
                    u32x4 w; w.x = pg8::cvt_pk_bf16(v0[0], v0[1]); w.y = pg8::cvt_pk_bf16(v0[2], v0[3]); w.z = pg8::cvt_pk_bf16(v1[0], v1[1]); w.w = pg8::cvt_pk_bf16(v1[2], v1[3]);
                    *(u32x4*)(rowp + bj * 128) = w; } }
    }
};
struct EpiF {
    static constexpr bool PERM = false, AFTER_DRAIN = false;
    float* C; int ldc;
    __device__ __forceinline__ void operator()(const f32x4 (&acc)[2][2][4][2], const pg8::Unit& u, int wr, int wc, int fr, int fq) const {
        const int row0 = u.pm * 256 + wr * 64 + fr, col0 = u.pn * 256 + wc * 32 + 4 * fq;
#pragma unroll
        for (int ai = 0; ai < 2; ++ai)
#pragma unroll
            for (int m = 0; m < 4; ++m) { float* rowp = C + (size_t)(row0 + ai * 128 + m * 16) * ldc + col0;
#pragma unroll
                for (int bj = 0; bj < 2; ++bj)
#pragma unroll
                    for (int n = 0; n < 2; ++n) *(f32x4*)(rowp + bj * 128 + n * 16) = acc[ai][bj][m][n]; }
    }
};

__device__ __forceinline__ void transpose_tile(const float* src, int N, int Nvalid, bf16_t* dst, int K, int n0, int k0, float* tile) {
    const int tid = threadIdx.x;
    {   const int r = tid >> 4, c4 = (tid & 15) * 4;
#pragma unroll
        for (int pss = 0; pss < 2; ++pss) { const int rr = r + pss * 32;
            f32x4 v = {0.f, 0.f, 0.f, 0.f};
            if (n0 < Nvalid) v = *(const f32x4*)(src + (size_t)(k0 + rr) * N + n0 + c4);
            tile[rr * 65 + c4 + 0] = v[0]; tile[rr * 65 + c4 + 1] = v[1]; tile[rr * 65 + c4 + 2] = v[2]; tile[rr * 65 + c4 + 3] = v[3]; } }
    __syncthreads();
    {   const int rr = tid >> 3, kc = (tid & 7) * 8; float f[8];
#pragma unroll
        for (int j = 0; j < 8; ++j) f[j] = tile[(kc + j) * 65 + rr];
        *(u32x4*)(dst + (size_t)(n0 + rr) * K + k0 + kc) = pack8(f); }
    __syncthreads();
}

__device__ __forceinline__ void phase0(const Params& p, unsigned char* shm) {
    float* tile = (float*)shm;
    const int tid = threadIdx.x;
    const bool defer = (gridDim.x == 256);
    constexpr int N_TR = 3072, N_MOD = 192, N_SW = 160, N_TAB = 24;
    for (int it0 = blockIdx.x; it0 < (defer ? 768 : N_TR) + N_MOD + N_SW + N_TAB; it0 += gridDim.x) {
        const int it = (defer && it0 >= 768) ? it0 + (N_TR - 768) : it0;
        if (it < N_TR) {
            if (it < 768) transpose_tile(p.in[12], DIN, DIN, (bf16_t*)(p.ws + WS_WINT), 1024, (it >> 4) * 64, (it & 15) * 64, tile);
            else if (it < 1024) { const int i = it - 768; transpose_tile(p.in[30], 1024, 1024, (bf16_t*)(p.ws + WS_WOUTT), 1024, (i >> 4) * 64, (i & 15) * 64, tile); }
            else if (it < 2048) { const int i = it - 1024; transpose_tile(p.in[31], 4096, 4096, (bf16_t*)(p.ws + WS_W1T), 1024, (i >> 4) * 64, (i & 15) * 64, tile); }
            else { const int i = it - 2048; transpose_tile(p.in[32], 1024, 1024, (bf16_t*)(p.ws + WS_W2T), 4096, (i >> 6) * 64, (i & 63) * 64, tile); }
        } else if (it < N_TR + N_MOD) {
            const int i = it - N_TR, cgp = i % 12, ks = i / 12, k0 = ks * 64;
            for (int e = tid; e < 576; e += 512) { const int b = e >> 6, kk = e & 63; const float cv = (b < 8) ? p.in[2][b * 1024 + k0 + kk] : p.in[5][k0 + kk]; tile[e] = cv * __builtin_amdgcn_rcpf(1.0f + __expf(-cv)); }
            __syncthreads();
            const int col = cgp * 512 + tid;
            float a0 = 0, a1 = 0, a2 = 0, a3 = 0, a4 = 0, a5 = 0, a6 = 0, a7 = 0, a8 = 0;
            const float* wm = p.in[6] + (size_t)k0 * 6144 + col;
#pragma unroll
            for (int hb = 0; hb < 2; ++hb) { float wv[32];
#pragma unroll
                for (int q = 0; q < 32; ++q) wv[q] = wm[(size_t)(hb * 32 + q) * 6144];
                __builtin_amdgcn_sched_barrier(0);
#pragma unroll
                for (int q = 0; q < 32; ++q) { const int kk = hb * 32 + q; const float w = wv[q];
                    a0 += tile[kk] * w; a1 += tile[64 + kk] * w; a2 += tile[128 + kk] * w; a3 += tile[192 + kk] * w; a4 += tile[256 + kk] * w;
                    a5 += tile[320 + kk] * w; a6 += tile[384 + kk] * w; a7 += tile[448 + kk] * w; a8 += tile[512 + kk] * w; } }
            float* mp = (float*)(p.ws + WS_MODPART) + (size_t)(ks * 9) * 6144 + col;
            mp[0] = a0; mp[6144] = a1; mp[2 * 6144] = a2; mp[3 * 6144] = a3; mp[4 * 6144] = a4; mp[5 * 6144] = a5; mp[6 * 6144] = a6; mp[7 * 6144] = a7; mp[8 * 6144] = a8;
            __syncthreads();
        } else if (it < N_TR + N_MOD + N_SW) {
            const int i = it - N_TR - N_MOD;
#pragma unroll
            for (int q = 0; q < 4; ++q) {
                const int e = i * 2048 + q * 512 + tid, which = e >> 16, r = e & 65535;
                float v; bf16_t* dst;
                if (which < 2) { const int d = r >> 15, n = (r >> 6) & 511, k = r & 63; v = p.in[which == 0 ? 14 : 16][d * 32768 + k * 512 + n]; dst = (bf16_t*)(p.ws + (which == 0 ? WS_WUPT : WS_AUPT)); }
                else if (which == 2) { const int n = r >> 7, k = r & 127; v = p.in[17][k * 512 + n]; dst = (bf16_t*)(p.ws + WS_GUPT); }
                else { const int dn = r >> 12, o = (r >> 6) & 63, c = r & 63; v = p.in[which == 3 ? 25 : 27][dn * 4096 + c * 64 + o]; dst = (bf16_t*)(p.ws + (which == 3 ? WS_WAT : WS_WXT)); }
                dst[r] = f2bf(v);
            }
        } else {
            const int i = it - N_TR - N_MOD - N_SW;
#pragma unroll
            for (int q = 0; q < 4; ++q) {
                const int e = i * 2048 + q * 512 + tid;
                const int isrow = e < 16384, e2 = isrow ? e : e - 16384, pos = e2 >> 9, j = e2 & 511, ii = j & 255;
                const float omega = 1.0f / powf(10000.0f, (float)ii / 256.0f);
                const float ang = (float)pos * omega;
                const float v = (j < 256) ? sinf(ang) : cosf(ang);
                ((float*)(p.ws + (isrow ? WS_ROWTAB : WS_COLTAB)))[e2] = v;
            }
        }
    }
}

__device__ __forceinline__ void deferred_transposes(const Params& p, unsigned char* shm, int which, int rank, int nranks) {
    float* tile = (float*)shm;
    if (which == 0) { for (int i = rank; i < 256; i += nranks) transpose_tile(p.in[30], 1024, 1024, (bf16_t*)(p.ws + WS_WOUTT), 1024, (i >> 4) * 64, (i & 15) * 64, tile); }
    else { for (int it = rank; it < 2048; it += nranks) {
            if (it < 1024) transpose_tile(p.in[31], 4096, 4096, (bf16_t*)(p.ws + WS_W1T), 1024, (it >> 4) * 64, (it & 15) * 64, tile);
            else { const int i = it - 1024; transpose_tile(p.in[32], 1024, 1024, (bf16_t*)(p.ws + WS_W2T), 4096, (i >> 6) * 64, (i & 63) * 64, tile); } } }
}

__device__ __forceinline__ void phase_h1(const Params& p, unsigned char* shm) {
    float* sm = (float*)shm;
    const int tid = threadIdx.x, wid = tid >> 6, lane = tid & 63;
    bf16_t* H = (bf16_t*)(p.ws + WS_ACT);
    for (int e = blockIdx.x * 512 + tid; e < 9 * 6144; e += gridDim.x * 512) ((float*)(p.ws + WS_MODF))[e] = mod_val(p, e / 6144, e % 6144);
    const int per16 = (NTOK / 16 + (int)gridDim.x - 1) / (int)gridDim.x; int cur_mrow = -1;
    auto body = [&](auto nr_tag, int row) { constexpr int NR = decltype(nr_tag)::value;
            f32x4 x[NR][4]; float ss[NR] = {};
#pragma unroll
            for (int u = 0; u < NR; ++u)
#pragma unroll
                for (int i = 0; i < 4; ++i) x[u][i] = load_x4(p, row + (u >> 1) * 16 + (u & 1), 4 * lane + 256 * i);
#pragma unroll
            for (int u = 0; u < NR; ++u)
#pragma unroll
                for (int i = 0; i < 4; ++i) ss[u] += x[u][i][0] * x[u][i][0] + x[u][i][1] * x[u][i][1] + x[u][i][2] * x[u][i][2] + x[u][i][3] * x[u][i][3];
#pragma unroll
            for (int o = 32; o > 0; o >>= 1) {
#pragma unroll
                for (int u = 0; u < NR; ++u) ss[u] += __shfl_xor(ss[u], o); }
#pragma unroll
            for (int u = 0; u < NR; ++u) { const float rstd = rsqrtf(ss[u] * (1.0f / 1024.0f) + 1e-6f);
#pragma unroll
                for (int i = 0; i < 4; ++i) { const int j = 4 * lane + 256 * i;
                    const f32x4 g = *(const f32x4*)(p.in[8] + j); float h[4];
#pragma unroll
                    for (int e = 0; e < 4; ++e) h[e] = x[u][i][e] * rstd * g[e] * (1.0f + sm[1024 + j + e]) + sm[j + e];
                    u32x2 w; w.x = pk2(h[0], h[1]); w.y = pk2(h[2], h[3]);
                    __builtin_nontemporal_store(w, (u32x2*)(H + (size_t)(row + (u >> 1) * 16 + (u & 1)) * DM + j)); } }
    };
    for (int k16 = 0; k16 < per16; ) {
        const int t16 = blockIdx.x * per16 + k16; if (t16 >= NTOK / 16) break;
        const int row = t16 * 16 + wid * 2, mrow = (t16 * 16 < NPR) ? 8 : ((t16 * 16 - NPR) >> 11);
        if (mrow != cur_mrow) { __syncthreads(); { float mv[4];
#pragma unroll
            for (int q = 0; q < 4; ++q) mv[q] = mod_val(p, mrow, tid + 512 * q);
#pragma unroll
            for (int q = 0; q < 4; ++q) sm[tid + 512 * q] = mv[q]; } __syncthreads(); cur_mrow = mrow; }
        const int t16b = t16 + 1; const bool pair = (k16 + 1 < per16) && (t16b < NTOK / 16) && (((t16b * 16 < NPR) ? 8 : ((t16b * 16 - NPR) >> 11)) == mrow);
        if (pair) { body(std::integral_constant<int, 4>{}, row); k16 += 2; } else { body(std::integral_constant<int, 2>{}, row); k16 += 1; }
    }
    __syncthreads();
}

constexpr int LO_O = 0;
constexpr int LO_XA = 87040;
constexpr int LO_PRM = 139264;
constexpr int LW_HALF = 26624 + 2 * 9216, LW_GB = 26624;
struct LruPre { u32x4 x[8]; u32x4 g[2]; };

template <int MODE>
__device__ __forceinline__ void lru_load_x(const Params& p, const TileInfo& ti, int j, int ht, LruPre& pre) {
    const bf16_t* Z = (const bf16_t*)(p.ws + WS_Z);
    const int t = ht >> 2, cq = ht & 3;
#pragma unroll
    for (int jj = 0; jj < 4; ++jj) { const int tt = ti.t0 + t + jj - 2; const bool ok = (tt >= 0) && (tt < ti.T);
        const bf16_t* src = Z + (size_t)(ti.seqrow0 + (ok ? tt : 0)) * DIN + ZXB + 64 * j + 16 * cq;
        const u32x4 z = {0u, 0u, 0u, 0u};
        pre.x[2 * jj] = ok ? *(const u32x4*)src : z; pre.x[2 * jj + 1] = ok ? *(const u32x4*)(src + 8) : z; }
    if (MODE == 1) { const bf16_t* src = Z + (size_t)(ti.row0 + t) * DIN + ZGB + 64 * j + 16 * cq; pre.g[0] = *(const u32x4*)src; pre.g[1] = *(const u32x4*)(src + 8); }
}

template <int MODE>
__device__ __forceinline__ void lru_wave_item(const Params& p, unsigned char* lh, const bf16_t* wt, const float* cp, const float (&pba)[2], const float (&pbx)[2], const float (&pc8)[2], int tile, int j, const TileInfo& ti, LruPre& pre, int ht, int next_tile, int par) {
    const bf16_t* Z = (const bf16_t*)(p.ws + WS_Z);
    bf16_t* xcb = (bf16_t*)lh; float* xcf = (float*)(lh + 9216); bf16_t* gbt = (bf16_t*)(lh + LW_GB + par * 9216);
    const int lane = ht & 63, nt = ht >> 6, fr = lane & 15, fq = lane >> 4, ch = 64 * j + 16 * nt + fr;
    {   const int t = ht >> 2, cq = ht & 3; float xc[16];
#pragma unroll
        for (int q = 0; q < 16; ++q) xc[q] = cp[4 * 64 + 16 * cq + q];
#pragma unroll
        for (int jj = 0; jj < 4; ++jj) { float f[16]; unpack8(pre.x[2 * jj], f); unpack8(pre.x[2 * jj + 1], f + 8); __builtin_amdgcn_sched_barrier(0);
#pragma unroll
            for (int q = 0; q < 16; ++q) xc[q] += f[q] * cp[jj * 64 + 16 * cq + q]; }
        *(u32x4*)(xcb + t * 72 + 16 * cq) = pack8(xc); *(u32x4*)(xcb + t * 72 + 16 * cq + 8) = pack8(xc + 8);
        if (MODE == 1) { *(u32x4*)(gbt + t * 72 + 16 * cq) = pre.g[0]; *(u32x4*)(gbt + t * 72 + 16 * cq + 8) = pre.g[1]; }
#pragma unroll
        for (int q = 0; q < 16; q += 4) *(f32x4*)(xcf + t * 68 + 16 * cq + q) = (f32x4){xc[q], xc[q + 1], xc[q + 2], xc[q + 3]}; }
    __builtin_amdgcn_sched_barrier(0);
    if (next_tile >= 0) { const TileInfo tn = tile_info(next_tile); lru_load_x<MODE>(p, tn, j, ht, pre); }
    __syncthreads();
    f32x4 A_[2][4], B_[2][4];
    bf16x8 bl[4][2];
#pragma unroll
    for (int o = 0; o < 4; ++o)
#pragma unroll
        for (int k2 = 0; k2 < 2; ++k2) bl[o][k2] = *(const bf16x8*)(wt + (o * 64 + 16 * nt + fr) * 72 + 32 * k2 + 8 * fq);
#pragma unroll
    for (int mt = 0; mt < 4; ++mt) {
        const bf16x8 a0 = *(const bf16x8*)(xcb + (16 * mt + fr) * 72 + 8 * fq), a1 = *(const bf16x8*)(xcb + (16 * mt + fr) * 72 + 32 + 8 * fq);
        f32x4 acc[4];
#pragma unroll
        for (int o = 0; o < 4; ++o) { acc[o] = (f32x4){0.f, 0.f, 0.f, 0.f};
            acc[o] = __builtin_amdgcn_mfma_f32_16x16x32_bf16(a0, bl[o][0], acc[o], 0, 0, 0); acc[o] = __builtin_amdgcn_mfma_f32_16x16x32_bf16(a1, bl[o][1], acc[o], 0, 0, 0); }
#pragma unroll
        for (int d = 0; d < 2; ++d)
#pragma unroll
            for (int e = 0; e < 4; ++e) {
                const float rg = sigmoidf_(acc[2 * d][e] + pba[d]), ig = sigmoidf_(acc[2 * d + 1][e] + pbx[d]);
                const float a = __expf(rg * pc8[d]);
                A_[d][mt][e] = a; B_[d][mt][e] = __builtin_amdgcn_sqrtf(fmaxf(1.0f - a * a, 0.0f)) * (ig * xcf[(16 * mt + 4 * fq + e) * 68 + 16 * nt + fr]); }
    }
    __syncthreads();
    float hin0 = 0.f, hin1 = 0.f;
    if (MODE == 1) {
        const int chain = lane & 31, dd = chain >> 4, part = lane >> 5;
        const float* car = (const float*)(p.ws + WS_CAR);
        float Pa = 1.0f, Ha = 0.0f;
#pragma unroll
        for (int hb = 0; hb < 2; ++hb) { float Pv[8], Hv[8];
#pragma unroll
            for (int i = 0; i < 8; ++i) { const int kk = part * 16 + hb * 8 + i; const int tl = dd ? (ti.tile0 + ti.ntile - 1 - kk) : (ti.tile0 + kk);
                const bool valid = (kk < ti.ntile) && (dd ? (tl > tile) : (tl < tile));
                const float* cc = car + (size_t)((tl * 8 + j) * 2 + dd) * 128 + 16 * nt + fr;
                Pv[i] = valid ? cc[0] : 1.0f; Hv[i] = valid ? cc[64] : 0.0f; }
#pragma unroll
            for (int i = 0; i < 8; ++i) { Ha = Pv[i] * Ha + Hv[i]; Pa = Pv[i] * Pa; }
            __builtin_amdgcn_sched_barrier(0); }
        const float P1 = __shfl(Pa, chain + 32), H1 = __shfl(Ha, chain + 32);
        const float P0 = __shfl(Pa, chain), H0 = __shfl(Ha, chain);
        float h0 = ti.sample ? p.in[4][ti.b * 1024 + dd * 512 + ch] : 0.f;
        h0 = P0 * h0 + H0; h0 = P1 * h0 + H1;
        hin0 = __shfl(h0, fr); hin1 = __shfl(h0, 16 + fr); }
    float hs[4][4];
#pragma unroll
    for (int d = 0; d < 2; ++d) {
        float R_P = 1.0f, R_H = 0.0f;
        float hin = d ? hin1 : hin0;
#pragma unroll
        for (int m_ = 0; m_ < 4; ++m_) { const int mt = d ? 3 - m_ : m_;
            float P = 1.0f, H = 0.0f;
#pragma unroll
            for (int e_ = 0; e_ < 4; ++e_) { const int e = d ? 3 - e_ : e_; H = A_[d][mt][e] * H + B_[d][mt][e]; P = A_[d][mt][e] * P; }
            const int sq = d ? 3 - fq : fq;
            {   const int src1 = d ? lane + 16 : lane - 16; const float Pp = __shfl(P, src1 & 63), Hp = __shfl(H, src1 & 63);
                if (sq >= 1) { H = P * Hp + H; P = P * Pp; } }
            {   const int src2 = d ? lane + 32 : lane - 32; const float Pp = __shfl(P, src2 & 63), Hp = __shfl(H, src2 & 63);
                if (sq >= 2) { H = P * Hp + H; P = P * Pp; } }
            const int lastl = d ? fr : 48 + fr; const float TP = __shfl(P, lastl), TH = __shfl(H, lastl);
            if (MODE == 1) {
                const int srcx = d ? lane + 16 : lane - 16; float EP = __shfl(P, srcx & 63), EH = __shfl(H, srcx & 63);
                if (sq == 0) { EP = 1.0f; EH = 0.0f; }
                float h = R_P * hin + R_H; h = EP * h + EH;
#pragma unroll
                for (int e_ = 0; e_ < 4; ++e_) { const int e = d ? 3 - e_ : e_; h = A_[d][mt][e] * h + B_[d][mt][e]; hs[mt][e] = (d == 0) ? h : hs[mt][e] + h; }
                if (!ti.sample) {
                    if (d == 0 && mt == 3 && fq == 3 && tile == ti.tile0 + ti.ntile - 1) p.out[OUT_LRU + ti.b * 1024 + ch] = h;
                    if (d == 1 && mt == 0 && fq == 0 && tile == ti.tile0) p.out[OUT_LRU + ti.b * 1024 + 512 + ch] = h; }
            }
            R_H = TP * R_H + TH; R_P = TP * R_P;
        }
        if (MODE == 0) { if (fq == 0) { float* car = (float*)(p.ws + WS_CAR) + (size_t)((tile * 8 + j) * 2 + d) * 128 + 16 * nt + fr; car[0] = R_P; car[64] = R_H; } }
    }
    if (MODE == 1) {
        bf16_t* Y = (bf16_t*)(p.ws + WS_ACT);
#pragma unroll
        for (int mt = 0; mt < 4; ++mt)
#pragma unroll
            for (int e = 0; e < 4; ++e) { const float x = bf2f(gbt[(16 * mt + 4 * fq + e) * 72 + 16 * nt + fr]);
                const float ge = 0.5f * x * (1.0f + tanhf_(0.7978845608028654f * (x + 0.044715f * x * x * x)));
                Y[(size_t)(ti.row0 + 16 * mt + 4 * fq + e) * DM + 512 + ch] = f2bf(hs[mt][e] * ge); }
    }
}

constexpr int LW_WT = 2 * LW_HALF, LW_CP = LW_WT + 4 * 64 * 72 * 2;
template <int MODE>
__device__ __forceinline__ void lru_phase(const Params& p, unsigned char* shm, int j, int tile0, int tstride, int ntiles_total) {
    const int tid = threadIdx.x, ht = tid & 255, half = tid >> 8, lane = tid & 63, nt = ht >> 6, fr = lane & 15;
    unsigned char* lh = shm + half * LW_HALF;
    bf16_t* wt = (bf16_t*)(shm + LW_WT); float* cp = (float*)(shm + LW_CP);
    for (int e = tid; e < 4 * 64 * 8; e += 512) { const int o = e >> 9, n = (e >> 3) & 63, k8 = e & 7;
        const u32x4 w = *(const u32x4*)((const bf16_t*)(p.ws + ((o & 1) ? WS_WXT : WS_WAT)) + (size_t)(((o >> 1) * 8 + j) * 64 + n) * 64 + 8 * k8);
        *(u32x4*)(wt + (o * 64 + n) * 72 + 8 * k8) = w; }
    if (tid < 320) { const int idx = tid >> 6, c = tid & 63; cp[tid] = (idx < 4) ? p.in[23][idx * 512 + 64 * j + c] : p.in[24][64 * j + c]; }
    float pba[2], pbx[2], pc8[2];
    {   const int ch = 64 * j + 16 * nt + fr;
#pragma unroll
        for (int d = 0; d < 2; ++d) { pba[d] = p.in[26][d * 512 + ch]; pbx[d] = p.in[28][d * 512 + ch]; pc8[d] = -8.0f * softplusf_(-p.in[29][d * 512 + ch]); } }
    const int nmax = (ntiles_total + 1) / 2, n = (ntiles_total - half + 1) / 2;
    LruPre pre;
    if (n > 0) { const TileInfo ti = tile_info(tile0 + half * tstride); lru_load_x<MODE>(p, ti, j, ht, pre); }
    __syncthreads();
    for (int i = 0; i < nmax; ++i) {
        if (i < n) { const int tile = tile0 + (2 * i + half) * tstride; const TileInfo ti = tile_info(tile);
            lru_wave_item<MODE>(p, lh, wt, cp, pba, pbx, pc8, tile, j, ti, pre, ht, (i + 1 < n) ? tile + 2 * tstride : -1, i & 1); }
        else { __syncthreads(); __syncthreads(); } }
}

__device__ __forceinline__ void phase_prep(const Params& p, unsigned char* shm) {
    const int tid = threadIdx.x, wid = tid >> 6, lane = tid & 63;
    const bf16_t* Z = (const bf16_t*)(p.ws + WS_Z);
    float* O = (float*)(shm + LO_O);
    bf16_t* XW = (bf16_t*)(shm + LO_XA); bf16_t* XA = XW + 64 * 136; bf16_t* XG = XA + 64 * 136;
    bf16_t* SCAN = (bf16_t*)p.out;
    {
    const int h = blockIdx.x & 7, nbj = gridDim.x >> 3;
    bf16x8 bw[2][2], ba[2][2], bg[4];
    {   const int fr = lane & 15, fq = lane >> 4, nt = wid & 3;
#pragma unroll
        for (int d = 0; d < 2; ++d)
#pragma unroll
            for (int k2 = 0; k2 < 2; ++k2) { const size_t o = (size_t)(d * 512 + h * 64 + 16 * nt + fr) * 64 + 32 * k2 + 8 * fq;
                bw[d][k2] = *(const bf16x8*)((const bf16_t*)(p.ws + WS_WUPT) + o); ba[d][k2] = *(const bf16x8*)((const bf16_t*)(p.ws + WS_AUPT) + o); }
#pragma unroll
        for (int k4 = 0; k4 < 4; ++k4) bg[k4] = *(const bf16x8*)((const bf16_t*)(p.ws + WS_GUPT) + (size_t)(h * 64 + 16 * nt + fr) * 128 + 32 * k4 + 8 * fq); }
    float* PR = (float*)(shm + LO_PRM);
    if (tid < 448) { const int idx = tid >> 6, c = tid & 63, hc = h * 64 + c;
        PR[tid] = (idx < 2) ? p.in[13][idx * 512 + hc] : (idx < 4) ? p.in[15][(idx - 2) * 512 + hc] : (idx == 4) ? p.in[18][hc] : (idx == 5) ? p.in[19][hc] : p.in[20][hc]; }
    u32x4 nx[8];
    {   const int tile = blockIdx.x >> 3;
        if (tile < NTILE) { const int t = tid >> 3, seg = tid & 7; const size_t zr = (size_t)(tile * 64 + t) * DIN;
#pragma unroll
            for (int hh = 0; hh < 2; ++hh) { const int c0 = seg * 16 + hh * 8; nx[hh] = *(const u32x4*)(Z + zr + ZXW + c0); nx[2 + hh] = *(const u32x4*)(Z + zr + ZXA + c0); nx[4 + hh] = *(const u32x4*)(Z + zr + ZXG + c0); }
            nx[6] = *(const u32x4*)(Z + zr + h * 64 + 8 * seg + ZR); nx[7] = *(const u32x4*)(Z + zr + h * 64 + 8 * seg + ZK); } }
    __syncthreads();
    for (int tile = blockIdx.x >> 3; tile < NTILE; tile += nbj) {
        const TileInfo ti = tile_info(tile);
        u32x4 cx[8];
#pragma unroll
        for (int i = 0; i < 8; ++i) cx[i] = nx[i];
        if (tile + nbj < NTILE) { const int t = tid >> 3, seg = tid & 7; const size_t zr = (size_t)((tile + nbj) * 64 + t) * DIN;
#pragma unroll
            for (int hh = 0; hh < 2; ++hh) { const int c0 = seg * 16 + hh * 8; nx[hh] = *(const u32x4*)(Z + zr + ZXW + c0); nx[2 + hh] = *(const u32x4*)(Z + zr + ZXA + c0); nx[4 + hh] = *(const u32x4*)(Z + zr + ZXG + c0); }
            nx[6] = *(const u32x4*)(Z + zr + h * 64 + 8 * seg + ZR); nx[7] = *(const u32x4*)(Z + zr + h * 64 + 8 * seg + ZK); }
        {   const int t = tid >> 3, seg = tid & 7; float f[8];
#pragma unroll
            for (int hh = 0; hh < 2; ++hh) { const int c0 = seg * 16 + hh * 8;
                *(u32x4*)(XW + t * 136 + c0) = cx[hh]; *(u32x4*)(XA + t * 136 + c0) = cx[2 + hh]; *(u32x4*)(XG + t * 136 + c0) = cx[4 + hh]; } }
        __syncthreads();
        {   const int fr = lane & 15, fq = lane >> 4, nt = wid & 3, mtb = 2 * (wid >> 2);
#pragma unroll
            for (int mi = 0; mi < 2; ++mi) { const int mt = mtb + mi; const bf16_t* ar = XW + (16 * mt + fr) * 136 + 8 * fq;
#pragma unroll
                for (int d = 0; d < 2; ++d) { f32x4 aw = {0.f, 0.f, 0.f, 0.f}, aa = aw;
#pragma unroll
                    for (int k2 = 0; k2 < 2; ++k2) { aw = __builtin_amdgcn_mfma_f32_16x16x32_bf16(*(const bf16x8*)(ar + d * 64 + 32 * k2), bw[d][k2], aw, 0, 0, 0);
                        aa = __builtin_amdgcn_mfma_f32_16x16x32_bf16(*(const bf16x8*)(ar + 64 * 136 + d * 64 + 32 * k2), ba[d][k2], aa, 0, 0, 0); }
#pragma unroll
                    for (int i = 0; i < 4; ++i) { O[(d * 64 + 16 * mt + 4 * fq + i) * 68 + 16 * nt + fr] = aw[i]; O[((2 + d) * 64 + 16 * mt + 4 * fq + i) * 68 + 16 * nt + fr] = aa[i]; } }
                f32x4 ag = {0.f, 0.f, 0.f, 0.f};
#pragma unroll
                for (int k4 = 0; k4 < 4; ++k4) ag = __builtin_amdgcn_mfma_f32_16x16x32_bf16(*(const bf16x8*)(ar + 2 * 64 * 136 + 32 * k4), bg[k4], ag, 0, 0, 0);
#pragma unroll
                for (int i = 0; i < 4; ++i) O[(4 * 64 + 16 * mt + 4 * fq + i) * 68 + 16 * nt + fr] = ag[i]; } }
        __syncthreads();
        {   const int t = tid >> 3, cs = tid & 7, row = ti.row0 + t; const size_t zr = (size_t)row * DIN + h * 64 + 8 * cs;
            float ss = 0.f;
            float kaw[8], rkw[8];
            {   float k[8], kkw[8]; unpack8(cx[7], k);
                *(f32x4*)kkw = *(const f32x4*)(PR + 4 * 64 + 8 * cs); *(f32x4*)(kkw + 4) = *(const f32x4*)(PR + 4 * 64 + 8 * cs + 4);
                *(f32x4*)kaw = *(const f32x4*)(PR + 5 * 64 + 8 * cs); *(f32x4*)(kaw + 4) = *(const f32x4*)(PR + 5 * 64 + 8 * cs + 4);
                *(f32x4*)rkw = *(const f32x4*)(PR + 6 * 64 + 8 * cs); *(f32x4*)(rkw + 4) = *(const f32x4*)(PR + 6 * 64 + 8 * cs + 4);
#pragma unroll
                for (int q = 0; q < 8; ++q) { const float kk = k[q] * kkw[q]; ss += kk * kk; } }
            ss = sum8(ss);
            const float inv = __builtin_amdgcn_rcpf(fmaxf(__builtin_amdgcn_sqrtf(ss), 1e-12f));
            float bs = 0.f;
            float rf[8], kf[8]; unpack8(cx[6], rf); unpack8(cx[7], kf);
#pragma unroll 1
            for (int d = 0; d < 2; ++d) {
                bf16_t* sp = SCAN + ((size_t)(d * NTOK + row) * 8 + h) * 128 + 8 * cs;
                float oa[8], ow[8], pa[8], pw[8];
                *(f32x4*)oa = *(const f32x4*)(O + ((2 + d) * 64 + t) * 68 + 8 * cs); *(f32x4*)(oa + 4) = *(const f32x4*)(O + ((2 + d) * 64 + t) * 68 + 8 * cs + 4);
                *(f32x4*)ow = *(const f32x4*)(O + (d * 64 + t) * 68 + 8 * cs); *(f32x4*)(ow + 4) = *(const f32x4*)(O + (d * 64 + t) * 68 + 8 * cs + 4);
                *(f32x4*)pa = *(const f32x4*)(PR + (2 + d) * 64 + 8 * cs); *(f32x4*)(pa + 4) = *(const f32x4*)(PR + (2 + d) * 64 + 8 * cs + 4);
                *(f32x4*)pw = *(const f32x4*)(PR + d * 64 + 8 * cs); *(f32x4*)(pw + 4) = *(const f32x4*)(PR + d * 64 + 8 * cs + 4);
                float lw[8], aa[8];
#pragma unroll
                for (int q = 0; q < 8; ++q) { const float a = sigmoidf_(pa[q] + oa[q]);
                    bs += rf[q] * (kf[q] * (1.0f + (a - 1.0f) * kaw[q])) * rkw[q];
                    lw[q] = -0.60653065971f * sigmoidf_(pw[q] + ow[q]);
                    aa[q] = a; }
                *(u32x4*)sp = pack8(lw); *(u32x4*)(sp + 64) = pack8(aa); }
            bs = sum8(bs);
            if (cs == 0) { ((float*)(p.ws + WS_INV))[row * 8 + h] = inv; ((float*)(p.ws + WS_BON))[row * 8 + h] = bs; }
            float g[8];
            *(f32x4*)g = *(const f32x4*)(O + (4 * 64 + t) * 68 + 8 * cs); *(f32x4*)(g + 4) = *(const f32x4*)(O + (4 * 64 + t) * 68 + 8 * cs + 4);
            *(u32x4*)((bf16_t*)(p.ws + WS_G) + (size_t)row * 512 + h * 64 + 8 * cs) = pack8(g); }
    }
    __syncthreads();
    }
    {   const int G = gridDim.x, bid = blockIdx.x, nbj = G >> 3, t0 = bid >> 3;
        const int ntl = (t0 < NTILE) ? (NTILE - t0 + nbj - 1) / nbj : 0;
        lru_phase<0>(p, shm, bid & 7, t0, nbj, ntl); }
}

constexpr int CB_A = 0, CB_R = 2304, CB_BT = 4608, CB_KT = 6656, CB_VT = 8704, CB_T = 10752, CB_TK = 11264, CB_MT = 11776, CB_MK = 12288, CB_G = 12800, CB_BYTES = 13056;
constexpr int PS_B = 0, PS_K = 2304, PS_M = 4608  , PS_BYTES = 6144;
constexpr int LO_CB = 0, LO_PS = 8 * CB_BYTES;

__device__ __forceinline__ void wsync() { __builtin_amdgcn_wave_barrier(); asm volatile("s_waitcnt lgkmcnt(0)" ::: "memory"); __builtin_amdgcn_wave_barrier(); }
__device__ __forceinline__ bf16x8 mk8(unsigned a, unsigned b, unsigned c, unsigned d) { u32x4 w; w.x = a; w.y = b; w.z = c; w.w = d; return __builtin_bit_cast(bf16x8, w); }

__device__ __forceinline__ void produce_chunk(const Params& p, unsigned char* cb, unsigned char* ps, int seqrow0, int T, int d, int h, int tau0, int lane) {
    const bf16_t* Z = (const bf16_t*)(p.ws + WS_Z); const bf16_t* SCAN = (const bf16_t*)p.out; const float* INV = (const float*)(p.ws + WS_INV);
    bf16_t* At = (bf16_t*)(cb + CB_A); bf16_t* Rt = (bf16_t*)(cb + CB_R); bf16_t* Bs = (bf16_t*)(ps + PS_B); bf16_t* Ks = (bf16_t*)(ps + PS_K);
    const int k = lane, hc = h * 64 + k;
    const float kkw = p.in[18][hc], kaw = p.in[19][hc];
    float beta[16], kdv[16], cums[16]; unsigned short vraw[16], lwr[16], asr[16], rrw[16], krw[16]; float invv[16];
    float cum = 0.f, e_last = 1.0f;
#pragma unroll
    for (int i = 0; i < 16; ++i) {
        const int tau = tau0 + i, row = seqrow0 + (d ? T - 1 - tau : tau);
        const bf16_t* sp = SCAN + ((size_t)(d * NTOK + row) * 8 + h) * 128;
        const bf16_t* zr = Z + (size_t)row * DIN + h * 64 + k;
        lwr[i] = sp[k]; asr[i] = sp[64 + k]; rrw[i] = zr[ZR]; krw[i] = zr[ZK]; vraw[i] = zr[ZV]; invv[i] = INV[row * 8 + h];
    }
    __builtin_amdgcn_sched_barrier(0);
#pragma unroll
    for (int i = 0; i < 16; ++i) {
        const float lw = bf2f(lwr[i]), as = bf2f(asr[i]), r = bf2f(rrw[i]), kr = bf2f(krw[i]);
        const float kk = kr * kkw * invv[i], be = kk * as, kd = kr * (1.0f + (as - 1.0f) * kaw);
        const float e_prev = e_last; cum += lw; const float e_i = __expf(cum), e_neg = __builtin_amdgcn_rcpf(e_i); e_last = e_i;
        At[i * 72 + k] = f2bf(-kk * e_prev); Rt[i * 72 + k] = f2bf(r * e_i); Bs[i * 72 + k] = f2bf(be * e_neg); Ks[i * 72 + k] = f2bf(kd * e_neg);
        beta[i] = be * e_neg; kdv[i] = kd * e_neg; cums[i] = cum;
    }
    const float gam = e_last; ((float*)(cb + CB_G))[k] = gam;
    {   unsigned wb[8], wk[8], wv[8];
#pragma unroll
        for (int i = 0; i < 16; i += 2) {
            wb[i >> 1] = pk2(beta[i] * gam, beta[i + 1] * gam); wk[i >> 1] = pk2(kdv[i] * gam, kdv[i + 1] * gam); wv[i >> 1] = (unsigned)vraw[i] | ((unsigned)vraw[i + 1] << 16); }
        u32x4* bt = (u32x4*)(cb + CB_BT + k * 32); u32x4* kt = (u32x4*)(cb + CB_KT + k * 32); u32x4* vt = (u32x4*)(cb + CB_VT + k * 32);
        u32x4 w; w.x = wb[0]; w.y = wb[1]; w.z = wb[2]; w.w = wb[3]; bt[0] = w; w.x = wb[4]; w.y = wb[5]; w.z = wb[6]; w.w = wb[7]; bt[1] = w;
        w.x = wk[0]; w.y = wk[1]; w.z = wk[2]; w.w = wk[3]; kt[0] = w; w.x = wk[4]; w.y = wk[5]; w.z = wk[6]; w.w = wk[7]; kt[1] = w;
        w.x = wv[0]; w.y = wv[1]; w.z = wv[2]; w.w = wv[3]; vt[0] = w; w.x = wv[4]; w.y = wv[5]; w.z = wv[6]; w.w = wv[7]; vt[1] = w; }
    wsync();
    const int fr = lane & 15, fq = lane >> 4;
    {   f32x4 lab = {0.f, 0.f, 0.f, 0.f}, lak = lab, mrb = lab, mrk = lab;
#pragma unroll
        for (int m = 0; m < 2; ++m) {
            const bf16x8 aA = *(const bf16x8*)(At + fr * 72 + 32 * m + 8 * fq), aR = *(const bf16x8*)(Rt + fr * 72 + 32 * m + 8 * fq);
            const bf16x8 bB = *(const bf16x8*)(Bs + fr * 72 + 32 * m + 8 * fq), bK = *(const bf16x8*)(Ks + fr * 72 + 32 * m + 8 * fq);
            lab = __builtin_amdgcn_mfma_f32_16x16x32_bf16(aA, bB, lab, 0, 0, 0); lak = __builtin_amdgcn_mfma_f32_16x16x32_bf16(aA, bK, lak, 0, 0, 0);
            mrb = __builtin_amdgcn_mfma_f32_16x16x32_bf16(aR, bB, mrb, 0, 0, 0); mrk = __builtin_amdgcn_mfma_f32_16x16x32_bf16(aR, bK, mrk, 0, 0, 0); }
        bf16_t* oLK = (bf16_t*)(cb + CB_TK); bf16_t* oMB = (bf16_t*)(cb + CB_MT); bf16_t* oMK = (bf16_t*)(cb + CB_MK);
#pragma unroll
        for (int e = 0; e < 4; ++e) { const int i = 4 * fq + e, j = fr;
            oLK[i * 16 + j] = f2bf((j < i) ? lak[e] : 0.f); oMB[i * 16 + j] = f2bf((j <= i) ? mrb[e] : 0.f); oMK[i * 16 + j] = f2bf((j <= i) ? mrk[e] : 0.f); }
        float* Lab = (float*)(ps + PS_M);
#pragma unroll
        for (int e = 0; e < 4; ++e) Lab[(4 * fq + e) * 20 + fr] = lab[e];
        wsync();
        f32x4 Lr[16][4];
#pragma unroll
        for (int i = 1; i < 16; ++i)
#pragma unroll
            for (int j4 = 0; j4 < (i + 3) / 4; ++j4) Lr[i][j4] = *(const f32x4*)(Lab + i * 20 + 4 * j4);
        __builtin_amdgcn_sched_barrier(0);
        float Tc[16];
#pragma unroll
        for (int i = 0; i < 16; ++i) { float sacc = (i == fr) ? 1.0f : 0.0f;
#pragma unroll
            for (int j4 = 0; j4 < (i + 3) / 4; ++j4) {
#pragma unroll
                for (int e = 0; e < 4; ++e) if (4 * j4 + e < i) sacc += Lr[i][j4][e] * Tc[4 * j4 + e]; }
            Tc[i] = sacc; }
        bf16_t* oT = (bf16_t*)(cb + CB_T);
        if (fq == 0) {
#pragma unroll
            for (int i = 0; i < 16; ++i) oT[i * 16 + fr] = f2bf(Tc[i]); } }
}

__device__ __forceinline__ void consume_chunk(const unsigned char* cb, int vt, int lane, f32x4 (&S)[4], bf16_t* ybase  , int seqrow0, int T, int d, int tau0) {
    const int fr = lane & 15, fq = lane >> 4;
    const bf16_t* At = (const bf16_t*)(cb + CB_A); const bf16_t* Rt = (const bf16_t*)(cb + CB_R);
    const bf16x8 bS0 = mk8(pg8::cvt_pk_bf16(S[0][0], S[0][1]), pg8::cvt_pk_bf16(S[0][2], S[0][3]), pg8::cvt_pk_bf16(S[1][0], S[1][1]), pg8::cvt_pk_bf16(S[1][2], S[1][3]));
    const bf16x8 bS1 = mk8(pg8::cvt_pk_bf16(S[2][0], S[2][1]), pg8::cvt_pk_bf16(S[2][2], S[2][3]), pg8::cvt_pk_bf16(S[3][0], S[3][1]), pg8::cvt_pk_bf16(S[3][2], S[3][3]));
    const u32x2 a00 = *(const u32x2*)(At + fr * 72 + 4 * fq), a01 = *(const u32x2*)(At + fr * 72 + 16 + 4 * fq), a10 = *(const u32x2*)(At + fr * 72 + 32 + 4 * fq), a11 = *(const u32x2*)(At + fr * 72 + 48 + 4 * fq);
    const u32x2 r00 = *(const u32x2*)(Rt + fr * 72 + 4 * fq), r01 = *(const u32x2*)(Rt + fr * 72 + 16 + 4 * fq), r10 = *(const u32x2*)(Rt + fr * 72 + 32 + 4 * fq), r11 = *(const u32x2*)(Rt + fr * 72 + 48 + 4 * fq);
    const f32x4 zero = {0.f, 0.f, 0.f, 0.f};
    f32x4 A0 = __builtin_amdgcn_mfma_f32_16x16x32_bf16(mk8(a00.x, a00.y, a01.x, a01.y), bS0, zero, 0, 0, 0);
    A0 = __builtin_amdgcn_mfma_f32_16x16x32_bf16(mk8(a10.x, a10.y, a11.x, a11.y), bS1, A0, 0, 0, 0);
    f32x4 Y = __builtin_amdgcn_mfma_f32_16x16x32_bf16(mk8(r00.x, r00.y, r01.x, r01.y), bS0, zero, 0, 0, 0);
    Y = __builtin_amdgcn_mfma_f32_16x16x32_bf16(mk8(r10.x, r10.y, r11.x, r11.y), bS1, Y, 0, 0, 0);
    const u32x2 vf = *(const u32x2*)(cb + CB_VT + (16 * vt + fr) * 32 + 8 * fq);
    const u32x2 tt = *(const u32x2*)(cb + CB_T + fr * 32 + 8 * fq), lk = *(const u32x2*)(cb + CB_TK + fr * 32 + 8 * fq);
    const u32x2 mb = *(const u32x2*)(cb + CB_MT + fr * 32 + 8 * fq), mk = *(const u32x2*)(cb + CB_MK + fr * 32 + 8 * fq);
    const bf16x8 bAV = mk8(pg8::cvt_pk_bf16(A0[0], A0[1]), pg8::cvt_pk_bf16(A0[2], A0[3]), vf.x, vf.y);
    const f32x4 X = __builtin_amdgcn_mfma_f32_16x16x32_bf16(mk8(0u, 0u, lk.x, lk.y), bAV, A0, 0, 0, 0);
    const bf16x8 bXV = mk8(pg8::cvt_pk_bf16(X[0], X[1]), pg8::cvt_pk_bf16(X[2], X[3]), vf.x, vf.y);
    const f32x4 U = __builtin_amdgcn_mfma_f32_16x16x32_bf16(mk8(tt.x, tt.y, 0u, 0u), bXV, zero, 0, 0, 0);
    const bf16x8 bUV = mk8(pg8::cvt_pk_bf16(U[0], U[1]), pg8::cvt_pk_bf16(U[2], U[3]), vf.x, vf.y);
    Y = __builtin_amdgcn_mfma_f32_16x16x32_bf16(mk8(mb.x, mb.y, mk.x, mk.y), bUV, Y, 0, 0, 0);
#pragma unroll
    for (int kt = 0; kt < 4; ++kt) {
        const f32x4 g4 = *(const f32x4*)(cb + CB_G + (16 * kt + 4 * fq) * 4);
        const u32x2 bf = *(const u32x2*)(cb + CB_BT + (16 * kt + fr) * 32 + 8 * fq), kf = *(const u32x2*)(cb + CB_KT + (16 * kt + fr) * 32 + 8 * fq);
        S[kt] = __builtin_amdgcn_mfma_f32_16x16x32_bf16(mk8(bf.x, bf.y, kf.x, kf.y), bUV, S[kt] * g4, 0, 0, 0); }
#pragma unroll
    for (int e = 0; e < 4; ++e) { const int tau = tau0 + 4 * fq + e, row = seqrow0 + (d ? T - 1 - tau : tau); ybase[(size_t)row * 512] = f2bf(Y[e]); }
}

__device__ __forceinline__ void rwkv_scan_item(const Params& p, unsigned char* shm, int item) {
    const int tid = threadIdx.x, wid = tid >> 6, lane = tid & 63, fr = lane & 15, fq = lane >> 4;
    int sample, b, h, d;
    if (item < 128) { sample = 1; b = item >> 4; h = (item >> 1) & 7; d = item & 1; }
    else { const int ii = item - 128; sample = 0; b = ii >> 4; h = (ii >> 1) & 7; d = ii & 1; }
    const int T = sample ? 2048 : 256, seqrow0 = sample ? NPR + b * 2048 : b * 256, nsc = T / 64;
    const bool consumer = wid < 4; const int vt = wid & 3;
    f32x4 S[4];
    if (consumer) {
        if (sample) { const float* s0 = p.in[3] + ((size_t)((b * 2 + d) * 8 + h)) * 4096 + (16 * vt + fr) * 64 + 4 * fq;
#pragma unroll
            for (int kt = 0; kt < 4; ++kt) S[kt] = *(const f32x4*)(s0 + 16 * kt); }
        else {
#pragma unroll
            for (int kt = 0; kt < 4; ++kt) S[kt] = (f32x4){0.f, 0.f, 0.f, 0.f}; }
    }
    bf16_t* ybase = (bf16_t*)(p.ws + WS_YA) + (size_t)d * NTOK * 512 + h * 64 + 16 * vt + fr;
    for (int s = 0; s < nsc / 2; ++s) {
        produce_chunk(p, shm + LO_CB + wid * CB_BYTES, shm + LO_PS + wid * PS_BYTES, seqrow0, T, d, h, s * 128 + wid * 16, lane);
        __syncthreads();
        if (consumer) {
#pragma unroll 2
            for (int c = 0; c < 8; ++c) consume_chunk(shm + LO_CB + c * CB_BYTES, vt, lane, S, ybase, seqrow0, T, d, s * 128 + c * 16);
        }
        __syncthreads();
    }
    if (consumer && !sample) { float* so = p.out + OUT_RWKV + ((size_t)((b * 2 + d) * 8 + h)) * 4096 + (16 * vt + fr) * 64 + 4 * fq;
#pragma unroll
        for (int kt = 0; kt < 4; ++kt) *(f32x4*)(so + 16 * kt) = S[kt]; }
    __syncthreads();
}

__device__ __forceinline__ void phase_scan(const Params& p, unsigned char* shm) {
    const int bid = blockIdx.x, G = gridDim.x;
    if (G == 256) { if (bid < 128) rwkv_scan_item(p, shm, bid); else { rwkv_scan_item(p, shm, 128 + (bid - 128) * 2); rwkv_scan_item(p, shm, 129 + (bid - 128) * 2); } }
    else for (int item = bid; item < 384; item += G) rwkv_scan_item(p, shm, item);
    {   const int nlb = G >> 1, lb = bid - (G - nlb);
        if (lb >= 0) { const int nbj = nlb >> 3, t0 = lb >> 3; const int ntl = (t0 < NTILE) ? (NTILE - t0 + nbj - 1) / nbj : 0;
            lru_phase<1>(p, shm, lb & 7, t0, nbj, ntl); } }
}

__device__ __forceinline__ void phase_combine(const Params& p) {
    const int tid = threadIdx.x, wid = tid >> 6, lane = tid & 63, h = lane >> 3;
    const bf16_t* Z = (const bf16_t*)(p.ws + WS_Z); const bf16_t* YA = (const bf16_t*)(p.ws + WS_YA); const bf16_t* G = (const bf16_t*)(p.ws + WS_G);
    const float* BON = (const float*)(p.ws + WS_BON);
    bf16_t* Y = (bf16_t*)(p.ws + WS_ACT);
    float lg[8], lb[8];
#pragma unroll
    for (int q = 0; q < 8; ++q) { lg[q] = p.in[21][8 * lane + q]; lb[q] = p.in[22][8 * lane + q]; }
    const int per16 = (NTOK / 16 + (int)gridDim.x - 1) / (int)gridDim.x;
    for (int k16 = 0; k16 < per16; ++k16) { const int t16 = blockIdx.x * per16 + k16; if (t16 >= NTOK / 16) break;
        {
            u32x4 w0[2], w1[2], wv[2], wg[2]; float bon[2];
#pragma unroll
            for (int u = 0; u < 2; ++u) { const int row = t16 * 16 + wid * 2 + u;
                w0[u] = *(const u32x4*)(YA + (size_t)row * 512 + 8 * lane); w1[u] = *(const u32x4*)(YA + (size_t)(NTOK + row) * 512 + 8 * lane);
                wv[u] = *(const u32x4*)(Z + (size_t)row * DIN + ZV + 8 * lane); wg[u] = *(const u32x4*)(G + (size_t)row * 512 + 8 * lane); bon[u] = BON[row * 8 + h]; }
#pragma unroll
            for (int u = 0; u < 2; ++u) { const int row = t16 * 16 + wid * 2 + u;
                float a[8], b[8], vv[8], g[8], o[8]; unpack8(w0[u], a); unpack8(w1[u], b); unpack8(wv[u], vv); unpack8(wg[u], g);
                float s1 = 0.f;
#pragma unroll
                for (int q = 0; q < 8; ++q) { a[q] += b[q]; s1 += a[q]; }
                s1 = sum8(s1);
                const float mu = s1 * (1.0f / 64.0f);
                float s2 = 0.f;
#pragma unroll
                for (int q = 0; q < 8; ++q) { a[q] -= mu; s2 += a[q] * a[q]; }
                s2 = sum8(s2);
                const float rstd = rsqrtf(s2 * (1.0f / 64.0f) + 64e-5f);
#pragma unroll
                for (int q = 0; q < 8; ++q) o[q] = (a[q] * rstd * lg[q] + lb[q] + bon[u] * vv[q]) * g[q];
                *(u32x4*)(Y + (size_t)row * DM + 8 * lane) = pack8(o); }
        }
    }
}

__device__ __forceinline__ void phase_res1(const Params& p, unsigned char* shm) {
    float* sm = (float*)shm;
    const int tid = threadIdx.x, wid = tid >> 6, lane = tid & 63;
    const bf16_t* O1 = (const bf16_t*)(p.ws + WS_O1); const bf16_t* O1P = (const bf16_t*)(p.ws + WS_O1P); const bool split = false; bf16_t* H = (bf16_t*)(p.ws + WS_ACT);
    const int per16 = (NTOK / 16 + (int)gridDim.x - 1) / (int)gridDim.x; int cur_mrow = -1;
    auto body = [&](auto nr_tag, int row) { constexpr int NR = decltype(nr_tag)::value;
            f32x4 o[NR][4], x1[NR][4]; float ss[NR] = {}, s2[NR] = {};
#pragma unroll
            for (int u = 0; u < NR; ++u)
#pragma unroll
                for (int i = 0; i < 4; ++i) { const int r = row + (u >> 1) * 16 + (u & 1), j = 4 * lane + 256 * i;
                    if (!split || r < 16384) { const u32x2 w = *(const u32x2*)(O1 + (size_t)r * DM + j);
                        o[u][i] = (f32x4){__uint_as_float(w.x << 16), __uint_as_float(w.x & 0xffff0000u), __uint_as_float(w.y << 16), __uint_as_float(w.y & 0xffff0000u)}; }
                    else { f32x4 a = {0.f, 0.f, 0.f, 0.f};
#pragma unroll
                        for (int pp = 0; pp < 4; ++pp) { const u32x2 w = *(const u32x2*)(O1P + ((size_t)pp * 4096 + (r - 16384)) * DM + j);
                            a += (f32x4){__uint_as_float(w.x << 16), __uint_as_float(w.x & 0xffff0000u), __uint_as_float(w.y << 16), __uint_as_float(w.y & 0xffff0000u)}; }
                        o[u][i] = a; }
                    x1[u][i] = load_x4(p, r, j); }
#pragma unroll
            for (int u = 0; u < NR; ++u)
#pragma unroll
                for (int i = 0; i < 4; ++i) ss[u] += o[u][i][0] * o[u][i][0] + o[u][i][1] * o[u][i][1] + o[u][i][2] * o[u][i][2] + o[u][i][3] * o[u][i][3];
#pragma unroll
            for (int sh = 32; sh > 0; sh >>= 1) {
#pragma unroll
                for (int u = 0; u < NR; ++u) ss[u] += __shfl_xor(ss[u], sh); }
#pragma unroll
            for (int u = 0; u < NR; ++u) { const float rstd = rsqrtf(ss[u] * (1.0f / 1024.0f) + 1e-6f);
#pragma unroll
                for (int i = 0; i < 4; ++i) { const int j = 4 * lane + 256 * i; const f32x4 g = *(const f32x4*)(p.in[9] + j);
#pragma unroll
                    for (int e = 0; e < 4; ++e) { x1[u][i][e] += sm[j + e] * (o[u][i][e] * rstd * g[e]); s2[u] += x1[u][i][e] * x1[u][i][e]; }
                    __builtin_nontemporal_store(x1[u][i], (f32x4*)(p.out + (size_t)(row + (u >> 1) * 16 + (u & 1)) * DM + j)); } }
#pragma unroll
            for (int sh = 32; sh > 0; sh >>= 1) {
#pragma unroll
                for (int u = 0; u < NR; ++u) s2[u] += __shfl_xor(s2[u], sh); }
#pragma unroll
            for (int u = 0; u < NR; ++u) { const float rstd2 = rsqrtf(s2[u] * (1.0f / 1024.0f) + 1e-6f);
#pragma unroll
                for (int i = 0; i < 4; ++i) { const int j = 4 * lane + 256 * i; const f32x4 g = *(const f32x4*)(p.in[10] + j); float h[4];
#pragma unroll
                    for (int e = 0; e < 4; ++e) h[e] = x1[u][i][e] * rstd2 * g[e] * (1.0f + sm[2048 + j + e]) + sm[1024 + j + e];
                    u32x2 w; w.x = pk2(h[0], h[1]); w.y = pk2(h[2], h[3]);
                    __builtin_nontemporal_store(w, (u32x2*)(H + (size_t)(row + (u >> 1) * 16 + (u & 1)) * DM + j)); } }
    };
    for (int k16 = 0; k16 < per16; ) {
        const int t16 = blockIdx.x * per16 + k16; if (t16 >= NTOK / 16) break;
        const int row = t16 * 16 + wid * 2, mrow = (t16 * 16 < NPR) ? 8 : ((t16 * 16 - NPR) >> 11);
        if (mrow != cur_mrow) { __syncthreads(); { float mv[6];
#pragma unroll
            for (int q = 0; q < 6; ++q) mv[q] = ((const float*)(p.ws + WS_MODF))[mrow * 6144 + 2048 + tid + 512 * q];
#pragma unroll
            for (int q = 0; q < 6; ++q) sm[tid + 512 * q] = mv[q]; } __syncthreads(); cur_mrow = mrow; }
        const int t16b = t16 + 1; const bool pair = (k16 + 1 < per16) && (t16b < NTOK / 16) && (((t16b * 16 < NPR) ? 8 : ((t16b * 16 - NPR) >> 11)) == mrow);
        if (pair) { body(std::integral_constant<int, 4>{}, row); k16 += 2; } else { body(std::integral_constant<int, 2>{}, row); k16 += 1; }
    }
    __syncthreads();
}

__device__ __forceinline__ void phase_final(const Params& p, unsigned char* shm) {
    float* sm = (float*)shm;
    const int tid = threadIdx.x, wid = tid >> 6, lane = tid & 63;
    const bf16_t* O2 = (const bf16_t*)(p.ws + WS_O2); const bf16_t* O2P = (const bf16_t*)(p.ws + WS_O2P); const bool split = (gridDim.x == 256);
    const int per16 = (NTOK / 16 + (int)gridDim.x - 1) / (int)gridDim.x; int cur_mrow = -1;
    auto body = [&](auto nr_tag, int row) { constexpr int NR = decltype(nr_tag)::value;
            f32x4 o[NR][4], x1[NR][4]; float ss[NR] = {};
#pragma unroll
            for (int u = 0; u < NR; ++u)
#pragma unroll
                for (int i = 0; i < 4; ++i) { const int r = row + (u >> 1) * 16 + (u & 1), j = 4 * lane + 256 * i;
                    if (!split || r < 16384) { const u32x2 w = *(const u32x2*)(O2 + (size_t)r * DM + j);
                        o[u][i] = (f32x4){__uint_as_float(w.x << 16), __uint_as_float(w.x & 0xffff0000u), __uint_as_float(w.y << 16), __uint_as_float(w.y & 0xffff0000u)}; }
                    else { f32x4 a = {0.f, 0.f, 0.f, 0.f};
#pragma unroll
                        for (int pp = 0; pp < 4; ++pp) { const u32x2 w = *(const u32x2*)(O2P + ((size_t)pp * 4096 + (r - 16384)) * DM + j);
                            a += (f32x4){__uint_as_float(w.x << 16), __uint_as_float(w.x & 0xffff0000u), __uint_as_float(w.y << 16), __uint_as_float(w.y & 0xffff0000u)}; }
                        o[u][i] = a; }
                    x1[u][i] = *(const f32x4*)(p.out + (size_t)r * DM + j); }
#pragma unroll
            for (int u = 0; u < NR; ++u)
#pragma unroll
                for (int i = 0; i < 4; ++i) ss[u] += o[u][i][0] * o[u][i][0] + o[u][i][1] * o[u][i][1] + o[u][i][2] * o[u][i][2] + o[u][i][3] * o[u][i][3];
#pragma unroll
            for (int sh = 32; sh > 0; sh >>= 1) {
#pragma unroll
                for (int u = 0; u < NR; ++u) ss[u] += __shfl_xor(ss[u], sh); }
#pragma unroll
            for (int u = 0; u < NR; ++u) { const float rstd = rsqrtf(ss[u] * (1.0f / 1024.0f) + 1e-6f);
#pragma unroll
                for (int i = 0; i < 4; ++i) { const int j = 4 * lane + 256 * i; const f32x4 g = *(const f32x4*)(p.in[11] + j);
#pragma unroll
                    for (int e = 0; e < 4; ++e) x1[u][i][e] += sm[j + e] * (o[u][i][e] * rstd * g[e]);
                    __builtin_nontemporal_store(x1[u][i], (f32x4*)(p.out + (size_t)(row + (u >> 1) * 16 + (u & 1)) * DM + j)); } }
    };
    for (int k16 = 0; k16 < per16; ) {
        const int t16 = blockIdx.x * per16 + k16; if (t16 >= NTOK / 16) break;
        const int row = t16 * 16 + wid * 2, mrow = (t16 * 16 < NPR) ? 8 : ((t16 * 16 - NPR) >> 11);
        if (mrow != cur_mrow) { __syncthreads(); { float mv[2];
#pragma unroll
            for (int q = 0; q < 2; ++q) mv[q] = ((const float*)(p.ws + WS_MODF))[mrow * 6144 + 5120 + tid + 512 * q];
#pragma unroll
            for (int q = 0; q < 2; ++q) sm[tid + 512 * q] = mv[q]; } __syncthreads(); cur_mrow = mrow; }
        const int t16b = t16 + 1; const bool pair = (k16 + 1 < per16) && (t16b < NTOK / 16) && (((t16b * 16 < NPR) ? 8 : ((t16b * 16 - NPR) >> 11)) == mrow);
        if (pair) { body(std::integral_constant<int, 4>{}, row); k16 += 2; } else { body(std::integral_constant<int, 2>{}, row); k16 += 1; }
    }
    __syncthreads();
}

template <class Epi>
__device__ __forceinline__ void run_gemm(unsigned char* shm, const bf16_t* A, const bf16_t* Bt, int M, int N, int K, const Epi& E) {
    pg8::Gemm g; g.A = A; g.Bt = Bt; g.M = M; g.N = N; g.K = K;
    pg8::StaticOrder S; S.init(M, N, (int)gridDim.x, (int)blockIdx.x, K);
    pg8::gemm_phase<Epi, pg8::StaticOrder>((PG8_LAS unsigned char*)shm, g, S, E);
}

template <class Epi>
__device__ __forceinline__ void run_gemm_split(unsigned char* shm, const bf16_t* A, const bf16_t* Bt, int M, int N, int K, const Epi& E) {
    pg8::Gemm g; g.A = A; g.Bt = Bt; g.M = M; g.N = N; g.K = K;
    pg8::SplitTailOrder S; S.init((int)blockIdx.x, K);
    pg8::gemm_phase<Epi, pg8::SplitTailOrder>((PG8_LAS unsigned char*)shm, g, S, E);
}

__global__ void __launch_bounds__(512, 2) fwd_megakernel(Params p, int ph_lo, int ph_hi, int coop) {
    extern __shared__ __attribute__((aligned(16))) unsigned char shm[];
    cg::grid_group grid = cg::this_grid();
    volatile LAS unsigned* xbst = (volatile LAS unsigned*)(shm + LDS_BYTES - 16);
    if (threadIdx.x == 0) { xbst[0] = 0u; xbst[1] = 0u; }
    __syncthreads();
    XcdBarrier xb = xcd_barrier_post((unsigned*)(p.ws + WS_BAR), xbst);
    if (coop == 2) grid.sync();
#ifndef PH_MASK
#define PH_MASK 0x7ff
#endif
#define PH_ON(k) ((PH_MASK & (1 << (k))) && ph_lo <= (k) && (k) < ph_hi)
#define PH_R(k) ((PH_REP >> (k)) & 1)
#define PH_SYNC(k) do { if (coop && (k) + 1 < ph_hi && ph_lo <= (k)) { xcd_barrier(xb); } } while (0)
    if (PH_ON(0)) for (int rep = 0; rep <= PH_R(0); ++rep) phase0(p, shm);
    PH_SYNC(0);
    if (PH_ON(1)) for (int rep = 0; rep <= PH_R(1); ++rep) phase_h1(p, shm);
    PH_SYNC(1);
    if (PH_ON(2)) for (int rep = 0; rep <= PH_R(2); ++rep) { EpiB16<2> E; E.O = (bf16_t*)(p.ws + WS_Z); E.ldc = DIN; E.ncols = DIN;
        run_gemm(shm, (const bf16_t*)(p.ws + WS_ACT), (const bf16_t*)(p.ws + WS_WINT), NTOK, DINP, 1024, E);
        if (gridDim.x == 256 && blockIdx.x >= 192) deferred_transposes(p, shm, 0, (int)blockIdx.x - 192, 64); }
    PH_SYNC(2);
    if (PH_ON(3)) for (int rep = 0; rep <= PH_R(3); ++rep) phase_prep(p, shm);
    PH_SYNC(3);
    if (PH_ON(4)) for (int rep = 0; rep <= PH_R(4); ++rep) phase_scan(p, shm);
    PH_SYNC(4);
    if (PH_ON(5)) for (int rep = 0; rep <= PH_R(5); ++rep) phase_combine(p);
    PH_SYNC(5);
    if (PH_ON(6)) for (int rep = 0; rep <= PH_R(6); ++rep) { EpiSplitB16 E; E.O = (bf16_t*)(p.ws + WS_O1); E.P = (bf16_t*)(p.ws + WS_O1P);
        run_gemm(shm, (const bf16_t*)(p.ws + WS_ACT), (const bf16_t*)(p.ws + WS_WOUTT), NTOK, 1024, 1024, E);
        if (gridDim.x == 256 && blockIdx.x >= 64) deferred_transposes(p, shm, 1, (int)blockIdx.x - 64, 192); }
    PH_SYNC(6);
    if (PH_ON(7)) for (int rep = 0; rep <= PH_R(7); ++rep) phase_res1(p, shm);
    PH_SYNC(7);
    if (PH_ON(8)) for (int rep = 0; rep <= PH_R(8); ++rep) { EpiB16<1> E; E.O = (bf16_t*)(p.ws + WS_F); E.ldc = DFF; E.ncols = DFF;
        run_gemm(shm, (const bf16_t*)(p.ws + WS_ACT), (const bf16_t*)(p.ws + WS_W1T), NTOK, DFF, 1024, E); }
    PH_SYNC(8);
    if (PH_ON(9)) for (int rep = 0; rep <= PH_R(9); ++rep) { EpiSplitB16 E; E.O = (bf16_t*)(p.ws + WS_O2); E.P = (bf16_t*)(p.ws + WS_O2P);
        if (gridDim.x == 256) run_gemm_split(shm, (const bf16_t*)(p.ws + WS_F), (const bf16_t*)(p.ws + WS_W2T), NTOK, 1024, DFF, E);
        else run_gemm(shm, (const bf16_t*)(p.ws + WS_F), (const bf16_t*)(p.ws + WS_W2T), NTOK, 1024, DFF, E); }
    PH_SYNC(9);
    if (PH_ON(10)) phase_final(p, shm);
}
}

extern "C" void kernel_launch(void* const* d_in, const int* in_sizes, int n_in, void* d_out, int out_size, void* d_ws, size_t ws_size, hipStream_t stream) {
    static int grid_blocks = 0;
    if (grid_blocks == 0) {
        int dev = 0, cus = 0, per_cu = 0;
        hipGetDevice(&dev);
        hipDeviceGetAttribute(&cus, hipDeviceAttributeMultiprocessorCount, dev);
        if (hipFuncSetAttribute((const void*)fwd_megakernel, hipFuncAttributeMaxDynamicSharedMemorySize, LDS_BYTES) != hipSuccess) { fprintf(stderr, "hipFuncSetAttribute failed\n"); }
        if (hipOccupancyMaxActiveBlocksPerMultiprocessor(&per_cu, (const void*)fwd_megakernel, 512, LDS_BYTES) != hipSuccess || per_cu < 1) { fprintf(stderr, "occupancy query: %d\n", per_cu); per_cu = 1; }
        (void)hipGetLastError();
        grid_blocks = cus * per_cu;
        if (n_in != 33 || ws_size < 256 * MiB) fprintf(stderr, "unexpected n_in %d / ws_size %zu\n", n_in, ws_size);
    }
    Params p{};
    for (int i = 0; i < 33; ++i) p.in[i] = (const float*)d_in[i];
    p.out = (float*)d_out; p.ws = (unsigned char*)d_ws;
#if MK_LAUNCHES == 1
    (void)hipMemsetAsync((unsigned char*)d_ws + WS_BAR, 0, XCD_BAR_WORDS * sizeof(unsigned), stream);
    int lo = 0, hi = 11, coop = 1;
    void* args[] = {&p, &lo, &hi, &coop};
    hipError_t e = hipLaunchCooperativeKernel((const void*)fwd_megakernel, dim3(grid_blocks), dim3(512), args, LDS_BYTES, stream);
    if (e != hipSuccess) fprintf(stderr, "cooperative launch failed: %s (grid %d)\n", hipGetErrorString(e), grid_blocks);
#else
    for (int ph = 0; ph < 11; ++ph) for (int rep = 0; rep <= ((HOST_REP >> ph) & 1); ++rep) hipLaunchKernelGGL(fwd_megakernel, dim3(grid_blocks), dim3(512), LDS_BYTES, stream, p, ph, ph + 1, 0);
#endif
}
```

```cpp
#include <hip/hip_runtime.h>
#include <hip/hip_cooperative_groups.h>
#include <cstdio>
#include <type_traits>
namespace cg = cooperative_groups;
#ifndef PH_REP
#define PH_REP 0
#endif
#define PH_R(k) ((PH_REP >> (k)) & 1)
#ifndef HOST_REP
#define HOST_REP 0
#endif
#ifndef LRU_LO
#define LRU_LO 3
#endif
#ifndef MK_LAUNCHES
#define MK_LAUNCHES 1
#endif
namespace pg8 {
#define PG8_LAS __attribute__((address_space(3)))
typedef unsigned short bf16_t;
typedef short bf16x8 __attribute__((ext_vector_type(8)));
typedef float f32x4 __attribute__((ext_vector_type(4)));
typedef unsigned u32x4 __attribute__((ext_vector_type(4)));
constexpr int BM = 256, BK = 64, HALF = 128, HTB = HALF * BK * 2  , STAGE_BYTES = 8 * HTB, NXCD = 8, WGM = 8;

__host__ __device__ __forceinline__ int lds_byte(int r, int c) { const int st = (r >> 4) * 2 + (c >> 5), rr = r & 15, cc = c & 31, ob = rr * 64 + cc * 2; return st * 1024 + (ob ^ (((ob >> 9) & 1) << 5)); }
__host__ __device__ __forceinline__ void stage_rc(int b, int& R, int& C) { const int st = b / 1024, sb = b % 1024, swz = sb ^ (((sb >> 9) & 1) << 5); R = (st >> 1) * 16 + swz / 64; C = (st & 1) * 32 + (swz % 64) / 2; }
__host__ __device__ __forceinline__ int perm32(int rho) { const int n = rho >> 4, i = rho & 15; return 8 * (i >> 2) + 4 * n + (i & 3); }

struct Unit { int pm, pn, k0, nk, part; };
struct Gemm { const bf16_t* A; const bf16_t* Bt; int M, N, K; };

struct StaticOrder {
    int nM, nN, nwg, G, c;
    int nkt;
    __host__ __device__ void init(int M, int N, int G_, int c_, int K_) { nM = M / BM; nN = N / BM; nwg = nM * nN; G = G_; c = c_; nkt = K_ / BK; }
    __host__ __device__ bool next(int i, Unit& u) const {
        const long L = (long)i * G + c; if (L >= nwg) return false;
        int wgid = (int)L; { const int q = nwg / NXCD, r = nwg % NXCD, xcd = wgid % NXCD, off = wgid / NXCD; wgid = (xcd < r ? xcd * (q + 1) : r * (q + 1) + (xcd - r) * q) + off; }
        const int nig = WGM * nN, gid = wgid / nig, fm = gid * WGM, gsz = (nM - fm) < WGM ? (nM - fm) : WGM;
        u.pm = fm + ((wgid % nig) % gsz); u.pn = (wgid % nig) / gsz; u.k0 = 0; u.nk = nkt; u.part = -1; return true;
    }
    __device__ __forceinline__ void a_ready(const Unit&) const {}
    __device__ __forceinline__ void done(const Unit&) const {}
};
typedef __bf16 bf16v2_t __attribute__((ext_vector_type(2)));
__device__ __forceinline__ unsigned cvt_pk_bf16(float lo, float hi) { bf16v2_t v; v.x = (__bf16)lo; v.y = (__bf16)hi; return __builtin_bit_cast(unsigned, v); }
struct SplitTailOrder {
    int c, nkt;
    __host__ __device__ void init(int c_, int K_) { c = c_; nkt = K_ / BK; }
    __host__ __device__ bool next(int i, Unit& u) const {
        const int x = c & 7, idx = c >> 3;
        if (i == 0) { const int w = x * 32 + idx; u.pm = w >> 2; u.pn = w & 3; u.k0 = 0; u.nk = nkt; u.part = -1; return true; }
        if (i == 1) { const int t = x * 8 + (idx >> 2), part = idx & 3; u.pm = 64 + (t >> 2); u.pn = t & 3; u.nk = nkt / 4; u.k0 = part * (nkt / 4) * BK; u.part = part; return true; }
        return false;
    }
    __device__ __forceinline__ void a_ready(const Unit&) const {}
    __device__ __forceinline__ void done(const Unit&) const {}
};
template <class Epi, class Sched>
__device__ __forceinline__ void gemm_phase(PG8_LAS unsigned char* lds, const Gemm g, const Sched& S, const Epi& E) {
    const int tid = threadIdx.x, wid = __builtin_amdgcn_readfirstlane(tid >> 6), lane = tid & 63, wr = wid >> 2, wc = wid & 3, fr = lane & 15, fq = lane >> 4;
    const int K = g.K;
    unsigned voffA[2], voffB[2];
#pragma unroll
    for (int i = 0; i < 2; ++i) { int R, C; stage_rc(tid * 16 + i * 8192, R, C); const int Rb = Epi::PERM ? ((R & ~31) + perm32(R & 31)) : R;
        voffA[i] = (unsigned)(R * K + C) * 2u; voffB[i] = (unsigned)(Rb * K + C) * 2u; }
    const size_t kstep = (size_t)(BK * 2);
    const size_t hstep = (size_t)HALF * K * 2;
    const size_t tstep = 2 * hstep;
    const unsigned ldsw = (unsigned)wid * 1024u;
    const int aoff = lds_byte(wr * 64 + fr, fq * 8), boff = lds_byte(wc * 32 + fr, fq * 8);
#define PG8_SA(b, h) (((b) * 2 + (h)) * HTB)
#define PG8_SB(b, h) ((4 + (b) * 2 + (h)) * HTB)
#define PG8_STAGE(bufoff, gbase, voff) do { _Pragma("unroll") for (int _i = 0; _i < 2; ++_i) \
        __builtin_amdgcn_global_load_lds((const unsigned*)((const char*)(gbase) + (voff)[_i]), (PG8_LAS unsigned*)(lds + (bufoff) + ldsw + _i * 8192), 16, 0, 0); } while (0)
#define PG8_LDA(dst, b, h) do { _Pragma("unroll") for (int m = 0; m < 4; ++m) _Pragma("unroll") for (int k = 0; k < 2; ++k) dst[m][k] = *(const PG8_LAS bf16x8*)(lds + PG8_SA(b, h) + aoff + m * 2048 + k * 1024); } while (0)
#define PG8_LDB(dst, b, h) do { _Pragma("unroll") for (int n = 0; n < 2; ++n) _Pragma("unroll") for (int k = 0; k < 2; ++k) dst[n][k] = *(const PG8_LAS bf16x8*)(lds + PG8_SB(b, h) + boff + n * 2048 + k * 1024); } while (0)
#define PG8_MMA(ai, bj, At, Bt) do { __builtin_amdgcn_s_setprio(1); _Pragma("unroll") for (int m = 0; m < 4; ++m) _Pragma("unroll") for (int n = 0; n < 2; ++n) _Pragma("unroll") for (int k = 0; k < 2; ++k) \
        acc[ai][bj][m][n] = __builtin_amdgcn_mfma_f32_16x16x32_bf16(Bt[n][k], At[m][k], acc[ai][bj][m][n], 0, 0, 0); __builtin_amdgcn_s_setprio(0); } while (0)
#define PG8_WAIT_V(n) asm volatile("s_waitcnt vmcnt(" #n ")" ::: "memory")
#define PG8_WAIT_L(n) asm volatile("s_waitcnt lgkmcnt(" #n ")" ::: "memory")
#define PG8_BAR __builtin_amdgcn_s_barrier()
#define PG8_SCHED __builtin_amdgcn_sched_barrier(0)
    Unit cur, nxt; int ui = 0;
    if (!S.next(0, cur)) return;
    f32x4 acc[2][2][4][2];
#pragma unroll
    for (int a = 0; a < 2; ++a)
#pragma unroll
        for (int b = 0; b < 2; ++b)
#pragma unroll
            for (int m = 0; m < 4; ++m)
#pragma unroll
                for (int n = 0; n < 2; ++n) acc[a][b][m][n] = (f32x4){0.f, 0.f, 0.f, 0.f};
    bf16x8 At[4][2], B0[2][2], B1[2][2];
    const char* cA = (const char*)g.A + (size_t)cur.pm * tstep + (size_t)cur.k0 * 2; const char* cB = (const char*)g.Bt + (size_t)cur.pn * tstep + (size_t)cur.k0 * 2;
    S.a_ready(cur);
    PG8_STAGE(PG8_SB(0, 0), cB, voffB); PG8_STAGE(PG8_SA(0, 0), cA, voffA); PG8_STAGE(PG8_SB(0, 1), cB + hstep, voffB); PG8_STAGE(PG8_SA(0, 1), cA + hstep, voffA);
    if (wr == 1) PG8_BAR;
    PG8_WAIT_V(4); PG8_BAR;
    PG8_STAGE(PG8_SB(1, 0), cB + kstep, voffB); PG8_STAGE(PG8_SA(1, 0), cA + kstep, voffA); PG8_STAGE(PG8_SB(1, 1), cB + hstep + kstep, voffB);
    PG8_WAIT_V(6); PG8_BAR;
    for (;;) {
        const bool has_next = S.next(ui + 1, nxt);
        const char* nA = has_next ? (const char*)g.A + (size_t)nxt.pm * tstep + (size_t)nxt.k0 * 2 : cA; const char* nB = has_next ? (const char*)g.Bt + (size_t)nxt.pn * tstep + (size_t)nxt.k0 * 2 : cB;
        const int nt = cur.nk;
        for (int t = 0; t < nt; t += 2) {
            const bool last = (t == nt - 2);
            const char* a1 = cA + (size_t)(t + 1) * kstep;
            const char* a2 = last ? nA : cA + (size_t)(t + 2) * kstep; const char* b2 = last ? nB : cB + (size_t)(t + 2) * kstep;
            const char* a3 = a2 + kstep; const char* b3 = b2 + kstep;
            if (last && has_next) S.a_ready(nxt);
            PG8_LDB(B0, 0, 0); PG8_SCHED; PG8_LDA(At, 0, 0); PG8_STAGE(PG8_SA(1, 1), a1 + hstep, voffA);
            PG8_WAIT_L(8); PG8_BAR; PG8_WAIT_L(0); PG8_MMA(0, 0, At, B0); PG8_BAR; PG8_SCHED;
            PG8_LDB(B1, 0, 1); PG8_STAGE(PG8_SB(0, 0), b2, voffB);
            PG8_BAR; PG8_WAIT_L(0); PG8_MMA(0, 1, At, B1); PG8_BAR;
            PG8_LDA(At, 0, 1); PG8_STAGE(PG8_SA(0, 0), a2, voffA);
            PG8_BAR; PG8_WAIT_L(0); PG8_MMA(1, 0, At, B0); PG8_BAR; PG8_SCHED;
            PG8_STAGE(PG8_SB(0, 1), b2 + hstep, voffB);
            PG8_WAIT_V(6); PG8_BAR; PG8_MMA(1, 1, At, B1); PG8_BAR;
            PG8_LDB(B0, 1, 0); PG8_SCHED; PG8_LDA(At, 1, 0); PG8_STAGE(PG8_SA(0, 1), a2 + hstep, voffA);
            PG8_WAIT_L(8); PG8_BAR; PG8_WAIT_L(0); PG8_MMA(0, 0, At, B0); PG8_BAR; PG8_SCHED;
            PG8_LDB(B1, 1, 1); PG8_STAGE(PG8_SB(1, 0), b3, voffB);
            PG8_BAR; PG8_WAIT_L(0); PG8_MMA(0, 1, At, B1); PG8_BAR;
            PG8_LDA(At, 1, 1); PG8_STAGE(PG8_SA(1, 0), a3, voffA);
            PG8_BAR; PG8_WAIT_L(0); PG8_MMA(1, 0, At, B0); PG8_BAR; PG8_SCHED;
            PG8_STAGE(PG8_SB(1, 1), b3 + hstep, voffB);
            PG8_WAIT_V(6); PG8_BAR; PG8_MMA(1, 1, At, B1); PG8_BAR;
        }
        if constexpr (!Epi::AFTER_DRAIN) { E(acc, cur, wr, wc, fr, fq); S.done(cur); }
        if (!has_next) break;
#pragma unroll
        for (int a = 0; a < 2; ++a)
#pragma unroll
            for (int b = 0; b < 2; ++b)
#pragma unroll
                for (int m = 0; m < 4; ++m)
#pragma unroll
                    for (int n = 0; n < 2; ++n) acc[a][b][m][n] = (f32x4){0.f, 0.f, 0.f, 0.f};
        cur = nxt; cA = nA; cB = nB; ++ui;
    }
    PG8_WAIT_V(0);
    if (wr == 0) PG8_BAR;
    PG8_BAR;
    if constexpr (Epi::AFTER_DRAIN) { E.fused(acc, cur, wr, wc, fr, fq, lds, wid, lane); S.done(cur); }
#undef PG8_SA
#undef PG8_SB
#undef PG8_STAGE
#undef PG8_LDA
#undef PG8_LDB
#undef PG8_MMA
#undef PG8_WAIT_V
#undef PG8_WAIT_L
#undef PG8_BAR
#undef PG8_SCHED
}
}

#define XB_TMO      128
#define XB_XCNT(j)  (256  + 64 * (j))
#define XB_XSUB(j)  (1280 + 64 * (j))
#define XB_XGEN(j)  (2304 + 64 * (j))
#define XB_TOP      3328
#define XB_TOPGEN   3392
#define XCD_BAR_WORDS 3456
#define XB_SPIN_CAP (1u << 18)
#define LAS __attribute__((address_space(3)))

__device__ __forceinline__ unsigned xb_ld(unsigned* p)              { return __hip_atomic_load(p, __ATOMIC_RELAXED, __HIP_MEMORY_SCOPE_AGENT); }
__device__ __forceinline__ unsigned xb_add(unsigned* p, unsigned v) { return __hip_atomic_fetch_add(p, v, __ATOMIC_RELAXED, __HIP_MEMORY_SCOPE_AGENT); }
__device__ __forceinline__ unsigned xb_xcc_id() { return (unsigned)__builtin_amdgcn_s_getreg((3 << 11) | 20) & 0xFu; }
#define XB_SPIN(cond, bar) do { unsigned _sp = 0; while (cond) { __builtin_amdgcn_s_sleep(1); \
    if ((++_sp & 255u) == 0u) { if (xb_ld(&(bar)[XB_TMO])) break; if (_sp > XB_SPIN_CAP) { atomicAdd(&(bar)[XB_TMO], 1u); break; } } } } while (0)

struct XcdBarrier {
    unsigned* bar; unsigned x;
    volatile LAS unsigned* st;
};

__device__ __forceinline__ XcdBarrier xcd_barrier_post(unsigned* bar, volatile LAS unsigned* st) {
    XcdBarrier b; b.bar = bar; b.x = xb_xcc_id(); b.st = st;
    if (threadIdx.x == 0) (void)xb_add(&bar[XB_XCNT(b.x)], 1u);
    return b;
}
__device__ __forceinline__ void xcd_barrier_complete(unsigned* bar, unsigned x, unsigned& nloc, unsigned& nx) {
    const unsigned G = gridDim.x * gridDim.y * gridDim.z;
    unsigned sum, cnt, mine, sp = 0u;
    for (;;) {
        sum = 0u; cnt = 0u; mine = 0u;
#pragma unroll
        for (unsigned j = 0; j < 16; ++j) { const unsigned c = xb_ld(&bar[XB_XCNT(j)]); sum += c; cnt += (c > 0u) ? 1u : 0u; mine = (j == x) ? c : mine; }
        if (sum == G) break;
        __builtin_amdgcn_s_sleep(1);
        if ((++sp & 255u) == 0u) { if (xb_ld(&bar[XB_TMO])) break; if (sp > XB_SPIN_CAP) { atomicAdd(&bar[XB_TMO], 1u); break; } }
    }
    nloc = mine > 0u ? mine : 1u; nx = cnt > 0u ? cnt : 1u;
}

__device__ __forceinline__ void xcd_barrier(const XcdBarrier& b) {
    asm volatile("s_waitcnt vmcnt(0)" ::: "memory");
    __syncthreads();
    if (threadIdx.x == 0) {
        unsigned* bar = b.bar;
        __builtin_amdgcn_s_waitcnt(0);
        unsigned nloc = b.st[0], nx = b.st[1];
        if (nloc == 0u) { xcd_barrier_complete(bar, b.x, nloc, nx); b.st[0] = nloc; b.st[1] = nx; }
        const unsigned old = xb_add(&bar[XB_XSUB(b.x)], 1u);
        const unsigned gen = old / nloc;
        if (old + 1u == (gen + 1u) * nloc) {
            __builtin_amdgcn_fence(__ATOMIC_RELEASE, "agent");
            asm volatile("s_waitcnt vmcnt(0)" ::: "memory");
            const unsigned og = xb_add(&bar[XB_TOP], 1u);
            const unsigned tg = og / nx;
            if (og + 1u == (tg + 1u) * nx) xb_add(&bar[XB_TOPGEN], 1u);
            else XB_SPIN(xb_ld(&bar[XB_TOPGEN]) == tg, bar);
            __builtin_amdgcn_fence(__ATOMIC_ACQUIRE, "agent");
            xb_add(&bar[XB_XGEN(b.x)], 1u);
            asm volatile("s_waitcnt vmcnt(0)" ::: "memory");
        } else {
            XB_SPIN(xb_ld(&bar[XB_XGEN(b.x)]) == gen, bar);
            __builtin_amdgcn_fence(__ATOMIC_ACQUIRE, "agent");
            asm volatile("s_waitcnt vmcnt(0)" ::: "memory");
        }
    }
    __syncthreads();
}

namespace {
using pg8::bf16_t; using pg8::bf16x8; using pg8::f32x4; using pg8::u32x4;
typedef unsigned u32x2 __attribute__((ext_vector_type(2)));

constexpr int DM = 1024, NTOK = 20480, NPR = 4096, DIN = 2944, DINP = 3072, DFF = 4096;
constexpr int ZR = 0, ZK = 512, ZV = 1024, ZXW = 1536, ZXA = 1664, ZXG = 1792, ZXB = 1920, ZGB = 2432;
constexpr int NTILE = NTOK / 64;
constexpr size_t MiB = 1048576;
constexpr size_t WS_W2T = 0;
constexpr size_t WS_WUPT = 8 * MiB;
constexpr size_t WS_AUPT = WS_WUPT + 131072;
constexpr size_t WS_GUPT = WS_AUPT + 131072;
constexpr size_t WS_WAT = WS_GUPT + 131072;
constexpr size_t WS_WXT = WS_WAT + 131072;
constexpr size_t WS_ROWTAB = WS_WXT + 131072;
constexpr size_t WS_COLTAB = WS_ROWTAB + 65536;
constexpr size_t WS_MODPART = 9 * MiB;
constexpr size_t WS_BAR = 12 * MiB + 512 * 1024;
constexpr size_t WS_MODF = WS_BAR + 65536;
constexpr size_t WS_F = 13 * MiB;
constexpr size_t WS_Z = WS_F;
constexpr size_t WS_YA = WS_F + 115 * MiB;
constexpr size_t WS_O1 = WS_F;
constexpr size_t WS_O1P = WS_F + 40 * MiB;
constexpr size_t WS_C = 173 * MiB;
constexpr size_t WS_WINT = WS_C;
constexpr size_t WS_WOUTT = WS_C + 6 * MiB;
constexpr size_t WS_W1T = WS_C + 8 * MiB;
constexpr size_t WS_ACT = WS_C + 16 * MiB;
constexpr size_t WS_G = WS_C + 56 * MiB;
constexpr size_t WS_INV = WS_C + 76 * MiB;
constexpr size_t WS_BON = WS_INV + 655360;
constexpr size_t WS_CAR = WS_BON + 655360;
constexpr size_t WS_O2 = WS_C;
constexpr size_t WS_O2P = WS_C + 40 * MiB;
constexpr size_t OUT_RWKV = (size_t)NTOK * DM;
constexpr size_t OUT_LRU = OUT_RWKV + 16 * 2 * 8 * 4096;

constexpr int LDS_BYTES = 154 * 1024;

struct Params {
    const float* in[33];
    float* out;
    unsigned char* ws;
};

__device__ __forceinline__ float bf2f(unsigned short b) { return __uint_as_float(((unsigned)b) << 16); }
__device__ __forceinline__ unsigned short f2bf(float f) { return __builtin_bit_cast(unsigned short, (__bf16)f); }
__device__ __forceinline__ unsigned pk2(float lo, float hi) { return pg8::cvt_pk_bf16(lo, hi); }
__device__ __forceinline__ void unpack8(const u32x4 w, float* f) {
    f[0] = __uint_as_float(w.x << 16); f[1] = __uint_as_float(w.x & 0xffff0000u);
    f[2] = __uint_as_float(w.y << 16); f[3] = __uint_as_float(w.y & 0xffff0000u);
    f[4] = __uint_as_float(w.z << 16); f[5] = __uint_as_float(w.z & 0xffff0000u);
    f[6] = __uint_as_float(w.w << 16); f[7] = __uint_as_float(w.w & 0xffff0000u);
}
__device__ __forceinline__ u32x4 pack8(const float* f) { u32x4 w; w.x = pk2(f[0], f[1]); w.y = pk2(f[2], f[3]); w.z = pk2(f[4], f[5]); w.w = pk2(f[6], f[7]); return w; }
__device__ __forceinline__ float sigmoidf_(float x) { return __builtin_amdgcn_rcpf(1.0f + __expf(-x)); }
__device__ __forceinline__ float softplusf_(float y) {
    if (y > 15.0f) return y;
    const float e = __expf(y), u = 1.0f + e;
    return (u == 1.0f) ? e : __logf(u) * (e * __builtin_amdgcn_rcpf(u - 1.0f));
}
__device__ __forceinline__ float tanhf_(float x) { const float e = __expf(2.0f * x); return 1.0f - 2.0f * __builtin_amdgcn_rcpf(e + 1.0f); }
__device__ __forceinline__ float wave_sum(float v) {
#pragma unroll
    for (int o = 32; o > 0; o >>= 1) v += __shfl_xor(v, o);
    return v;
}
__device__ __forceinline__ float sum8(float v) { v += __shfl_xor(v, 1); v += __shfl_xor(v, 2); v += __shfl_xor(v, 4); return v; }

struct TileInfo { int row0; int mrow; int b; int t0; int T; int seqrow0; int sample; int tile0; int ntile; };
__device__ __forceinline__ TileInfo tile_info(int tile) {
    TileInfo ti; ti.row0 = tile * 64;
    if (tile < 64) { ti.sample = 0; ti.b = tile >> 2; ti.t0 = (tile & 3) * 64; ti.T = 256; ti.mrow = 8; ti.seqrow0 = ti.b * 256; ti.tile0 = ti.b * 4; ti.ntile = 4; }
    else { const int s = tile - 64; ti.sample = 1; ti.b = s >> 5; ti.t0 = (s & 31) * 64; ti.T = 2048; ti.mrow = ti.b; ti.seqrow0 = NPR + ti.b * 2048; ti.tile0 = 64 + ti.b * 32; ti.ntile = 32; }
    return ti;
}
__device__ __forceinline__ f32x4 load_x4(const Params& p, int row, int j) {
    if (row < NPR) return *(const f32x4*)(p.in[0] + (size_t)row * DM + j);
    const int r = row - NPR, t = r & 2047;
    f32x4 x = *(const f32x4*)(p.in[1] + (size_t)r * DM + j);
    const float* tab = (j < 512) ? (const float*)(p.ws + WS_ROWTAB) + (t >> 6) * 512 + j : (const float*)(p.ws + WS_COLTAB) + (t & 63) * 512 + (j - 512);
    const f32x4 e = *(const f32x4*)tab;
    return x + e;
}
__device__ __forceinline__ float mod_val(const Params& p, int mrow, int col) {
    const float* mp = (const float*)(p.ws + WS_MODPART);
    float s = p.in[7][col];
#pragma unroll
    for (int ks = 0; ks < 16; ++ks) s += mp[(size_t)(ks * 9 + mrow) * 6144 + col];
    return s;
}

__device__ __forceinline__ f32x4 mm16(const bf16_t* A, int lda, const bf16_t* BT, int ldb, int K, int lane) {
    const int fr = lane & 15, fq = lane >> 4;
    f32x4 acc = {0.f, 0.f, 0.f, 0.f};
    for (int kk = 0; kk < K; kk += 32) {
        const bf16x8 a = *(const bf16x8*)(A + fr * lda + kk + 8 * fq);
        const bf16x8 b = *(const bf16x8*)(BT + (size_t)fr * ldb + kk + 8 * fq);
        acc = __builtin_amdgcn_mfma_f32_16x16x32_bf16(a, b, acc, 0, 0, 0);
    }
    return acc;
}

template <int ACT> struct EpiB16 {
    static constexpr bool PERM = true, AFTER_DRAIN = false;
    bf16_t* O; int ldc; int ncols;
    __device__ __forceinline__ void operator()(const f32x4 (&acc)[2][2][4][2], const pg8::Unit& u, int wr, int wc, int fr, int fq) const {
        const int row0 = u.pm * 256 + wr * 64 + fr; const int col0 = u.pn * 256 + wc * 32 + 8 * fq;
#pragma unroll
        for (int ai = 0; ai < 2; ++ai)
#pragma unroll
            for (int m = 0; m < 4; ++m) { bf16_t* rowp = O + (size_t)(row0 + ai * 128 + m * 16) * ldc + col0;
#pragma unroll
                for (int bj = 0; bj < 2; ++bj) { f32x4 v0 = acc[ai][bj][m][0], v1 = acc[ai][bj][m][1];
                    if (ACT == 1) {
#pragma unroll
                        for (int j = 0; j < 4; ++j) { const float a = fmaxf(v0[j], 0.f), b = fmaxf(v1[j], 0.f); v0[j] = a * a; v1[j] = b * b; } }
                    if (ACT == 2 && bj == 0) {
                        if (u.pn == 6) {
#pragma unroll
                            for (int j = 0; j < 4; ++j) { v0[j] = tanhf_(v0[j]); v1[j] = tanhf_(v1[j]); } }
                        if (u.pn == 7) {
#pragma unroll
                            for (int j = 0; j < 4; ++j) { v0[j] = sigmoidf_(v0[j]); v1[j] = sigmoidf_(v1[j]); } } }
                    u32x4 w; w.x = pg8::cvt_pk_bf16(v0[0], v0[1]); w.y = pg8::cvt_pk_bf16(v0[2], v0[3]); w.z = pg8::cvt_pk_bf16(v1[0], v1[1]); w.w = pg8::cvt_pk_bf16(v1[2], v1[3]);
                    if (col0 + bj * 128 < ncols) *(u32x4*)(rowp + bj * 128) = w; } }
    }
};
struct EpiSplitB16 {
    static constexpr bool PERM = true, AFTER_DRAIN = false;
    bf16_t* O; bf16_t* P;
    __device__ __forceinline__ void operator()(const f32x4 (&acc)[2][2][4][2], const pg8::Unit& u, int wr, int wc, int fr, int fq) const {
        const int row0 = u.pm * 256 + wr * 64 + fr; const int col0 = u.pn * 256 + wc * 32 + 8 * fq;
        bf16_t* base = (u.part < 0) ? O + (size_t)row0 * 1024 : P + ((size_t)u.part * 4096 + (row0 - 16384)) * 1024;
#pragma unroll
        for (int ai = 0; ai < 2; ++ai)
#pragma unroll
            for (int m = 0; m < 4; ++m) { bf16_t* rowp = base + (size_t)(ai * 128 + m * 16) * 1024 + col0;
#pragma unroll
                for (int bj = 0; bj < 2; ++bj) { const f32x4 v0 = acc[ai][bj][m][0], v1 = acc[ai][bj][m][1];
                    u32x4 w; w.x = pg8::cvt_pk_bf16(v0[0], v0[1]); w.y = pg8::cvt_pk_bf16(v0[2], v0[3]); w.z = pg8::cvt_pk_bf16(v1[0], v1[1]); w.w = pg8::cvt_pk_bf16(v1[2], v1[3]);
                    *(u32x4*)(rowp + bj * 128) = w; } }
    }
};
struct EpiF {
    static constexpr bool PERM = false, AFTER_DRAIN = false;
    float* C; int ldc;
    __device__ __forceinline__ void operator()(const f32x4 (&acc)[2][2][4][2], const pg8::Unit& u, int wr, int wc, int fr, int fq) const {
        const int row0 = u.pm * 256 + wr * 64 + fr, col0 = u.pn * 256 + wc * 32 + 4 * fq;
#pragma unroll
        for (int ai = 0; ai < 2; ++ai)
#pragma unroll
            for (int m = 0; m < 4; ++m) { float* rowp = C + (size_t)(row0 + ai * 128 + m * 16) * ldc + col0;
#pragma unroll
                for (int bj = 0; bj < 2; ++bj)
#pragma unroll
                    for (int n = 0; n < 2; ++n) *(f32x4*)(rowp + bj * 128 + n * 16) = acc[ai][bj][m][n]; }
    }
};

__device__ __forceinline__ void transpose_tile(const float* src, int N, int Nvalid, bf16_t* dst, int K, int n0, int k0, float* tile) {
    const int tid = threadIdx.x;
    {   const int r = tid >> 4, c4 = (tid & 15) * 4;
#pragma unroll
        for (int pss = 0; pss < 2; ++pss) { const int rr = r + pss * 32;
            f32x4 v = {0.f, 0.f, 0.f, 0.f};
            if (n0 < Nvalid) v = *(const f32x4*)(src + (size_t)(k0 + rr) * N + n0 + c4);
            tile[rr * 65 + c4 + 0] = v[0]; tile[rr * 65 + c4 + 1] = v[1]; tile[rr * 65 + c4 + 2] = v[2]; tile[rr * 65 + c4 + 3] = v[3]; } }
    __syncthreads();
    {   const int rr = tid >> 3, kc = (tid & 7) * 8; float f[8];
#pragma unroll
        for (int j = 0; j < 8; ++j) f[j] = tile[(kc + j) * 65 + rr];
        *(u32x4*)(dst + (size_t)(n0 + rr) * K + k0 + kc) = pack8(f); }
    __syncthreads();
}

__device__ __forceinline__ void phase0(const Params& p, unsigned char* shm) {
    float* tile = (float*)shm;
    const int tid = threadIdx.x;
    const bool defer = (gridDim.x == 256);
    constexpr int N_TR = 3072, N_MOD = 192, N_SW = 160, N_TAB = 24;
    for (int it0 = blockIdx.x; it0 < (defer ? 768 : N_TR) + N_MOD + N_SW + N_TAB; it0 += gridDim.x) {
        const int it = (defer && it0 >= 768) ? it0 + (N_TR - 768) : it0;
        if (it < N_TR) {
            if (it < 768) transpose_tile(p.in[12], DIN, DIN, (bf16_t*)(p.ws + WS_WINT), 1024, (it >> 4) * 64, (it & 15) * 64, tile);
            else if (it < 1024) { const int i = it - 768; transpose_tile(p.in[30], 1024, 1024, (bf16_t*)(p.ws + WS_WOUTT), 1024, (i >> 4) * 64, (i & 15) * 64, tile); }
            else if (it < 2048) { const int i = it - 1024; transpose_tile(p.in[31], 4096, 4096, (bf16_t*)(p.ws + WS_W1T), 1024, (i >> 4) * 64, (i & 15) * 64, tile); }
            else { const int i = it - 2048; transpose_tile(p.in[32], 1024, 1024, (bf16_t*)(p.ws + WS_W2T), 4096, (i >> 6) * 64, (i & 63) * 64, tile); }
        } else if (it < N_TR + N_MOD) {
            const int i = it - N_TR, cgp = i % 12, ks = i / 12, k0 = ks * 64;
            for (int e = tid; e < 576; e += 512) { const int b = e >> 6, kk = e & 63; const float cv = (b < 8) ? p.in[2][b * 1024 + k0 + kk] : p.in[5][k0 + kk]; tile[e] = cv * __builtin_amdgcn_rcpf(1.0f + __expf(-cv)); }
            __syncthreads();
            const int col = cgp * 512 + tid;
            float a0 = 0, a1 = 0, a2 = 0, a3 = 0, a4 = 0, a5 = 0, a6 = 0, a7 = 0, a8 = 0;
            const float* wm = p.in[6] + (size_t)k0 * 6144 + col;
#pragma unroll
            for (int hb = 0; hb < 2; ++hb) { float wv[32];
#pragma unroll
                for (int q = 0; q < 32; ++q) wv[q] = wm[(size_t)(hb * 32 + q) * 6144];
                __builtin_amdgcn_sched_barrier(0);
#pragma unroll
                for (int q = 0; q < 32; ++q) { const int kk = hb * 32 + q; const float w = wv[q];
                    a0 += tile[kk] * w; a1 += tile[64 + kk] * w; a2 += tile[128 + kk] * w; a3 += tile[192 + kk] * w; a4 += tile[256 + kk] * w;
                    a5 += tile[320 + kk] * w; a6 += tile[384 + kk] * w; a7 += tile[448 + kk] * w; a8 += tile[512 + kk] * w; } }
            float* mp = (float*)(p.ws + WS_MODPART) + (size_t)(ks * 9) * 6144 + col;
            mp[0] = a0; mp[6144] = a1; mp[2 * 6144] = a2; mp[3 * 6144] = a3; mp[4 * 6144] = a4; mp[5 * 6144] = a5; mp[6 * 6144] = a6; mp[7 * 6144] = a7; mp[8 * 6144] = a8;
            __syncthreads();
        } else if (it < N_TR + N_MOD + N_SW) {
            const int i = it - N_TR - N_MOD;
float vq[4]; bf16_t* dq[4]; int rq[4];
#pragma unroll
            for (int q = 0; q < 4; ++q) {
                const int e = i * 2048 + q * 512 + tid, which = e >> 16, r = e & 65535;
                float v; bf16_t* dst;
                if (which < 2) { const int d = r >> 15, n = (r >> 6) & 511, k = r & 63; v = p.in[which == 0 ? 14 : 16][d * 32768 + k * 512 + n]; dst = (bf16_t*)(p.ws + (which == 0 ? WS_WUPT : WS_AUPT)); }
                else if (which == 2) { const int n = r >> 7, k = r & 127; v = p.in[17][k * 512 + n]; dst = (bf16_t*)(p.ws + WS_GUPT); }
                else { const int dn = r >> 12, o = (r >> 6) & 63, c = r & 63; v = p.in[which == 3 ? 25 : 27][dn * 4096 + c * 64 + o]; dst = (bf16_t*)(p.ws + (which == 3 ? WS_WAT : WS_WXT)); }
                vq[q] = v; dq[q] = dst; rq[q] = r;
            }
#pragma unroll
            for (int q = 0; q < 4; ++q) dq[q][rq[q]] = f2bf(vq[q]);
        } else {
            const int i = it - N_TR - N_MOD - N_SW;
#pragma unroll
            for (int q = 0; q < 4; ++q) {
                const int e = i * 2048 + q * 512 + tid;
                const int isrow = e < 16384, e2 = isrow ? e : e - 16384, pos = e2 >> 9, j = e2 & 511, ii = j & 255;
                const float omega = 1.0f / powf(10000.0f, (float)ii / 256.0f);
                const float ang = (float)pos * omega;
                const float v = (j < 256) ? sinf(ang) : cosf(ang);
                ((float*)(p.ws + (isrow ? WS_ROWTAB : WS_COLTAB)))[e2] = v;
            }
        }
    }
}

__device__ __forceinline__ void deferred_transposes(const Params& p, unsigned char* shm, int which, int rank, int nranks) {
    float* tile = (float*)shm;
    if (which == 0) { for (int i = rank; i < 256; i += nranks) transpose_tile(p.in[30], 1024, 1024, (bf16_t*)(p.ws + WS_WOUTT), 1024, (i >> 4) * 64, (i & 15) * 64, tile); }
    else { for (int it = rank; it < 2048; it += nranks) {
            if (it < 1024) transpose_tile(p.in[31], 4096, 4096, (bf16_t*)(p.ws + WS_W1T), 1024, (it >> 4) * 64, (it & 15) * 64, tile);
            else { const int i = it - 1024; transpose_tile(p.in[32], 1024, 1024, (bf16_t*)(p.ws + WS_W2T), 4096, (i >> 6) * 64, (i & 63) * 64, tile); } } }
}

__device__ __forceinline__ void phase_h1(const Params& p, unsigned char* shm) {
    float* sm = (float*)shm;
    const int tid = threadIdx.x, wid = tid >> 6, lane = tid & 63;
    bf16_t* H = (bf16_t*)(p.ws + WS_ACT);
    for (int e = blockIdx.x * 512 + tid; e < 9 * 6144; e += gridDim.x * 512) ((float*)(p.ws + WS_MODF))[e] = mod_val(p, e / 6144, e % 6144);
    const int per16 = (NTOK / 16 + (int)gridDim.x - 1) / (int)gridDim.x; int cur_mrow = -1;
    auto body = [&](auto nr_tag, int row) { constexpr int NR = decltype(nr_tag)::value;
            f32x4 x[NR][4]; float ss[NR] = {};
#pragma unroll
            for (int u = 0; u < NR; ++u)
#pragma unroll
                for (int i = 0; i < 4; ++i) x[u][i] = load_x4(p, row + (u >> 1) * 16 + (u & 1), 4 * lane + 256 * i);
#pragma unroll
            for (int u = 0; u < NR; ++u)
#pragma unroll
                for (int i = 0; i < 4; ++i) ss[u] += x[u][i][0] * x[u][i][0] + x[u][i][1] * x[u][i][1] + x[u][i][2] * x[u][i][2] + x[u][i][3] * x[u][i][3];
#pragma unroll
            for (int o = 32; o > 0; o >>= 1) {
#pragma unroll
                for (int u = 0; u < NR; ++u) ss[u] += __shfl_xor(ss[u], o); }
#pragma unroll
            for (int u = 0; u < NR; ++u) { const float rstd = rsqrtf(ss[u] * (1.0f / 1024.0f) + 1e-6f);
#pragma unroll
                for (int i = 0; i < 4; ++i) { const int j = 4 * lane + 256 * i;
                    const f32x4 g = *(const f32x4*)(p.in[8] + j); float h[4];
#pragma unroll
                    for (int e = 0; e < 4; ++e) h[e] = x[u][i][e] * rstd * g[e] * (1.0f + sm[1024 + j + e]) + sm[j + e];
                    u32x2 w; w.x = pk2(h[0], h[1]); w.y = pk2(h[2], h[3]);
                    __builtin_nontemporal_store(w, (u32x2*)(H + (size_t)(row + (u >> 1) * 16 + (u & 1)) * DM + j)); } }
    };
    for (int k16 = 0; k16 < per16; ) {
        const int t16 = blockIdx.x * per16 + k16; if (t16 >= NTOK / 16) break;
        const int row = t16 * 16 + wid * 2, mrow = (t16 * 16 < NPR) ? 8 : ((t16 * 16 - NPR) >> 11);
        if (mrow != cur_mrow) { __syncthreads(); { float mv[4];
#pragma unroll
            for (int q = 0; q < 4; ++q) mv[q] = mod_val(p, mrow, tid + 512 * q);
#pragma unroll
            for (int q = 0; q < 4; ++q) sm[tid + 512 * q] = mv[q]; } __syncthreads(); cur_mrow = mrow; }
        const int t16b = t16 + 1; const bool pair = (k16 + 1 < per16) && (t16b < NTOK / 16) && (((t16b * 16 < NPR) ? 8 : ((t16b * 16 - NPR) >> 11)) == mrow);
        if (pair) { body(std::integral_constant<int, 4>{}, row); k16 += 2; } else { body(std::integral_constant<int, 2>{}, row); k16 += 1; }
    }
    __syncthreads();
}

constexpr int LO_O = 0;
constexpr int LO_XA = 87040;
constexpr int LO_PRM = 139264;
constexpr int LW_HALF = 26624 + 2 * 9216, LW_GB = 26624;
struct LruPre { u32x4 x[8]; u32x4 g[2]; };

template <int MODE>
__device__ __forceinline__ void lru_load_x(const Params& p, const TileInfo& ti, int j, int ht, LruPre& pre) {
    const bf16_t* Z = (const bf16_t*)(p.ws + WS_Z);
    const int t = ht >> 2, cq = ht & 3;
#pragma unroll
    for (int jj = 0; jj < 4; ++jj) { const int tt = ti.t0 + t + jj - 2; const bool ok = (tt >= 0) && (tt < ti.T);
        const bf16_t* src = Z + (size_t)(ti.seqrow0 + (ok ? tt : 0)) * DIN + ZXB + 64 * j + 16 * cq;
        const u32x4 z = {0u, 0u, 0u, 0u};
        pre.x[2 * jj] = ok ? *(const u32x4*)src : z; pre.x[2 * jj + 1] = ok ? *(const u32x4*)(src + 8) : z; }
    if (MODE == 1) { const bf16_t* src = Z + (size_t)(ti.row0 + t) * DIN + ZGB + 64 * j + 16 * cq; pre.g[0] = *(const u32x4*)src; pre.g[1] = *(const u32x4*)(src + 8); }
}

template <int MODE>
__device__ __forceinline__ void lru_wave_item(const Params& p, unsigned char* lh, const bf16_t* wt, const float* cp, const float (&pba)[2], const float (&pbx)[2], const float (&pc8)[2], int tile, int j, const TileInfo& ti, LruPre& pre, int ht, int next_tile, int par) {
    const bf16_t* Z = (const bf16_t*)(p.ws + WS_Z);
    bf16_t* xcb = (bf16_t*)lh; float* xcf = (float*)(lh + 9216); bf16_t* gbt = (bf16_t*)(lh + LW_GB + par * 9216);
    const int lane = ht & 63, nt = ht >> 6, fr = lane & 15, fq = lane >> 4, ch = 64 * j + 16 * nt + fr;
    {   const int t = ht >> 2, cq = ht & 3; float xc[16];
#pragma unroll
        for (int q = 0; q < 16; ++q) xc[q] = cp[4 * 64 + 16 * cq + q];
#pragma unroll
        for (int jj = 0; jj < 4; ++jj) { float f[16]; unpack8(pre.x[2 * jj], f); unpack8(pre.x[2 * jj + 1], f + 8); __builtin_amdgcn_sched_barrier(0);
#pragma unroll
            for (int q = 0; q < 16; ++q) xc[q] += f[q] * cp[jj * 64 + 16 * cq + q]; }
        *(u32x4*)(xcb + t * 72 + 16 * cq) = pack8(xc); *(u32x4*)(xcb + t * 72 + 16 * cq + 8) = pack8(xc + 8);
        if (MODE == 1) { *(u32x4*)(gbt + t * 72 + 16 * cq) = pre.g[0]; *(u32x4*)(gbt + t * 72 + 16 * cq + 8) = pre.g[1]; }
#pragma unroll
        for (int q = 0; q < 16; q += 4) *(f32x4*)(xcf + t * 68 + 16 * cq + q) = (f32x4){xc[q], xc[q + 1], xc[q + 2], xc[q + 3]}; }
    __builtin_amdgcn_sched_barrier(0);
    if (next_tile >= 0) { const TileInfo tn = tile_info(next_tile); lru_load_x<MODE>(p, tn, j, ht, pre); }
    __syncthreads();
    f32x4 A_[2][4], B_[2][4];
    bf16x8 bl[4][2];
#pragma unroll
    for (int o = 0; o < 4; ++o)
#pragma unroll
        for (int k2 = 0; k2 < 2; ++k2) bl[o][k2] = *(const bf16x8*)(wt + (o * 64 + 16 * nt + fr) * 72 + 32 * k2 + 8 * fq);
#pragma unroll
    for (int mt = 0; mt < 4; ++mt) {
        const bf16x8 a0 = *(const bf16x8*)(xcb + (16 * mt + fr) * 72 + 8 * fq), a1 = *(const bf16x8*)(xcb + (16 * mt + fr) * 72 + 32 + 8 * fq);
        f32x4 acc[4];
#pragma unroll
        for (int o = 0; o < 4; ++o) { acc[o] = (f32x4){0.f, 0.f, 0.f, 0.f};
            acc[o] = __builtin_amdgcn_mfma_f32_16x16x32_bf16(a0, bl[o][0], acc[o], 0, 0, 0); acc[o] = __builtin_amdgcn_mfma_f32_16x16x32_bf16(a1, bl[o][1], acc[o], 0, 0, 0); }
#pragma unroll
        for (int d = 0; d < 2; ++d)
#pragma unroll
            for (int e = 0; e < 4; ++e) {
                const float rg = sigmoidf_(acc[2 * d][e] + pba[d]), ig = sigmoidf_(acc[2 * d + 1][e] + pbx[d]);
                const float a = __expf(rg * pc8[d]);
                A_[d][mt][e] = a; B_[d][mt][e] = __builtin_amdgcn_sqrtf(fmaxf(1.0f - a * a, 0.0f)) * (ig * xcf[(16 * mt + 4 * fq + e) * 68 + 16 * nt + fr]); }
    }
    __syncthreads();
    float hin0 = 0.f, hin1 = 0.f;
    if (MODE == 1) {
        const int chain = lane & 31, dd = chain >> 4, part = lane >> 5;
        const float* car = (const float*)(p.ws + WS_CAR);
        float Pa = 1.0f, Ha = 0.0f;
#pragma unroll
        for (int hb = 0; hb < 2; ++hb) { float Pv[8], Hv[8];
#pragma unroll
            for (int i = 0; i < 8; ++i) { const int kk = part * 16 + hb * 8 + i; const int tl = dd ? (ti.tile0 + ti.ntile - 1 - kk) : (ti.tile0 + kk);
                const bool valid = (kk < ti.ntile) && (dd ? (tl > tile) : (tl < tile));
                const float* cc = car + (size_t)((tl * 8 + j) * 2 + dd) * 128 + 16 * nt + fr;
                Pv[i] = valid ? cc[0] : 1.0f; Hv[i] = valid ? cc[64] : 0.0f; }
#pragma unroll
            for (int i = 0; i < 8; ++i) { Ha = Pv[i] * Ha + Hv[i]; Pa = Pv[i] * Pa; }
            __builtin_amdgcn_sched_barrier(0); }
        const float P1 = __shfl(Pa, chain + 32), H1 = __shfl(Ha, chain + 32);
        const float P0 = __shfl(Pa, chain), H0 = __shfl(Ha, chain);
        float h0 = ti.sample ? p.in[4][ti.b * 1024 + dd * 512 + ch] : 0.f;
        h0 = P0 * h0 + H0; h0 = P1 * h0 + H1;
        hin0 = __shfl(h0, fr); hin1 = __shfl(h0, 16 + fr); }
    float hs[4][4];
#pragma unroll
    for (int d = 0; d < 2; ++d) {
        float R_P = 1.0f, R_H = 0.0f;
        float hin = d ? hin1 : hin0;
#pragma unroll
        for (int m_ = 0; m_ < 4; ++m_) { const int mt = d ? 3 - m_ : m_;
            float P = 1.0f, H = 0.0f;
#pragma unroll
            for (int e_ = 0; e_ < 4; ++e_) { const int e = d ? 3 - e_ : e_; H = A_[d][mt][e] * H + B_[d][mt][e]; P = A_[d][mt][e] * P; }
            const int sq = d ? 3 - fq : fq;
            {   const int src1 = d ? lane + 16 : lane - 16; const float Pp = __shfl(P, src1 & 63), Hp = __shfl(H, src1 & 63);
                if (sq >= 1) { H = P * Hp + H; P = P * Pp; } }
            {   const int src2 = d ? lane + 32 : lane - 32; const float Pp = __shfl(P, src2 & 63), Hp = __shfl(H, src2 & 63);
                if (sq >= 2) { H = P * Hp + H; P = P * Pp; } }
            const int lastl = d ? fr : 48 + fr; const float TP = __shfl(P, lastl), TH = __shfl(H, lastl);
            if (MODE == 1) {
                const int srcx = d ? lane + 16 : lane - 16; float EP = __shfl(P, srcx & 63), EH = __shfl(H, srcx & 63);
                if (sq == 0) { EP = 1.0f; EH = 0.0f; }
                float h = R_P * hin + R_H; h = EP * h + EH;
#pragma unroll
                for (int e_ = 0; e_ < 4; ++e_) { const int e = d ? 3 - e_ : e_; h = A_[d][mt][e] * h + B_[d][mt][e]; hs[mt][e] = (d == 0) ? h : hs[mt][e] + h; }
                if (!ti.sample) {
                    if (d == 0 && mt == 3 && fq == 3 && tile == ti.tile0 + ti.ntile - 1) p.out[OUT_LRU + ti.b * 1024 + ch] = h;
                    if (d == 1 && mt == 0 && fq == 0 && tile == ti.tile0) p.out[OUT_LRU + ti.b * 1024 + 512 + ch] = h; }
            }
            R_H = TP * R_H + TH; R_P = TP * R_P;
        }
        if (MODE == 0) { if (fq == 0) { float* car = (float*)(p.ws + WS_CAR) + (size_t)((tile * 8 + j) * 2 + d) * 128 + 16 * nt + fr; car[0] = R_P; car[64] = R_H; } }
    }
    if (MODE == 1) {
        bf16_t* Y = (bf16_t*)(p.ws + WS_ACT);
#pragma unroll
        for (int mt = 0; mt < 4; ++mt)
#pragma unroll
            for (int e = 0; e < 4; ++e) { const float x = bf2f(gbt[(16 * mt + 4 * fq + e) * 72 + 16 * nt + fr]);
                const float ge = 0.5f * x * (1.0f + tanhf_(0.7978845608028654f * (x + 0.044715f * x * x * x)));
                Y[(size_t)(ti.row0 + 16 * mt + 4 * fq + e) * DM + 512 + ch] = f2bf(hs[mt][e] * ge); }
    }
}

constexpr int LW_WT = 2 * LW_HALF, LW_CP = LW_WT + 4 * 64 * 72 * 2;
template <int MODE>
__device__ __forceinline__ void lru_phase(const Params& p, unsigned char* shm, int j, int tile0, int tstride, int ntiles_total) {
    const int tid = threadIdx.x, ht = tid & 255, half = tid >> 8, lane = tid & 63, nt = ht >> 6, fr = lane & 15;
    unsigned char* lh = shm + half * LW_HALF;
    bf16_t* wt = (bf16_t*)(shm + LW_WT); float* cp = (float*)(shm + LW_CP);
    {   u32x4 wv[4];
#pragma unroll
        for (int q = 0; q < 4; ++q) { const int e = tid + 512 * q, o = e >> 9, n = (e >> 3) & 63, k8 = e & 7;
            wv[q] = *(const u32x4*)((const bf16_t*)(p.ws + ((o & 1) ? WS_WXT : WS_WAT)) + (size_t)(((o >> 1) * 8 + j) * 64 + n) * 64 + 8 * k8); }
#pragma unroll
        for (int q = 0; q < 4; ++q) { const int e = tid + 512 * q, o = e >> 9, n = (e >> 3) & 63, k8 = e & 7; *(u32x4*)(wt + (o * 64 + n) * 72 + 8 * k8) = wv[q]; } }
    if (tid < 320) { const int idx = tid >> 6, c = tid & 63; cp[tid] = (idx < 4) ? p.in[23][idx * 512 + 64 * j + c] : p.in[24][64 * j + c]; }
    float pba[2], pbx[2], pc8[2];
    {   const int ch = 64 * j + 16 * nt + fr;
#pragma unroll
        for (int d = 0; d < 2; ++d) { pba[d] = p.in[26][d * 512 + ch]; pbx[d] = p.in[28][d * 512 + ch]; pc8[d] = -8.0f * softplusf_(-p.in[29][d * 512 + ch]); } }
    const int nmax = (ntiles_total + 1) / 2, n = (ntiles_total - half + 1) / 2;
    LruPre pre;
    if (n > 0) { const TileInfo ti = tile_info(tile0 + half * tstride); lru_load_x<MODE>(p, ti, j, ht, pre); }
    __syncthreads();
    for (int i = 0; i < nmax; ++i) {
        if (i < n) { const int tile = tile0 + (2 * i + half) * tstride; const TileInfo ti = tile_info(tile);
            lru_wave_item<MODE>(p, lh, wt, cp, pba, pbx, pc8, tile, j, ti, pre, ht, (i + 1 < n) ? tile + 2 * tstride : -1, i & 1); }
        else { __syncthreads(); __syncthreads(); } }
}

__device__ __forceinline__ void phase_prep(const Params& p, unsigned char* shm) {
    const int tid = threadIdx.x, wid = tid >> 6, lane = tid & 63;
    const bf16_t* Z = (const bf16_t*)(p.ws + WS_Z);
    float* O = (float*)(shm + LO_O);
    bf16_t* XW = (bf16_t*)(shm + LO_XA); bf16_t* XA = XW + 64 * 136; bf16_t* XG = XA + 64 * 136;
    bf16_t* SCAN = (bf16_t*)p.out;
    {
    const int h = blockIdx.x & 7, nbj = gridDim.x >> 3;
    bf16x8 bw[2][2], ba[2][2], bg[4];
    {   const int fr = lane & 15, fq = lane >> 4, nt = wid & 3;
#pragma unroll
        for (int d = 0; d < 2; ++d)
#pragma unroll
            for (int k2 = 0; k2 < 2; ++k2) { const size_t o = (size_t)(d * 512 + h * 64 + 16 * nt + fr) * 64 + 32 * k2 + 8 * fq;
                bw[d][k2] = *(const bf16x8*)((const bf16_t*)(p.ws + WS_WUPT) + o); ba[d][k2] = *(const bf16x8*)((const bf16_t*)(p.ws + WS_AUPT) + o); }
#pragma unroll
        for (int k4 = 0; k4 < 4; ++k4) bg[k4] = *(const bf16x8*)((const bf16_t*)(p.ws + WS_GUPT) + (size_t)(h * 64 + 16 * nt + fr) * 128 + 32 * k4 + 8 * fq); }
    float* PR = (float*)(shm + LO_PRM);
    if (tid < 448) { const int idx = tid >> 6, c = tid & 63, hc = h * 64 + c;
        PR[tid] = (idx < 2) ? p.in[13][idx * 512 + hc] : (idx < 4) ? p.in[15][(idx - 2) * 512 + hc] : (idx == 4) ? p.in[18][hc] : (idx == 5) ? p.in[19][hc] : p.in[20][hc]; }
    u32x4 nx[8];
    {   const int tile = blockIdx.x >> 3;
        if (tile < NTILE) { const int t = tid >> 3, seg = tid & 7; const size_t zr = (size_t)(tile * 64 + t) * DIN;
#pragma unroll
            for (int hh = 0; hh < 2; ++hh) { const int c0 = seg * 16 + hh * 8; nx[hh] = *(const u32x4*)(Z + zr + ZXW + c0); nx[2 + hh] = *(const u32x4*)(Z + zr + ZXA + c0); nx[4 + hh] = *(const u32x4*)(Z + zr + ZXG + c0); }
            nx[6] = *(const u32x4*)(Z + zr + h * 64 + 8 * seg + ZR); nx[7] = *(const u32x4*)(Z + zr + h * 64 + 8 * seg + ZK); } }
    __syncthreads();
    for (int tile = blockIdx.x >> 3; tile < NTILE; tile += nbj) {
        const TileInfo ti = tile_info(tile);
        u32x4 cx[8];
#pragma unroll
        for (int i = 0; i < 8; ++i) cx[i] = nx[i];
        if (tile + nbj < NTILE) { const int t = tid >> 3, seg = tid & 7; const size_t zr = (size_t)((tile + nbj) * 64 + t) * DIN;
#pragma unroll
            for (int hh = 0; hh < 2; ++hh) { const int c0 = seg * 16 + hh * 8; nx[hh] = *(const u32x4*)(Z + zr + ZXW + c0); nx[2 + hh] = *(const u32x4*)(Z + zr + ZXA + c0); nx[4 + hh] = *(const u32x4*)(Z + zr + ZXG + c0); }
            nx[6] = *(const u32x4*)(Z + zr + h * 64 + 8 * seg + ZR); nx[7] = *(const u32x4*)(Z + zr + h * 64 + 8 * seg + ZK); }
        {   const int t = tid >> 3, seg = tid & 7; float f[8];
#pragma unroll
            for (int hh = 0; hh < 2; ++hh) { const int c0 = seg * 16 + hh * 8;
                *(u32x4*)(XW + t * 136 + c0) = cx[hh]; *(u32x4*)(XA + t * 136 + c0) = cx[2 + hh]; *(u32x4*)(XG + t * 136 + c0) = cx[4 + hh]; } }
        __syncthreads();
        {   const int fr = lane & 15, fq = lane >> 4, nt = wid & 3, mtb = 2 * (wid >> 2);
#pragma unroll
            for (int mi = 0; mi < 2; ++mi) { const int mt = mtb + mi; const bf16_t* ar = XW + (16 * mt + fr) * 136 + 8 * fq;
#pragma unroll
                for (int d = 0; d < 2; ++d) { f32x4 aw = {0.f, 0.f, 0.f, 0.f}, aa = aw;
#pragma unroll
                    for (int k2 = 0; k2 < 2; ++k2) { aw = __builtin_amdgcn_mfma_f32_16x16x32_bf16(*(const bf16x8*)(ar + d * 64 + 32 * k2), bw[d][k2], aw, 0, 0, 0);
                        aa = __builtin_amdgcn_mfma_f32_16x16x32_bf16(*(const bf16x8*)(ar + 64 * 136 + d * 64 + 32 * k2), ba[d][k2], aa, 0, 0, 0); }
#pragma unroll
                    for (int i = 0; i < 4; ++i) { O[(d * 64 + 16 * mt + 4 * fq + i) * 68 + 16 * nt + fr] = aw[i]; O[((2 + d) * 64 + 16 * mt + 4 * fq + i) * 68 + 16 * nt + fr] = aa[i]; } }
                f32x4 ag = {0.f, 0.f, 0.f, 0.f};
#pragma unroll
                for (int k4 = 0; k4 < 4; ++k4) ag = __builtin_amdgcn_mfma_f32_16x16x32_bf16(*(const bf16x8*)(ar + 2 * 64 * 136 + 32 * k4), bg[k4], ag, 0, 0, 0);
#pragma unroll
                for (int i = 0; i < 4; ++i) O[(4 * 64 + 16 * mt + 4 * fq + i) * 68 + 16 * nt + fr] = ag[i]; } }
        __syncthreads();
        {   const int t = tid >> 3, cs = tid & 7, row = ti.row0 + t; const size_t zr = (size_t)row * DIN + h * 64 + 8 * cs;
            float ss = 0.f;
            float kaw[8], rkw[8];
            {   float k[8], kkw[8]; unpack8(cx[7], k);
                *(f32x4*)kkw = *(const f32x4*)(PR + 4 * 64 + 8 * cs); *(f32x4*)(kkw + 4) = *(const f32x4*)(PR + 4 * 64 + 8 * cs + 4);
                *(f32x4*)kaw = *(const f32x4*)(PR + 5 * 64 + 8 * cs); *(f32x4*)(kaw + 4) = *(const f32x4*)(PR + 5 * 64 + 8 * cs + 4);
                *(f32x4*)rkw = *(const f32x4*)(PR + 6 * 64 + 8 * cs); *(f32x4*)(rkw + 4) = *(const f32x4*)(PR + 6 * 64 + 8 * cs + 4);
#pragma unroll
                for (int q = 0; q < 8; ++q) { const float kk = k[q] * kkw[q]; ss += kk * kk; } }
            ss = sum8(ss);
            const float inv = __builtin_amdgcn_rcpf(fmaxf(__builtin_amdgcn_sqrtf(ss), 1e-12f));
            float bs = 0.f;
            float rf[8], kf[8]; unpack8(cx[6], rf); unpack8(cx[7], kf);
#pragma unroll 1
            for (int d = 0; d < 2; ++d) {
                bf16_t* sp = SCAN + ((size_t)(d * NTOK + row) * 8 + h) * 128 + 8 * cs;
                float oa[8], ow[8], pa[8], pw[8];
                *(f32x4*)oa = *(const f32x4*)(O + ((2 + d) * 64 + t) * 68 + 8 * cs); *(f32x4*)(oa + 4) = *(const f32x4*)(O + ((2 + d) * 64 + t) * 68 + 8 * cs + 4);
                *(f32x4*)ow = *(const f32x4*)(O + (d * 64 + t) * 68 + 8 * cs); *(f32x4*)(ow + 4) = *(const f32x4*)(O + (d * 64 + t) * 68 + 8 * cs + 4);
                *(f32x4*)pa = *(const f32x4*)(PR + (2 + d) * 64 + 8 * cs); *(f32x4*)(pa + 4) = *(const f32x4*)(PR + (2 + d) * 64 + 8 * cs + 4);
                *(f32x4*)pw = *(const f32x4*)(PR + d * 64 + 8 * cs); *(f32x4*)(pw + 4) = *(const f32x4*)(PR + d * 64 + 8 * cs + 4);
                float lw[8], aa[8];
#pragma unroll
                for (int q = 0; q < 8; ++q) { const float a = sigmoidf_(pa[q] + oa[q]);
                    bs += rf[q] * (kf[q] * (1.0f + (a - 1.0f) * kaw[q])) * rkw[q];
                    lw[q] = -0.60653065971f * sigmoidf_(pw[q] + ow[q]);
                    aa[q] = a; }
                *(u32x4*)sp = pack8(lw); *(u32x4*)(sp + 64) = pack8(aa); }
            bs = sum8(bs);
            if (cs == 0) { ((float*)(p.ws + WS_INV))[row * 8 + h] = inv; ((float*)(p.ws + WS_BON))[row * 8 + h] = bs; }
            float g[8];
            *(f32x4*)g = *(const f32x4*)(O + (4 * 64 + t) * 68 + 8 * cs); *(f32x4*)(g + 4) = *(const f32x4*)(O + (4 * 64 + t) * 68 + 8 * cs + 4);
            *(u32x4*)((bf16_t*)(p.ws + WS_G) + (size_t)row * 512 + h * 64 + 8 * cs) = pack8(g); }
    }
    __syncthreads();
    }
    {   const int G = gridDim.x, bid = blockIdx.x, nbj = G >> 3, t0 = bid >> 3;
        const int ntl = (t0 < NTILE) ? (NTILE - t0 + nbj - 1) / nbj : 0;
        lru_phase<0>(p, shm, bid & 7, t0, nbj, ntl); }
}

constexpr int CB_A = 0, CB_R = 2304, CB_BT = 4608, CB_KT = 6656, CB_VT = 8704, CB_T = 10752, CB_TK = 11264, CB_MT = 11776, CB_MK = 12288, CB_G = 12800, CB_BYTES = 13056;
constexpr int PS_B = 0, PS_K = 2304, PS_M = 4608  , PS_BYTES = 6144;
constexpr int LO_CB = 0, LO_PS = 8 * CB_BYTES;

__device__ __forceinline__ void wsync() { __builtin_amdgcn_wave_barrier(); asm volatile("s_waitcnt lgkmcnt(0)" ::: "memory"); __builtin_amdgcn_wave_barrier(); }
__device__ __forceinline__ bf16x8 mk8(unsigned a, unsigned b, unsigned c, unsigned d) { u32x4 w; w.x = a; w.y = b; w.z = c; w.w = d; return __builtin_bit_cast(bf16x8, w); }

__device__ __forceinline__ void produce_chunk(const Params& p, unsigned char* cb, unsigned char* ps, int seqrow0, int T, int d, int h, int tau0, int lane) {
    const bf16_t* Z = (const bf16_t*)(p.ws + WS_Z); const bf16_t* SCAN = (const bf16_t*)p.out; const float* INV = (const float*)(p.ws + WS_INV);
    bf16_t* At = (bf16_t*)(cb + CB_A); bf16_t* Rt = (bf16_t*)(cb + CB_R); bf16_t* Bs = (bf16_t*)(ps + PS_B); bf16_t* Ks = (bf16_t*)(ps + PS_K);
    const int k = lane, hc = h * 64 + k;
    const float kkw = p.in[18][hc], kaw = p.in[19][hc];
    float beta[16], kdv[16], cums[16]; unsigned short vraw[16], lwr[16], asr[16], rrw[16], krw[16]; float invv[16];
    float cum = 0.f, e_last = 1.0f;
#pragma unroll
    for (int i = 0; i < 16; ++i) {
        const int tau = tau0 + i, row = seqrow0 + (d ? T - 1 - tau : tau);
        const bf16_t* sp = SCAN + ((size_t)(d * NTOK + row) * 8 + h) * 128;
        const bf16_t* zr = Z + (size_t)row * DIN + h * 64 + k;
        lwr[i] = sp[k]; asr[i] = sp[64 + k]; rrw[i] = zr[ZR]; krw[i] = zr[ZK]; vraw[i] = zr[ZV]; invv[i] = INV[row * 8 + h];
    }
    __builtin_amdgcn_sched_barrier(0);
#pragma unroll
    for (int i = 0; i < 16; ++i) {
        const float lw = bf2f(lwr[i]), as = bf2f(asr[i]), r = bf2f(rrw[i]), kr = bf2f(krw[i]);
        const float kk = kr * kkw * invv[i], be = kk * as, kd = kr * (1.0f + (as - 1.0f) * kaw);
        const float e_prev = e_last; cum += lw; const float e_i = __expf(cum), e_neg = __builtin_amdgcn_rcpf(e_i); e_last = e_i;
        At[i * 72 + k] = f2bf(-kk * e_prev); Rt[i * 72 + k] = f2bf(r * e_i); Bs[i * 72 + k] = f2bf(be * e_neg); Ks[i * 72 + k] = f2bf(kd * e_neg);
        beta[i] = be * e_neg; kdv[i] = kd * e_neg; cums[i] = cum;
    }
    const float gam = e_last; ((float*)(cb + CB_G))[k] = gam;
    {   unsigned wb[8], wk[8], wv[8];
#pragma unroll
        for (int i = 0; i < 16; i += 2) {
            wb[i >> 1] = pk2(beta[i] * gam, beta[i + 1] * gam); wk[i >> 1] = pk2(kdv[i] * gam, kdv[i + 1] * gam); wv[i >> 1] = (unsigned)vraw[i] | ((unsigned)vraw[i + 1] << 16); }
        u32x4* bt = (u32x4*)(cb + CB_BT + k * 32); u32x4* kt = (u32x4*)(cb + CB_KT + k * 32); u32x4* vt = (u32x4*)(cb + CB_VT + k * 32);
        u32x4 w; w.x = wb[0]; w.y = wb[1]; w.z = wb[2]; w.w = wb[3]; bt[0] = w; w.x = wb[4]; w.y = wb[5]; w.z = wb[6]; w.w = wb[7]; bt[1] = w;
        w.x = wk[0]; w.y = wk[1]; w.z = wk[2]; w.w = wk[3]; kt[0] = w; w.x = wk[4]; w.y = wk[5]; w.z = wk[6]; w.w = wk[7]; kt[1] = w;
        w.x = wv[0]; w.y = wv[1]; w.z = wv[2]; w.w = wv[3]; vt[0] = w; w.x = wv[4]; w.y = wv[5]; w.z = wv[6]; w.w = wv[7]; vt[1] = w; }
    wsync();
    const int fr = lane & 15, fq = lane >> 4;
    {   f32x4 lab = {0.f, 0.f, 0.f, 0.f}, lak = lab, mrb = lab, mrk = lab;
#pragma unroll
        for (int m = 0; m < 2; ++m) {
            const bf16x8 aA = *(const bf16x8*)(At + fr * 72 + 32 * m + 8 * fq), aR = *(const bf16x8*)(Rt + fr * 72 + 32 * m + 8 * fq);
            const bf16x8 bB = *(const bf16x8*)(Bs + fr * 72 + 32 * m + 8 * fq), bK = *(const bf16x8*)(Ks + fr * 72 + 32 * m + 8 * fq);
            lab = __builtin_amdgcn_mfma_f32_16x16x32_bf16(aA, bB, lab, 0, 0, 0); lak = __builtin_amdgcn_mfma_f32_16x16x32_bf16(aA, bK, lak, 0, 0, 0);
            mrb = __builtin_amdgcn_mfma_f32_16x16x32_bf16(aR, bB, mrb, 0, 0, 0); mrk = __builtin_amdgcn_mfma_f32_16x16x32_bf16(aR, bK, mrk, 0, 0, 0); }
        bf16_t* oLK = (bf16_t*)(cb + CB_TK); bf16_t* oMB = (bf16_t*)(cb + CB_MT); bf16_t* oMK = (bf16_t*)(cb + CB_MK);
#pragma unroll
        for (int e = 0; e < 4; ++e) { const int i = 4 * fq + e, j = fr;
            oLK[i * 16 + j] = f2bf((j < i) ? lak[e] : 0.f); oMB[i * 16 + j] = f2bf((j <= i) ? mrb[e] : 0.f); oMK[i * 16 + j] = f2bf((j <= i) ? mrk[e] : 0.f); }
        float* Lab = (float*)(ps + PS_M);
#pragma unroll
        for (int e = 0; e < 4; ++e) Lab[(4 * fq + e) * 20 + fr] = lab[e];
        wsync();
        f32x4 Lr[16][4];
#pragma unroll
        for (int i = 1; i < 16; ++i)
#pragma unroll
            for (int j4 = 0; j4 < (i + 3) / 4; ++j4) Lr[i][j4] = *(const f32x4*)(Lab + i * 20 + 4 * j4);
        __builtin_amdgcn_sched_barrier(0);
        float Tc[16];
#pragma unroll
        for (int i = 0; i < 16; ++i) { float sacc = (i == fr) ? 1.0f : 0.0f;
#pragma unroll
            for (int j4 = 0; j4 < (i + 3) / 4; ++j4) {
#pragma unroll
                for (int e = 0; e < 4; ++e) if (4 * j4 + e < i) sacc += Lr[i][j4][e] * Tc[4 * j4 + e]; }
            Tc[i] = sacc; }
        bf16_t* oT = (bf16_t*)(cb + CB_T);
        if (fq == 0) {
#pragma unroll
            for (int i = 0; i < 16; ++i) oT[i * 16 + fr] = f2bf(Tc[i]); } }
}

__device__ __forceinline__ void consume_chunk(const unsigned char* cb, int vt, int lane, f32x4 (&S)[4], bf16_t* ybase  , int seqrow0, int T, int d, int tau0) {
    const int fr = lane & 15, fq = lane >> 4;
    const bf16_t* At = (const bf16_t*)(cb + CB_A); const bf16_t* Rt = (const bf16_t*)(cb + CB_R);
    const bf16x8 bS0 = mk8(pg8::cvt_pk_bf16(S[0][0], S[0][1]), pg8::cvt_pk_bf16(S[0][2], S[0][3]), pg8::cvt_pk_bf16(S[1][0], S[1][1]), pg8::cvt_pk_bf16(S[1][2], S[1][3]));
    const bf16x8 bS1 = mk8(pg8::cvt_pk_bf16(S[2][0], S[2][1]), pg8::cvt_pk_bf16(S[2][2], S[2][3]), pg8::cvt_pk_bf16(S[3][0], S[3][1]), pg8::cvt_pk_bf16(S[3][2], S[3][3]));
    const u32x2 a00 = *(const u32x2*)(At + fr * 72 + 4 * fq), a01 = *(const u32x2*)(At + fr * 72 + 16 + 4 * fq), a10 = *(const u32x2*)(At + fr * 72 + 32 + 4 * fq), a11 = *(const u32x2*)(At + fr * 72 + 48 + 4 * fq);
    const u32x2 r00 = *(const u32x2*)(Rt + fr * 72 + 4 * fq), r01 = *(const u32x2*)(Rt + fr * 72 + 16 + 4 * fq), r10 = *(const u32x2*)(Rt + fr * 72 + 32 + 4 * fq), r11 = *(const u32x2*)(Rt + fr * 72 + 48 + 4 * fq);
    const f32x4 zero = {0.f, 0.f, 0.f, 0.f};
    f32x4 A0 = __builtin_amdgcn_mfma_f32_16x16x32_bf16(mk8(a00.x, a00.y, a01.x, a01.y), bS0, zero, 0, 0, 0);
    A0 = __builtin_amdgcn_mfma_f32_16x16x32_bf16(mk8(a10.x, a10.y, a11.x, a11.y), bS1, A0, 0, 0, 0);
    f32x4 Y = __builtin_amdgcn_mfma_f32_16x16x32_bf16(mk8(r00.x, r00.y, r01.x, r01.y), bS0, zero, 0, 0, 0);
    Y = __builtin_amdgcn_mfma_f32_16x16x32_bf16(mk8(r10.x, r10.y, r11.x, r11.y), bS1, Y, 0, 0, 0);
    const u32x2 vf = *(const u32x2*)(cb + CB_VT + (16 * vt + fr) * 32 + 8 * fq);
    const u32x2 tt = *(const u32x2*)(cb + CB_T + fr * 32 + 8 * fq), lk = *(const u32x2*)(cb + CB_TK + fr * 32 + 8 * fq);
    const u32x2 mb = *(const u32x2*)(cb + CB_MT + fr * 32 + 8 * fq), mk = *(const u32x2*)(cb + CB_MK + fr * 32 + 8 * fq);
    const bf16x8 bAV = mk8(pg8::cvt_pk_bf16(A0[0], A0[1]), pg8::cvt_pk_bf16(A0[2], A0[3]), vf.x, vf.y);
    const f32x4 X = __builtin_amdgcn_mfma_f32_16x16x32_bf16(mk8(0u, 0u, lk.x, lk.y), bAV, A0, 0, 0, 0);
    const bf16x8 bXV = mk8(pg8::cvt_pk_bf16(X[0], X[1]), pg8::cvt_pk_bf16(X[2], X[3]), vf.x, vf.y);
    const f32x4 U = __builtin_amdgcn_mfma_f32_16x16x32_bf16(mk8(tt.x, tt.y, 0u, 0u), bXV, zero, 0, 0, 0);
    const bf16x8 bUV = mk8(pg8::cvt_pk_bf16(U[0], U[1]), pg8::cvt_pk_bf16(U[2], U[3]), vf.x, vf.y);
    Y = __builtin_amdgcn_mfma_f32_16x16x32_bf16(mk8(mb.x, mb.y, mk.x, mk.y), bUV, Y, 0, 0, 0);
#pragma unroll
    for (int kt = 0; kt < 4; ++kt) {
        const f32x4 g4 = *(const f32x4*)(cb + CB_G + (16 * kt + 4 * fq) * 4);
        const u32x2 bf = *(const u32x2*)(cb + CB_BT + (16 * kt + fr) * 32 + 8 * fq), kf = *(const u32x2*)(cb + CB_KT + (16 * kt + fr) * 32 + 8 * fq);
        S[kt] = __builtin_amdgcn_mfma_f32_16x16x32_bf16(mk8(bf.x, bf.y, kf.x, kf.y), bUV, S[kt] * g4, 0, 0, 0); }
#pragma unroll
    for (int e = 0; e < 4; ++e) { const int tau = tau0 + 4 * fq + e, row = seqrow0 + (d ? T - 1 - tau : tau); ybase[(size_t)row * 512] = f2bf(Y[e]); }
}

__device__ __forceinline__ void rwkv_scan_item(const Params& p, unsigned char* shm, int item) {
    const int tid = threadIdx.x, wid = tid >> 6, lane = tid & 63, fr = lane & 15, fq = lane >> 4;
    int sample, b, h, d;
    if (item < 128) { sample = 1; b = item >> 4; h = (item >> 1) & 7; d = item & 1; }
    else { const int ii = item - 128; sample = 0; b = ii >> 4; h = (ii >> 1) & 7; d = ii & 1; }
    const int T = sample ? 2048 : 256, seqrow0 = sample ? NPR + b * 2048 : b * 256, nsc = T / 64;
    const bool consumer = wid < 4; const int vt = wid & 3;
    f32x4 S[4];
    if (consumer) {
        if (sample) { const float* s0 = p.in[3] + ((size_t)((b * 2 + d) * 8 + h)) * 4096 + (16 * vt + fr) * 64 + 4 * fq;
#pragma unroll
            for (int kt = 0; kt < 4; ++kt) S[kt] = *(const f32x4*)(s0 + 16 * kt); }
        else {
#pragma unroll
            for (int kt = 0; kt < 4; ++kt) S[kt] = (f32x4){0.f, 0.f, 0.f, 0.f}; }
    }
    bf16_t* ybase = (bf16_t*)(p.ws + WS_YA) + (size_t)d * NTOK * 512 + h * 64 + 16 * vt + fr;
    for (int s = 0; s < nsc / 2; ++s) {
        produce_chunk(p, shm + LO_CB + wid * CB_BYTES, shm + LO_PS + wid * PS_BYTES, seqrow0, T, d, h, s * 128 + wid * 16, lane);
        __syncthreads();
        if (consumer) {
#pragma unroll 1
            for (int c = 0; c < 8; ++c) consume_chunk(shm + LO_CB + c * CB_BYTES, vt, lane, S, ybase, seqrow0, T, d, s * 128 + c * 16);
        }
        __syncthreads();
    }
    if (consumer && !sample) { float* so = p.out + OUT_RWKV + ((size_t)((b * 2 + d) * 8 + h)) * 4096 + (16 * vt + fr) * 64 + 4 * fq;
#pragma unroll
        for (int kt = 0; kt < 4; ++kt) *(f32x4*)(so + 16 * kt) = S[kt]; }
    __syncthreads();
}

__device__ __forceinline__ void phase_scan(const Params& p, unsigned char* shm) {
    const int bid = blockIdx.x, G = gridDim.x;
    if (G == 256) { if (bid < 128) rwkv_scan_item(p, shm, bid); else { rwkv_scan_item(p, shm, 128 + (bid - 128) * 2); rwkv_scan_item(p, shm, 129 + (bid - 128) * 2); } }
    else for (int item = bid; item < 384; item += G) rwkv_scan_item(p, shm, item);
    {   const int nlb = G >> 1, lb = bid - (G - nlb);
        if (lb >= 0) { const int nbj = nlb >> 3, t0 = lb >> 3; const int ntl = (t0 < NTILE) ? (NTILE - t0 + nbj - 1) / nbj : 0;
            lru_phase<1>(p, shm, lb & 7, t0, nbj, ntl); } }
}

__device__ __forceinline__ void phase_combine(const Params& p) {
    const int tid = threadIdx.x, wid = tid >> 6, lane = tid & 63, h = lane >> 3;
    const bf16_t* Z = (const bf16_t*)(p.ws + WS_Z); const bf16_t* YA = (const bf16_t*)(p.ws + WS_YA); const bf16_t* G = (const bf16_t*)(p.ws + WS_G);
    const float* BON = (const float*)(p.ws + WS_BON);
    bf16_t* Y = (bf16_t*)(p.ws + WS_ACT);
    float lg[8], lb[8];
#pragma unroll
    for (int q = 0; q < 8; ++q) { lg[q] = p.in[21][8 * lane + q]; lb[q] = p.in[22][8 * lane + q]; }
    const int per16 = (NTOK / 16 + (int)gridDim.x - 1) / (int)gridDim.x;
    for (int k16 = 0; k16 < per16; ++k16) { const int t16 = blockIdx.x * per16 + k16; if (t16 >= NTOK / 16) break;
        {
            u32x4 w0[2], w1[2], wv[2], wg[2]; float bon[2];
#pragma unroll
            for (int u = 0; u < 2; ++u) { const int row = t16 * 16 + wid * 2 + u;
                w0[u] = *(const u32x4*)(YA + (size_t)row * 512 + 8 * lane); w1[u] = *(const u32x4*)(YA + (size_t)(NTOK + row) * 512 + 8 * lane);
                wv[u] = *(const u32x4*)(Z + (size_t)row * DIN + ZV + 8 * lane); wg[u] = *(const u32x4*)(G + (size_t)row * 512 + 8 * lane); bon[u] = BON[row * 8 + h]; }
#pragma unroll
            for (int u = 0; u < 2; ++u) { const int row = t16 * 16 + wid * 2 + u;
                float a[8], b[8], vv[8], g[8], o[8]; unpack8(w0[u], a); unpack8(w1[u], b); unpack8(wv[u], vv); unpack8(wg[u], g);
                float s1 = 0.f;
#pragma unroll
                for (int q = 0; q < 8; ++q) { a[q] += b[q]; s1 += a[q]; }
                s1 = sum8(s1);
                const float mu = s1 * (1.0f / 64.0f);
                float s2 = 0.f;
#pragma unroll
                for (int q = 0; q < 8; ++q) { a[q] -= mu; s2 += a[q] * a[q]; }
                s2 = sum8(s2);
                const float rstd = rsqrtf(s2 * (1.0f / 64.0f) + 64e-5f);
#pragma unroll
                for (int q = 0; q < 8; ++q) o[q] = (a[q] * rstd * lg[q] + lb[q] + bon[u] * vv[q]) * g[q];
                *(u32x4*)(Y + (size_t)row * DM + 8 * lane) = pack8(o); }
        }
    }
}

__device__ __forceinline__ void phase_res1(const Params& p, unsigned char* shm) {
    float* sm = (float*)shm;
    const int tid = threadIdx.x, wid = tid >> 6, lane = tid & 63;
    const bf16_t* O1 = (const bf16_t*)(p.ws + WS_O1); const bf16_t* O1P = (const bf16_t*)(p.ws + WS_O1P); const bool split = false; bf16_t* H = (bf16_t*)(p.ws + WS_ACT);
    const int per16 = (NTOK / 16 + (int)gridDim.x - 1) / (int)gridDim.x; int cur_mrow = -1;
    auto body = [&](auto nr_tag, int row) { constexpr int NR = decltype(nr_tag)::value;
            f32x4 o[NR][4], x1[NR][4]; float ss[NR] = {}, s2[NR] = {};
            f32x4 g9[4], g10[4];
#pragma unroll
            for (int i = 0; i < 4; ++i) { g9[i] = *(const f32x4*)(p.in[9] + 4 * lane + 256 * i); g10[i] = *(const f32x4*)(p.in[10] + 4 * lane + 256 * i); }
#pragma unroll
            for (int u = 0; u < NR; ++u)
#pragma unroll
                for (int i = 0; i < 4; ++i) { const int r = row + (u >> 1) * 16 + (u & 1), j = 4 * lane + 256 * i;
                    if (!split || r < 16384) { const u32x2 w = *(const u32x2*)(O1 + (size_t)r * DM + j);
                        o[u][i] = (f32x4){__uint_as_float(w.x << 16), __uint_as_float(w.x & 0xffff0000u), __uint_as_float(w.y << 16), __uint_as_float(w.y & 0xffff0000u)}; }
                    else { f32x4 a = {0.f, 0.f, 0.f, 0.f};
#pragma unroll
                        for (int pp = 0; pp < 4; ++pp) { const u32x2 w = *(const u32x2*)(O1P + ((size_t)pp * 4096 + (r - 16384)) * DM + j);
                            a += (f32x4){__uint_as_float(w.x << 16), __uint_as_float(w.x & 0xffff0000u), __uint_as_float(w.y << 16), __uint_as_float(w.y & 0xffff0000u)}; }
                        o[u][i] = a; }
                    x1[u][i] = load_x4(p, r, j); }
#pragma unroll
            for (int u = 0; u < NR; ++u)
#pragma unroll
                for (int i = 0; i < 4; ++i) ss[u] += o[u][i][0] * o[u][i][0] + o[u][i][1] * o[u][i][1] + o[u][i][2] * o[u][i][2] + o[u][i][3] * o[u][i][3];
#pragma unroll
            for (int sh = 32; sh > 0; sh >>= 1) {
#pragma unroll
                for (int u = 0; u < NR; ++u) ss[u] += __shfl_xor(ss[u], sh); }
#pragma unroll
            for (int u = 0; u < NR; ++u) { const float rstd = rsqrtf(ss[u] * (1.0f / 1024.0f) + 1e-6f);
#pragma unroll
                for (int i = 0; i < 4; ++i) { const int j = 4 * lane + 256 * i; const f32x4 g = g9[i];
#pragma unroll
                    for (int e = 0; e < 4; ++e) { x1[u][i][e] += sm[j + e] * (o[u][i][e] * rstd * g[e]); s2[u] += x1[u][i][e] * x1[u][i][e]; }
                    __builtin_nontemporal_store(x1[u][i], (f32x4*)(p.out + (size_t)(row + (u >> 1) * 16 + (u & 1)) * DM + j)); } }
#pragma unroll
            for (int sh = 32; sh > 0; sh >>= 1) {
#pragma unroll
                for (int u = 0; u < NR; ++u) s2[u] += __shfl_xor(s2[u], sh); }
#pragma unroll
            for (int u = 0; u < NR; ++u) { const float rstd2 = rsqrtf(s2[u] * (1.0f / 1024.0f) + 1e-6f);
#pragma unroll
                for (int i = 0; i < 4; ++i) { const int j = 4 * lane + 256 * i; const f32x4 g = g10[i]; float h[4];
#pragma unroll
                    for (int e = 0; e < 4; ++e) h[e] = x1[u][i][e] * rstd2 * g[e] * (1.0f + sm[2048 + j + e]) + sm[1024 + j + e];
                    u32x2 w; w.x = pk2(h[0], h[1]); w.y = pk2(h[2], h[3]);
                    __builtin_nontemporal_store(w, (u32x2*)(H + (size_t)(row + (u >> 1) * 16 + (u & 1)) * DM + j)); } }
    };
    for (int k16 = 0; k16 < per16; ) {
        const int t16 = blockIdx.x * per16 + k16; if (t16 >= NTOK / 16) break;
        const int row = t16 * 16 + wid * 2, mrow = (t16 * 16 < NPR) ? 8 : ((t16 * 16 - NPR) >> 11);
        if (mrow != cur_mrow) { __syncthreads(); { float mv[6];
#pragma unroll
            for (int q = 0; q < 6; ++q) mv[q] = ((const float*)(p.ws + WS_MODF))[mrow * 6144 + 2048 + tid + 512 * q];
#pragma unroll
            for (int q = 0; q < 6; ++q) sm[tid + 512 * q] = mv[q]; } __syncthreads(); cur_mrow = mrow; }
        const int t16b = t16 + 1; const bool pair = (k16 + 1 < per16) && (t16b < NTOK / 16) && (((t16b * 16 < NPR) ? 8 : ((t16b * 16 - NPR) >> 11)) == mrow);
        if (pair) { body(std::integral_constant<int, 4>{}, row); k16 += 2; } else { body(std::integral_constant<int, 2>{}, row); k16 += 1; }
    }
    __syncthreads();
}

__device__ __forceinline__ void phase_final(const Params& p, unsigned char* shm) {
    float* sm = (float*)shm;
    const int tid = threadIdx.x, wid = tid >> 6, lane = tid & 63;
    const bf16_t* O2 = (const bf16_t*)(p.ws + WS_O2); const bf16_t* O2P = (const bf16_t*)(p.ws + WS_O2P); const bool split = (gridDim.x == 256);
    const int per16 = (NTOK / 16 + (int)gridDim.x - 1) / (int)gridDim.x; int cur_mrow = -1;
    auto body = [&](auto nr_tag, int row) { constexpr int NR = decltype(nr_tag)::value;
            f32x4 o[NR][4], x1[NR][4]; float ss[NR] = {};
#pragma unroll
            for (int u = 0; u < NR; ++u)
#pragma unroll
                for (int i = 0; i < 4; ++i) { const int r = row + (u >> 1) * 16 + (u & 1), j = 4 * lane + 256 * i;
                    if (!split || r < 16384) { const u32x2 w = *(const u32x2*)(O2 + (size_t)r * DM + j);
                        o[u][i] = (f32x4){__uint_as_float(w.x << 16), __uint_as_float(w.x & 0xffff0000u), __uint_as_float(w.y << 16), __uint_as_float(w.y & 0xffff0000u)}; }
                    else { f32x4 a = {0.f, 0.f, 0.f, 0.f};
#pragma unroll
                        for (int pp = 0; pp < 4; ++pp) { const u32x2 w = *(const u32x2*)(O2P + ((size_t)pp * 4096 + (r - 16384)) * DM + j);
                            a += (f32x4){__uint_as_float(w.x << 16), __uint_as_float(w.x & 0xffff0000u), __uint_as_float(w.y << 16), __uint_as_float(w.y & 0xffff0000u)}; }
                        o[u][i] = a; }
                    x1[u][i] = *(const f32x4*)(p.out + (size_t)r * DM + j); }
#pragma unroll
            for (int u = 0; u < NR; ++u)
#pragma unroll
                for (int i = 0; i < 4; ++i) ss[u] += o[u][i][0] * o[u][i][0] + o[u][i][1] * o[u][i][1] + o[u][i][2] * o[u][i][2] + o[u][i][3] * o[u][i][3];
#pragma unroll
            for (int sh = 32; sh > 0; sh >>= 1) {
#pragma unroll
                for (int u = 0; u < NR; ++u) ss[u] += __shfl_xor(ss[u], sh); }
#pragma unroll
            for (int u = 0; u < NR; ++u) { const float rstd = rsqrtf(ss[u] * (1.0f / 1024.0f) + 1e-6f);
#pragma unroll
                for (int i = 0; i < 4; ++i) { const int j = 4 * lane + 256 * i; const f32x4 g = *(const f32x4*)(p.in[11] + j);
#pragma unroll
                    for (int e = 0; e < 4; ++e) x1[u][i][e] += sm[j + e] * (o[u][i][e] * rstd * g[e]);
                    __builtin_nontemporal_store(x1[u][i], (f32x4*)(p.out + (size_t)(row + (u >> 1) * 16 + (u & 1)) * DM + j)); } }
    };
    for (int k16 = 0; k16 < per16; ) {
        const int t16 = blockIdx.x * per16 + k16; if (t16 >= NTOK / 16) break;
        const int row = t16 * 16 + wid * 2, mrow = (t16 * 16 < NPR) ? 8 : ((t16 * 16 - NPR) >> 11);
        if (mrow != cur_mrow) { __syncthreads(); { float mv[2];
#pragma unroll
            for (int q = 0; q < 2; ++q) mv[q] = ((const float*)(p.ws + WS_MODF))[mrow * 6144 + 5120 + tid + 512 * q];
#pragma unroll
            for (int q = 0; q < 2; ++q) sm[tid + 512 * q] = mv[q]; } __syncthreads(); cur_mrow = mrow; }
        const int t16b = t16 + 1; const bool pair = (k16 + 1 < per16) && (t16b < NTOK / 16) && (((t16b * 16 < NPR) ? 8 : ((t16b * 16 - NPR) >> 11)) == mrow);
        if (pair) { body(std::integral_constant<int, 4>{}, row); k16 += 2; } else { body(std::integral_constant<int, 2>{}, row); k16 += 1; }
    }
    __syncthreads();
}

template <class Epi>
__device__ __forceinline__ void run_gemm(unsigned char* shm, const bf16_t* A, const bf16_t* Bt, int M, int N, int K, const Epi& E) {
    pg8::Gemm g; g.A = A; g.Bt = Bt; g.M = M; g.N = N; g.K = K;
    pg8::StaticOrder S; S.init(M, N, (int)gridDim.x, (int)blockIdx.x, K);
    pg8::gemm_phase<Epi, pg8::StaticOrder>((PG8_LAS unsigned char*)shm, g, S, E);
}

template <class Epi>
__device__ __forceinline__ void run_gemm_split(unsigned char* shm, const bf16_t* A, const bf16_t* Bt, int M, int N, int K, const Epi& E) {
    pg8::Gemm g; g.A = A; g.Bt = Bt; g.M = M; g.N = N; g.K = K;
    pg8::SplitTailOrder S; S.init((int)blockIdx.x, K);
    pg8::gemm_phase<Epi, pg8::SplitTailOrder>((PG8_LAS unsigned char*)shm, g, S, E);
}

__global__ void __launch_bounds__(512, 2) fwd_megakernel(Params p, int ph_lo, int ph_hi, int coop) {
    extern __shared__ __attribute__((aligned(16))) unsigned char shm[];
    cg::grid_group grid = cg::this_grid();
    volatile LAS unsigned* xbst = (volatile LAS unsigned*)(shm + LDS_BYTES - 16);
    if (threadIdx.x == 0) { xbst[0] = 0u; xbst[1] = 0u; }
    __syncthreads();
    XcdBarrier xb = xcd_barrier_post((unsigned*)(p.ws + WS_BAR), xbst);
    if (coop == 2) grid.sync();
#ifndef PH_MASK
#define PH_MASK 0x7ff
#endif
#define PH_ON(k) ((PH_MASK & (1 << (k))) && ph_lo <= (k) && (k) < ph_hi)
#define PH_R(k) ((PH_REP >> (k)) & 1)
#define PH_SYNC(k) do { if (coop && (k) + 1 < ph_hi && ph_lo <= (k)) { xcd_barrier(xb); } } while (0)
    if (PH_ON(0)) for (int rep = 0; rep <= PH_R(0); ++rep) phase0(p, shm);
    PH_SYNC(0);
    if (PH_ON(1)) for (int rep = 0; rep <= PH_R(1); ++rep) phase_h1(p, shm);
    PH_SYNC(1);
    if (PH_ON(2)) for (int rep = 0; rep <= PH_R(2); ++rep) { EpiB16<2> E; E.O = (bf16_t*)(p.ws + WS_Z); E.ldc = DIN; E.ncols = DIN;
        run_gemm(shm, (const bf16_t*)(p.ws + WS_ACT), (const bf16_t*)(p.ws + WS_WINT), NTOK, DINP, 1024, E);
        if (gridDim.x == 256 && blockIdx.x >= 192) deferred_transposes(p, shm, 0, (int)blockIdx.x - 192, 64); }
    PH_SYNC(2);
    if (PH_ON(3)) for (int rep = 0; rep <= PH_R(3); ++rep) phase_prep(p, shm);
    PH_SYNC(3);
    if (PH_ON(4)) for (int rep = 0; rep <= PH_R(4); ++rep) phase_scan(p, shm);
    PH_SYNC(4);
    if (PH_ON(5)) for (int rep = 0; rep <= PH_R(5); ++rep) phase_combine(p);
    PH_SYNC(5);
    if (PH_ON(6)) for (int rep = 0; rep <= PH_R(6); ++rep) { EpiSplitB16 E; E.O = (bf16_t*)(p.ws + WS_O1); E.P = (bf16_t*)(p.ws + WS_O1P);
        run_gemm(shm, (const bf16_t*)(p.ws + WS_ACT), (const bf16_t*)(p.ws + WS_WOUTT), NTOK, 1024, 1024, E);
        if (gridDim.x == 256 && blockIdx.x >= 64) deferred_transposes(p, shm, 1, (int)blockIdx.x - 64, 192); }
    PH_SYNC(6);
    if (PH_ON(7)) for (int rep = 0; rep <= PH_R(7); ++rep) phase_res1(p, shm);
    PH_SYNC(7);
    if (PH_ON(8)) for (int rep = 0; rep <= PH_R(8); ++rep) { EpiB16<1> E; E.O = (bf16_t*)(p.ws + WS_F); E.ldc = DFF; E.ncols = DFF;
        run_gemm(shm, (const bf16_t*)(p.ws + WS_ACT), (const bf16_t*)(p.ws + WS_W1T), NTOK, DFF, 1024, E); }
    PH_SYNC(8);
    if (PH_ON(9)) for (int rep = 0; rep <= PH_R(9); ++rep) { EpiSplitB16 E; E.O = (bf16_t*)(p.ws + WS_O2); E.P = (bf16_t*)(p.ws + WS_O2P);
        if (gridDim.x == 256) run_gemm_split(shm, (const bf16_t*)(p.ws + WS_F), (const bf16_t*)(p.ws + WS_W2T), NTOK, 1024, DFF, E);
        else run_gemm(shm, (const bf16_t*)(p.ws + WS_F), (const bf16_t*)(p.ws + WS_W2T), NTOK, 1024, DFF, E); }
    PH_SYNC(9);
    if (PH_ON(10)) phase_final(p, shm);
}
}

extern "C" void kernel_launch(void* const* d_in, const int* in_sizes, int n_in, void* d_out, int out_size, void* d_ws, size_t ws_size, hipStream_t stream) {
    static int grid_blocks = 0;
    if (grid_blocks == 0) {
        int dev = 0, cus = 0, per_cu = 0;
        hipGetDevice(&dev);
        hipDeviceGetAttribute(&cus, hipDeviceAttributeMultiprocessorCount, dev);
        if (hipFuncSetAttribute((const void*)fwd_megakernel, hipFuncAttributeMaxDynamicSharedMemorySize, LDS_BYTES) != hipSuccess) { fprintf(stderr, "hipFuncSetAttribute failed\n"); }
        if (hipOccupancyMaxActiveBlocksPerMultiprocessor(&per_cu, (const void*)fwd_megakernel, 512, LDS_BYTES) != hipSuccess || per_cu < 1) { fprintf(stderr, "occupancy query: %d\n", per_cu); per_cu = 1; }
        (void)hipGetLastError();
        grid_blocks = cus * per_cu;
        if (n_in != 33 || ws_size < 256 * MiB) fprintf(stderr, "unexpected n_in %d / ws_size %zu\n", n_in, ws_size);
    }
    Params p{};
    for (int i = 0; i < 33; ++i) p.in[i] = (const float*)d_in[i];
    p.out = (float*)d_out; p.ws = (unsigned char*)d_ws;
#if MK_LAUNCHES == 1
    (void)hipMemsetAsync((unsigned char*)d_ws + WS_BAR, 0, XCD_BAR_WORDS * sizeof(unsigned), stream);
    int lo = 0, hi = 11, coop = 1;
    void* args[] = {&p, &lo, &hi, &coop};
    hipError_t e = hipLaunchCooperativeKernel((const void*)fwd_megakernel, dim3(grid_blocks), dim3(512), args, LDS_BYTES, stream);
    if (e != hipSuccess) fprintf(stderr, "cooperative launch failed: %s (grid %d)\n", hipGetErrorString(e), grid_blocks);
#else
    for (int ph = 0; ph < 11; ++ph) for (int rep = 0; rep <= ((HOST_REP >> ph) & 1); ++rep) hipLaunchKernelGGL(fwd_megakernel, dim3(grid_blocks), dim3(512), LDS_BYTES, stream, p, ph, ph + 1, 0);
#endif
}
```

```cpp
#include <hip/hip_runtime.h>
#include <hip/hip_cooperative_groups.h>
#include <cstdio>
#include <type_traits>
namespace cg = cooperative_groups;
#ifndef PH_REP
#define PH_REP 0
#endif
#define PH_R(k) ((PH_REP >> (k)) & 1)
#ifndef HOST_REP
#define HOST_REP 0
#endif
#ifndef LRU_LO
#define LRU_LO 3
#endif
#ifndef MK_LAUNCHES
#define MK_LAUNCHES 1
#endif
namespace pg8 {
#define PG8_LAS __attribute__((address_space(3)))
typedef unsigned short bf16_t;
typedef short bf16x8 __attribute__((ext_vector_type(8)));
typedef float f32x4 __attribute__((ext_vector_type(4)));
typedef unsigned u32x4 __attribute__((ext_vector_type(4)));
constexpr int BM = 256, BK = 64, HALF = 128, HTB = HALF * BK * 2  , STAGE_BYTES = 8 * HTB, NXCD = 8, WGM = 8;

__host__ __device__ __forceinline__ int lds_byte(int r, int c) { const int st = (r >> 4) * 2 + (c >> 5), rr = r & 15, cc = c & 31, ob = rr * 64 + cc * 2; return st * 1024 + (ob ^ (((ob >> 9) & 1) << 5)); }
__host__ __device__ __forceinline__ void stage_rc(int b, int& R, int& C) { const int st = b / 1024, sb = b % 1024, swz = sb ^ (((sb >> 9) & 1) << 5); R = (st >> 1) * 16 + swz / 64; C = (st & 1) * 32 + (swz % 64) / 2; }
__host__ __device__ __forceinline__ int perm32(int rho) { const int n = rho >> 4, i = rho & 15; return 8 * (i >> 2) + 4 * n + (i & 3); }

struct Unit { int pm, pn, k0, nk, part; };
struct Gemm { const bf16_t* A; const bf16_t* Bt; int M, N, K; };

struct StaticOrder {
    int nM, nN, nwg, G, c;
    int nkt;
    __host__ __device__ void init(int M, int N, int G_, int c_, int K_) { nM = M / BM; nN = N / BM; nwg = nM * nN; G = G_; c = c_; nkt = K_ / BK; }
    __host__ __device__ bool next(int i, Unit& u) const {
        const long L = (long)i * G + c; if (L >= nwg) return false;
        int wgid = (int)L; { const int q = nwg / NXCD, r = nwg % NXCD, xcd = wgid % NXCD, off = wgid / NXCD; wgid = (xcd < r ? xcd * (q + 1) : r * (q + 1) + (xcd - r) * q) + off; }
        const int nig = WGM * nN, gid = wgid / nig, fm = gid * WGM, gsz = (nM - fm) < WGM ? (nM - fm) : WGM;
        u.pm = fm + ((wgid % nig) % gsz); u.pn = (wgid % nig) / gsz; u.k0 = 0; u.nk = nkt; u.part = -1; return true;
    }
    __device__ __forceinline__ void a_ready(const Unit&) const {}
    __device__ __forceinline__ void done(const Unit&) const {}
};
typedef __bf16 bf16v2_t __attribute__((ext_vector_type(2)));
__device__ __forceinline__ unsigned cvt_pk_bf16(float lo, float hi) { bf16v2_t v; v.x = (__bf16)lo; v.y = (__bf16)hi; return __builtin_bit_cast(unsigned, v); }
struct SplitTailOrder {
    int c, nkt;
    __host__ __device__ void init(int c_, int K_) { c = c_; nkt = K_ / BK; }
    __host__ __device__ bool next(int i, Unit& u) const {
        const int x = c & 7, idx = c >> 3;
        if (i == 0) { const int w = x * 32 + idx; u.pm = w >> 2; u.pn = w & 3; u.k0 = 0; u.nk = nkt; u.part = -1; return true; }
        if (i == 1) { const int t = x * 8 + (idx >> 2), part = idx & 3; u.pm = 64 + (t >> 2); u.pn = t & 3; u.nk = nkt / 4; u.k0 = part * (nkt / 4) * BK; u.part = part; return true; }
        return false;
    }
    __device__ __forceinline__ void a_ready(const Unit&) const {}
    __device__ __forceinline__ void done(const Unit&) const {}
};
template <class Epi, class Sched>
__device__ __forceinline__ void gemm_phase(PG8_LAS unsigned char* lds, const Gemm g, const Sched& S, const Epi& E) {
    const int tid = threadIdx.x, wid = __builtin_amdgcn_readfirstlane(tid >> 6), lane = tid & 63, wr = wid >> 2, wc = wid & 3, fr = lane & 15, fq = lane >> 4;
    const int K = g.K;
    unsigned voffA[2], voffB[2];
#pragma unroll
    for (int i = 0; i < 2; ++i) { int R, C; stage_rc(tid * 16 + i * 8192, R, C); const int Rb = Epi::PERM ? ((R & ~31) + perm32(R & 31)) : R;
        voffA[i] = (unsigned)(R * K + C) * 2u; voffB[i] = (unsigned)(Rb * K + C) * 2u; }
    const size_t kstep = (size_t)(BK * 2);
    const size_t hstep = (size_t)HALF * K * 2;
    const size_t tstep = 2 * hstep;
    const unsigned ldsw = (unsigned)wid * 1024u;
    const int aoff = lds_byte(wr * 64 + fr, fq * 8), boff = lds_byte(wc * 32 + fr, fq * 8);
#define PG8_SA(b, h) (((b) * 2 + (h)) * HTB)
#define PG8_SB(b, h) ((4 + (b) * 2 + (h)) * HTB)
#define PG8_STAGE(bufoff, gbase, voff) do { _Pragma("unroll") for (int _i = 0; _i < 2; ++_i) \
        __builtin_amdgcn_global_load_lds((const unsigned*)((const char*)(gbase) + (voff)[_i]), (PG8_LAS unsigned*)(lds + (bufoff) + ldsw + _i * 8192), 16, 0, 0); } while (0)
#define PG8_LDA(dst, b, h) do { _Pragma("unroll") for (int m = 0; m < 4; ++m) _Pragma("unroll") for (int k = 0; k < 2; ++k) dst[m][k] = *(const PG8_LAS bf16x8*)(lds + PG8_SA(b, h) + aoff + m * 2048 + k * 1024); } while (0)
#define PG8_LDB(dst, b, h) do { _Pragma("unroll") for (int n = 0; n < 2; ++n) _Pragma("unroll") for (int k = 0; k < 2; ++k) dst[n][k] = *(const PG8_LAS bf16x8*)(lds + PG8_SB(b, h) + boff + n * 2048 + k * 1024); } while (0)
#define PG8_MMA(ai, bj, At, Bt) do { __builtin_amdgcn_s_setprio(1); _Pragma("unroll") for (int m = 0; m < 4; ++m) _Pragma("unroll") for (int n = 0; n < 2; ++n) _Pragma("unroll") for (int k = 0; k < 2; ++k) \
        acc[ai][bj][m][n] = __builtin_amdgcn_mfma_f32_16x16x32_bf16(Bt[n][k], At[m][k], acc[ai][bj][m][n], 0, 0, 0); __builtin_amdgcn_s_setprio(0); } while (0)
#define PG8_WAIT_V(n) asm volatile("s_waitcnt vmcnt(" #n ")" ::: "memory")
#define PG8_WAIT_L(n) asm volatile("s_waitcnt lgkmcnt(" #n ")" ::: "memory")
#define PG8_BAR __builtin_amdgcn_s_barrier()
#define PG8_SCHED __builtin_amdgcn_sched_barrier(0)
    Unit cur, nxt; int ui = 0;
    if (!S.next(0, cur)) return;
    f32x4 acc[2][2][4][2];
#pragma unroll
    for (int a = 0; a < 2; ++a)
#pragma unroll
        for (int b = 0; b < 2; ++b)
#pragma unroll
            for (int m = 0; m < 4; ++m)
#pragma unroll
                for (int n = 0; n < 2; ++n) acc[a][b][m][n] = (f32x4){0.f, 0.f, 0.f, 0.f};
    bf16x8 At[4][2], B0[2][2], B1[2][2];
    const char* cA = (const char*)g.A + (size_t)cur.pm * tstep + (size_t)cur.k0 * 2; const char* cB = (const char*)g.Bt + (size_t)cur.pn * tstep + (size_t)cur.k0 * 2;
    S.a_ready(cur);
    PG8_STAGE(PG8_SB(0, 0), cB, voffB); PG8_STAGE(PG8_SA(0, 0), cA, voffA); PG8_STAGE(PG8_SB(0, 1), cB + hstep, voffB); PG8_STAGE(PG8_SA(0, 1), cA + hstep, voffA);
    if (wr == 1) PG8_BAR;
    PG8_WAIT_V(4); PG8_BAR;
    PG8_STAGE(PG8_SB(1, 0), cB + kstep, voffB); PG8_STAGE(PG8_SA(1, 0), cA + kstep, voffA); PG8_STAGE(PG8_SB(1, 1), cB + hstep + kstep, voffB);
    PG8_WAIT_V(6); PG8_BAR;
    for (;;) {
        const bool has_next = S.next(ui + 1, nxt);
        const char* nA = has_next ? (const char*)g.A + (size_t)nxt.pm * tstep + (size_t)nxt.k0 * 2 : cA; const char* nB = has_next ? (const char*)g.Bt + (size_t)nxt.pn * tstep + (size_t)nxt.k0 * 2 : cB;
        const int nt = cur.nk;
        for (int t = 0; t < nt; t += 2) {
            const bool last = (t == nt - 2);
            const char* a1 = cA + (size_t)(t + 1) * kstep;
            const char* a2 = last ? nA : cA + (size_t)(t + 2) * kstep; const char* b2 = last ? nB : cB + (size_t)(t + 2) * kstep;
            const char* a3 = a2 + kstep; const char* b3 = b2 + kstep;
            if (last && has_next) S.a_ready(nxt);
            PG8_LDB(B0, 0, 0); PG8_SCHED; PG8_LDA(At, 0, 0); PG8_STAGE(PG8_SA(1, 1), a1 + hstep, voffA);
            PG8_WAIT_L(8); PG8_BAR; PG8_WAIT_L(0); PG8_MMA(0, 0, At, B0); PG8_BAR; PG8_SCHED;
            PG8_LDB(B1, 0, 1); PG8_STAGE(PG8_SB(0, 0), b2, voffB);
            PG8_BAR; PG8_WAIT_L(0); PG8_MMA(0, 1, At, B1); PG8_BAR;
            PG8_LDA(At, 0, 1); PG8_STAGE(PG8_SA(0, 0), a2, voffA);
            PG8_BAR; PG8_WAIT_L(0); PG8_MMA(1, 0, At, B0); PG8_BAR; PG8_SCHED;
            PG8_STAGE(PG8_SB(0, 1), b2 + hstep, voffB);
            PG8_WAIT_V(6); PG8_BAR; PG8_MMA(1, 1, At, B1); PG8_BAR;
            PG8_LDB(B0, 1, 0); PG8_SCHED; PG8_LDA(At, 1, 0); PG8_STAGE(PG8_SA(0, 1), a2 + hstep, voffA);
            PG8_WAIT_L(8); PG8_BAR; PG8_WAIT_L(0); PG8_MMA(0, 0, At, B0); PG8_BAR; PG8_SCHED;
            PG8_LDB(B1, 1, 1); PG8_STAGE(PG8_SB(1, 0), b3, voffB);
            PG8_BAR; PG8_WAIT_L(0); PG8_MMA(0, 1, At, B1); PG8_BAR;
            PG8_LDA(At, 1, 1); PG8_STAGE(PG8_SA(1, 0), a3, voffA);
            PG8_BAR; PG8_WAIT_L(0); PG8_MMA(1, 0, At, B0); PG8_BAR; PG8_SCHED;
            PG8_STAGE(PG8_SB(1, 1), b3 + hstep, voffB);
            PG8_WAIT_V(6); PG8_BAR; PG8_MMA(1, 1, At, B1); PG8_BAR;
        }
        if constexpr (!Epi::AFTER_DRAIN) { E(acc, cur, wr, wc, fr, fq); S.done(cur); }
        if (!has_next) break;
#pragma unroll
        for (int a = 0; a < 2; ++a)
#pragma unroll
            for (int b = 0; b < 2; ++b)
#pragma unroll
                for (int m = 0; m < 4; ++m)
#pragma unroll
                    for (int n = 0; n < 2; ++n) acc[a][b][m][n] = (f32x4){0.f, 0.f, 0.f, 0.f};
        cur = nxt; cA = nA; cB = nB; ++ui;
    }
    PG8_WAIT_V(0);
    if (wr == 0) PG8_BAR;
    PG8_BAR;
    if constexpr (Epi::AFTER_DRAIN) { E.fused(acc, cur, wr, wc, fr, fq, lds, wid, lane); S.done(cur); }
#undef PG8_SA
#undef PG8_SB
#undef PG8_STAGE
#undef PG8_LDA
#undef PG8_LDB
#undef PG8_MMA
#undef PG8_WAIT_V
#undef PG8_WAIT_L
#undef PG8_BAR
#undef PG8_SCHED
}
}

#define XB_TMO      128
#define XB_XCNT(j)  (256  + 64 * (j))
#define XB_XSUB(j)  (1280 + 64 * (j))
#define XB_XGEN(j)  (2304 + 64 * (j))
#define XB_TOP      3328
#define XB_TOPGEN   3392
#define XCD_BAR_WORDS 3456
#define XB_SPIN_CAP (1u << 18)
#define LAS __attribute__((address_space(3)))

__device__ __forceinline__ unsigned xb_ld(unsigned* p)              { return __hip_atomic_load(p, __ATOMIC_RELAXED, __HIP_MEMORY_SCOPE_AGENT); }
__device__ __forceinline__ unsigned xb_add(unsigned* p, unsigned v) { return __hip_atomic_fetch_add(p, v, __ATOMIC_RELAXED, __HIP_MEMORY_SCOPE_AGENT); }
__device__ __forceinline__ unsigned xb_xcc_id() { return (unsigned)__builtin_amdgcn_s_getreg((3 << 11) | 20) & 0xFu; }
#define XB_SPIN(cond, bar) do { unsigned _sp = 0; while (cond) { __builtin_amdgcn_s_sleep(1); \
    if ((++_sp & 255u) == 0u) { if (xb_ld(&(bar)[XB_TMO])) break; if (_sp > XB_SPIN_CAP) { atomicAdd(&(bar)[XB_TMO], 1u); break; } } } } while (0)

struct XcdBarrier {
    unsigned* bar; unsigned x;
    volatile LAS unsigned* st;
};

__device__ __forceinline__ XcdBarrier xcd_barrier_post(unsigned* bar, volatile LAS unsigned* st) {
    XcdBarrier b; b.bar = bar; b.x = xb_xcc_id(); b.st = st;
    if (threadIdx.x == 0) (void)xb_add(&bar[XB_XCNT(b.x)], 1u);
    return b;
}
__device__ __forceinline__ void xcd_barrier_complete(unsigned* bar, unsigned x, unsigned& nloc, unsigned& nx) {
    const unsigned G = gridDim.x * gridDim.y * gridDim.z;
    unsigned sum, cnt, mine, sp = 0u;
    for (;;) {
        sum = 0u; cnt = 0u; mine = 0u;
#pragma unroll
        for (unsigned j = 0; j < 16; ++j) { const unsigned c = xb_ld(&bar[XB_XCNT(j)]); sum += c; cnt += (c > 0u) ? 1u : 0u; mine = (j == x) ? c : mine; }
        if (sum == G) break;
        __builtin_amdgcn_s_sleep(1);
        if ((++sp & 255u) == 0u) { if (xb_ld(&bar[XB_TMO])) break; if (sp > XB_SPIN_CAP) { atomicAdd(&bar[XB_TMO], 1u); break; } }
    }
    nloc = mine > 0u ? mine : 1u; nx = cnt > 0u ? cnt : 1u;
}

__device__ __forceinline__ void xcd_barrier(const XcdBarrier& b) {
    asm volatile("s_waitcnt vmcnt(0)" ::: "memory");
    __syncthreads();
    if (threadIdx.x == 0) {
        unsigned* bar = b.bar;
        __builtin_amdgcn_s_waitcnt(0);
        unsigned nloc = b.st[0], nx = b.st[1];
        if (nloc == 0u) { xcd_barrier_complete(bar, b.x, nloc, nx); b.st[0] = nloc; b.st[1] = nx; }
        const unsigned old = xb_add(&bar[XB_XSUB(b.x)], 1u);
        const unsigned gen = old / nloc;
        if (old + 1u == (gen + 1u) * nloc) {
            __builtin_amdgcn_fence(__ATOMIC_RELEASE, "agent");
            asm volatile("s_waitcnt vmcnt(0)" ::: "memory");
            const unsigned og = xb_add(&bar[XB_TOP], 1u);
            const unsigned tg = og / nx;
            if (og + 1u == (tg + 1u) * nx) xb_add(&bar[XB_TOPGEN], 1u);
            else XB_SPIN(xb_ld(&bar[XB_TOPGEN]) == tg, bar);
            __builtin_amdgcn_fence(__ATOMIC_ACQUIRE, "agent");
            xb_add(&bar[XB_XGEN(b.x)], 1u);
            asm volatile("s_waitcnt vmcnt(0)" ::: "memory");
        } else {
            XB_SPIN(xb_ld(&bar[XB_XGEN(b.x)]) == gen, bar);
            __builtin_amdgcn_fence(__ATOMIC_ACQUIRE, "agent");
            asm volatile("s_waitcnt vmcnt(0)" ::: "memory");
        }
    }
    __syncthreads();
}

namespace {
using pg8::bf16_t; using pg8::bf16x8; using pg8::f32x4; using pg8::u32x4;
typedef unsigned u32x2 __attribute__((ext_vector_type(2)));

constexpr int DM = 1024, NTOK = 20480, NPR = 4096, DIN = 2944, DINP = 3072, DFF = 4096;
constexpr int ZR = 0, ZK = 512, ZV = 1024, ZXW = 1536, ZXA = 1664, ZXG = 1792, ZXB = 1920, ZGB = 2432;
constexpr int NTILE = NTOK / 64;
constexpr size_t MiB = 1048576;
constexpr size_t WS_W2T = 0;
constexpr size_t WS_WUPT = 8 * MiB;
constexpr size_t WS_AUPT = WS_WUPT + 131072;
constexpr size_t WS_GUPT = WS_AUPT + 131072;
constexpr size_t WS_WAT = WS_GUPT + 131072;
constexpr size_t WS_WXT = WS_WAT + 131072;
constexpr size_t WS_ROWTAB = WS_WXT + 131072;
constexpr size_t WS_COLTAB = WS_ROWTAB + 65536;
constexpr size_t WS_MODPART = 9 * MiB;
constexpr size_t WS_BAR = 12 * MiB + 512 * 1024;
constexpr size_t WS_MODF = WS_BAR + 65536;
constexpr size_t WS_F = 13 * MiB;
constexpr size_t WS_Z = WS_F;
constexpr size_t WS_YA = WS_F + 115 * MiB;
constexpr size_t WS_O1 = WS_F;
constexpr size_t WS_O1P = WS_F + 40 * MiB;
constexpr size_t WS_C = 173 * MiB;
constexpr size_t WS_WINT = WS_C;
constexpr size_t WS_WOUTT = WS_C + 6 * MiB;
constexpr size_t WS_W1T = WS_C + 8 * MiB;
constexpr size_t WS_ACT = WS_C + 16 * MiB;
constexpr size_t WS_G = WS_C + 56 * MiB;
constexpr size_t WS_INV = WS_C + 76 * MiB;
constexpr size_t WS_BON = WS_INV + 655360;
constexpr size_t WS_CAR = WS_BON + 655360;
constexpr size_t WS_O2 = WS_C;
constexpr size_t WS_O2P = WS_C + 40 * MiB;
constexpr size_t OUT_RWKV = (size_t)NTOK * DM;
constexpr size_t OUT_LRU = OUT_RWKV + 16 * 2 * 8 * 4096;

constexpr int LDS_BYTES = 154 * 1024;

struct Params {
    const float* in[33];
    float* out;
    unsigned char* ws;
};

__device__ __forceinline__ float bf2f(unsigned short b) { return __uint_as_float(((unsigned)b) << 16); }
__device__ __forceinline__ unsigned short f2bf(float f) { return __builtin_bit_cast(unsigned short, (__bf16)f); }
__device__ __forceinline__ unsigned pk2(float lo, float hi) { return pg8::cvt_pk_bf16(lo, hi); }
__device__ __forceinline__ void unpack8(const u32x4 w, float* f) {
    f[0] = __uint_as_float(w.x << 16); f[1] = __uint_as_float(w.x & 0xffff0000u);
    f[2] = __uint_as_float(w.y << 16); f[3] = __uint_as_float(w.y & 0xffff0000u);
    f[4] = __uint_as_float(w.z << 16); f[5] = __uint_as_float(w.z & 0xffff0000u);
    f[6] = __uint_as_float(w.w << 16); f[7] = __uint_as_float(w.w & 0xffff0000u);
}
__device__ __forceinline__ u32x4 pack8(const float* f) { u32x4 w; w.x = pk2(f[0], f[1]); w.y = pk2(f[2], f[3]); w.z = pk2(f[4], f[5]); w.w = pk2(f[6], f[7]); return w; }
__device__ __forceinline__ float sigmoidf_(float x) { return __builtin_amdgcn_rcpf(1.0f + __expf(-x)); }
__device__ __forceinline__ float softplusf_(float y) {
    if (y > 15.0f) return y;
    const float e = __expf(y), u = 1.0f + e;
    return (u == 1.0f) ? e : __logf(u) * (e * __builtin_amdgcn_rcpf(u - 1.0f));
}
__device__ __forceinline__ float tanhf_(float x) { const float e = __expf(2.0f * x); return 1.0f - 2.0f * __builtin_amdgcn_rcpf(e + 1.0f); }
__device__ __forceinline__ float wave_sum(float v) {
#pragma unroll
    for (int o = 32; o > 0; o >>= 1) v += __shfl_xor(v, o);
    return v;
}
__device__ __forceinline__ float sum8(float v) { v += __shfl_xor(v, 1); v += __shfl_xor(v, 2); v += __shfl_xor(v, 4); return v; }

struct TileInfo { int row0; int mrow; int b; int t0; int T; int seqrow0; int sample; int tile0; int ntile; };
__device__ __forceinline__ TileInfo tile_info(int tile) {
    TileInfo ti; ti.row0 = tile * 64;
    if (tile < 64) { ti.sample = 0; ti.b = tile >> 2; ti.t0 = (tile & 3) * 64; ti.T = 256; ti.mrow = 8; ti.seqrow0 = ti.b * 256; ti.tile0 = ti.b * 4; ti.ntile = 4; }
    else { const int s = tile - 64; ti.sample = 1; ti.b = s >> 5; ti.t0 = (s & 31) * 64; ti.T = 2048; ti.mrow = ti.b; ti.seqrow0 = NPR + ti.b * 2048; ti.tile0 = 64 + ti.b * 32; ti.ntile = 32; }
    return ti;
}
__device__ __forceinline__ f32x4 load_x4(const Params& p, int row, int j) {
    if (row < NPR) return *(const f32x4*)(p.in[0] + (size_t)row * DM + j);
    const int r = row - NPR, t = r & 2047;
    f32x4 x = *(const f32x4*)(p.in[1] + (size_t)r * DM + j);
    const float* tab = (j < 512) ? (const float*)(p.ws + WS_ROWTAB) + (t >> 6) * 512 + j : (const float*)(p.ws + WS_COLTAB) + (t & 63) * 512 + (j - 512);
    const f32x4 e = *(const f32x4*)tab;
    return x + e;
}
__device__ __forceinline__ float mod_val(const Params& p, int mrow, int col) {
    const float* mp = (const float*)(p.ws + WS_MODPART);
    float s = p.in[7][col];
#pragma unroll
    for (int ks = 0; ks < 16; ++ks) s += mp[(size_t)(ks * 9 + mrow) * 6144 + col];
    return s;
}

__device__ __forceinline__ f32x4 mm16(const bf16_t* A, int lda, const bf16_t* BT, int ldb, int K, int lane) {
    const int fr = lane & 15, fq = lane >> 4;
    f32x4 acc = {0.f, 0.f, 0.f, 0.f};
    for (int kk = 0; kk < K; kk += 32) {
        const bf16x8 a = *(const bf16x8*)(A + fr * lda + kk + 8 * fq);
        const bf16x8 b = *(const bf16x8*)(BT + (size_t)fr * ldb + kk + 8 * fq);
        acc = __builtin_amdgcn_mfma_f32_16x16x32_bf16(a, b, acc, 0, 0, 0);
    }
    return acc;
}

template <int ACT> struct EpiB16 {
    static constexpr bool PERM = true, AFTER_DRAIN = false;
    bf16_t* O; int ldc; int ncols;
    __device__ __forceinline__ void operator()(const f32x4 (&acc)[2][2][4][2], const pg8::Unit& u, int wr, int wc, int fr, int fq) const {
        const int row0 = u.pm * 256 + wr * 64 + fr; const int col0 = u.pn * 256 + wc * 32 + 8 * fq;
#pragma unroll
        for (int ai = 0; ai < 2; ++ai)
#pragma unroll
            for (int m = 0; m < 4; ++m) { bf16_t* rowp = O + (size_t)(row0 + ai * 128 + m * 16) * ldc + col0;
#pragma unroll
                for (int bj = 0; bj < 2; ++bj) { f32x4 v0 = acc[ai][bj][m][0], v1 = acc[ai][bj][m][1];
                    if (ACT == 1) {
#pragma unroll
                        for (int j = 0; j < 4; ++j) { const float a = fmaxf(v0[j], 0.f), b = fmaxf(v1[j], 0.f); v0[j] = a * a; v1[j] = b * b; } }
                    if (ACT == 2 && bj == 0) {
                        if (u.pn == 6) {
#pragma unroll
                            for (int j = 0; j < 4; ++j) { v0[j] = tanhf_(v0[j]); v1[j] = tanhf_(v1[j]); } }
                        if (u.pn == 7) {
#pragma unroll
                            for (int j = 0; j < 4; ++j) { v0[j] = sigmoidf_(v0[j]); v1[j] = sigmoidf_(v1[j]); } } }
                    u32x4 w; w.x = pg8::cvt_pk_bf16(v0[0], v0[1]); w.y = pg8::cvt_pk_bf16(v0[2], v0[3]); w.z = pg8::cvt_pk_bf16(v1[0], v1[1]); w.w = pg8::cvt_pk_bf16(v1[2], v1[3]);
                    if (col0 + bj * 128 < ncols) *(u32x4*)(rowp + bj * 128) = w; } }
    }
};
struct EpiSplitB16 {
    static constexpr bool PERM = true, AFTER_DRAIN = false;
    bf16_t* O; bf16_t* P;
    __device__ __forceinline__ void operator()(const f32x4 (&acc)[2][2][4][2], const pg8::Unit& u, int wr, int wc, int fr, int fq) const {
        const int row0 = u.pm * 256 + wr * 64 + fr; const int col0 = u.pn * 256 + wc * 32 + 8 * fq;
        bf16_t* base = (u.part < 0) ? O + (size_t)row0 * 1024 : P + ((size_t)u.part * 4096 + (row0 - 16384)) * 1024;
#pragma unroll
        for (int ai = 0; ai < 2; ++ai)
#pragma unroll
            for (int m = 0; m < 4; ++m) { bf16_t* rowp = base + (size_t)(ai * 128 + m * 16) * 1024 + col0;
#pragma unroll
                for (int bj = 0; bj < 2; ++bj) { const f32x4 v0 = acc[ai][bj][m][0], v1 = acc[ai][bj][m][1];
                    u32x4 w; w.x = pg8::cvt_pk_bf16(v0[0], v0[1]); w.y = pg8::cvt_pk_bf16(v0[2], v0[3]); w.z = pg8::cvt_pk_bf16(v1[0], v1[1]); w.w = pg8::cvt_pk_bf16(v1[2], v1[3]);
                    *(u32x4*)(rowp + bj * 128) = w; } }
    }
};
struct EpiF {
    static constexpr bool PERM = false, AFTER_DRAIN = false;
    float* C; int ldc;
    __device__ __forceinline__ void operator()(const f32x4 (&acc)[2][2][4][2], const pg8::Unit& u, int wr, int wc, int fr, int fq) const {
        const int row0 = u.pm * 256 + wr * 64 + fr, col0 = u.pn * 256 + wc * 32 + 4 * fq;
#pragma unroll
        for (int ai = 0; ai < 2; ++ai)
#pragma unroll
            for (int m = 0; m < 4; ++m) { float* rowp = C + (size_t)(row0 + ai * 128 + m * 16) * ldc + col0;
#pragma unroll
                for (int bj = 0; bj < 2; ++bj)
#pragma unroll
                    for (int n = 0; n < 2; ++n) *(f32x4*)(rowp + bj * 128 + n * 16) = acc[ai][bj][m][n]; }
    }
};

__device__ __forceinline__ void transpose_tile(const float* src, int N, int Nvalid, bf16_t* dst, int K, int n0, int k0, float* tile) {
    const int tid = threadIdx.x;
    {   const int r = tid >> 4, c4 = (tid & 15) * 4;
#pragma unroll
        for (int pss = 0; pss < 2; ++pss) { const int rr = r + pss * 32;
            f32x4 v = {0.f, 0.f, 0.f, 0.f};
            if (n0 < Nvalid) v = *(const f32x4*)(src + (size_t)(k0 + rr) * N + n0 + c4);
            tile[rr * 65 + c4 + 0] = v[0]; tile[rr * 65 + c4 + 1] = v[1]; tile[rr * 65 + c4 + 2] = v[2]; tile[rr * 65 + c4 + 3] = v[3]; } }
    __syncthreads();
    {   const int rr = tid >> 3, kc = (tid & 7) * 8; float f[8];
#pragma unroll
        for (int j = 0; j < 8; ++j) f[j] = tile[(kc + j) * 65 + rr];
        *(u32x4*)(dst + (size_t)(n0 + rr) * K + k0 + kc) = pack8(f); }
    __syncthreads();
}

__device__ __forceinline__ void phase0(const Params& p, unsigned char* shm) {
    float* tile = (float*)shm;
    const int tid = threadIdx.x;
    const bool defer = (gridDim.x == 256);
    constexpr int N_TR = 3072, N_MOD = 192, N_SW = 160, N_TAB = 24;
    for (int it0 = blockIdx.x; it0 < (defer ? 768 : N_TR) + N_MOD + N_SW + N_TAB; it0 += gridDim.x) {
        const int it = (defer && it0 >= 768) ? it0 + (N_TR - 768) : it0;
        if (it < N_TR) {
            if (it < 768) transpose_tile(p.in[12], DIN, DIN, (bf16_t*)(p.ws + WS_WINT), 1024, (it >> 4) * 64, (it & 15) * 64, tile);
            else if (it < 1024) { const int i = it - 768; transpose_tile(p.in[30], 1024, 1024, (bf16_t*)(p.ws + WS_WOUTT), 1024, (i >> 4) * 64, (i & 15) * 64, tile); }
            else if (it < 2048) { const int i = it - 1024; transpose_tile(p.in[31], 4096, 4096, (bf16_t*)(p.ws + WS_W1T), 1024, (i >> 4) * 64, (i & 15) * 64, tile); }
            else { const int i = it - 2048; transpose_tile(p.in[32], 1024, 1024, (bf16_t*)(p.ws + WS_W2T), 4096, (i >> 6) * 64, (i & 63) * 64, tile); }
        } else if (it < N_TR + N_MOD) {
            const int i = it - N_TR, cgp = i % 12, ks = i / 12, k0 = ks * 64;
            for (int e = tid; e < 576; e += 512) { const int b = e >> 6, kk = e & 63; const float cv = (b < 8) ? p.in[2][b * 1024 + k0 + kk] : p.in[5][k0 + kk]; tile[e] = cv * __builtin_amdgcn_rcpf(1.0f + __expf(-cv)); }
            __syncthreads();
            const int col = cgp * 512 + tid;
            float a0 = 0, a1 = 0, a2 = 0, a3 = 0, a4 = 0, a5 = 0, a6 = 0, a7 = 0, a8 = 0;
            const float* wm = p.in[6] + (size_t)k0 * 6144 + col;
#pragma unroll
            for (int hb = 0; hb < 2; ++hb) { float wv[32];
#pragma unroll
                for (int q = 0; q < 32; ++q) wv[q] = wm[(size_t)(hb * 32 + q) * 6144];
                __builtin_amdgcn_sched_barrier(0);
#pragma unroll
                for (int q = 0; q < 32; ++q) { const int kk = hb * 32 + q; const float w = wv[q];
                    a0 += tile[kk] * w; a1 += tile[64 + kk] * w; a2 += tile[128 + kk] * w; a3 += tile[192 + kk] * w; a4 += tile[256 + kk] * w;
                    a5 += tile[320 + kk] * w; a6 += tile[384 + kk] * w; a7 += tile[448 + kk] * w; a8 += tile[512 + kk] * w; } }
            float* mp = (float*)(p.ws + WS_MODPART) + (size_t)(ks * 9) * 6144 + col;
            mp[0] = a0; mp[6144] = a1; mp[2 * 6144] = a2; mp[3 * 6144] = a3; mp[4 * 6144] = a4; mp[5 * 6144] = a5; mp[6 * 6144] = a6; mp[7 * 6144] = a7; mp[8 * 6144] = a8;
            __syncthreads();
        } else if (it < N_TR + N_MOD + N_SW) {
            const int i = it - N_TR - N_MOD;
float vq[4]; bf16_t* dq[4]; int rq[4];
#pragma unroll
            for (int q = 0; q < 4; ++q) {
                const int e = i * 2048 + q * 512 + tid, which = e >> 16, r = e & 65535;
                float v; bf16_t* dst;
                if (which < 2) { const int d = r >> 15, n = (r >> 6) & 511, k = r & 63; v = p.in[which == 0 ? 14 : 16][d * 32768 + k * 512 + n]; dst = (bf16_t*)(p.ws + (which == 0 ? WS_WUPT : WS_AUPT)); }
                else if (which == 2) { const int n = r >> 7, k = r & 127; v = p.in[17][k * 512 + n]; dst = (bf16_t*)(p.ws + WS_GUPT); }
                else { const int dn = r >> 12, o = (r >> 6) & 63, c = r & 63; v = p.in[which == 3 ? 25 : 27][dn * 4096 + c * 64 + o]; dst = (bf16_t*)(p.ws + (which == 3 ? WS_WAT : WS_WXT)); }
                vq[q] = v; dq[q] = dst; rq[q] = r;
            }
#pragma unroll
            for (int q = 0; q < 4; ++q) dq[q][rq[q]] = f2bf(vq[q]);
        } else {
            const int i = it - N_TR - N_MOD - N_SW;
#pragma unroll
            for (int q = 0; q < 4; ++q) {
                const int e = i * 2048 + q * 512 + tid;
                const int isrow = e < 16384, e2 = isrow ? e : e - 16384, pos = e2 >> 9, j = e2 & 511, ii = j & 255;
                const float omega = 1.0f / powf(10000.0f, (float)ii / 256.0f);
                const float ang = (float)pos * omega;
                const float v = (j < 256) ? sinf(ang) : cosf(ang);
                ((float*)(p.ws + (isrow ? WS_ROWTAB : WS_COLTAB)))[e2] = v;
            }
        }
    }
}

__device__ __forceinline__ void deferred_transposes(const Params& p, unsigned char* shm, int which, int rank, int nranks) {
    float* tile = (float*)shm;
    if (which == 0) { for (int i = rank; i < 256; i += nranks) transpose_tile(p.in[30], 1024, 1024, (bf16_t*)(p.ws + WS_WOUTT), 1024, (i >> 4) * 64, (i & 15) * 64, tile); }
    else { for (int it = rank; it < 2048; it += nranks) {
            if (it < 1024) transpose_tile(p.in[31], 4096, 4096, (bf16_t*)(p.ws + WS_W1T), 1024, (it >> 4) * 64, (it & 15) * 64, tile);
            else { const int i = it - 1024; transpose_tile(p.in[32], 1024, 1024, (bf16_t*)(p.ws + WS_W2T), 4096, (i >> 6) * 64, (i & 63) * 64, tile); } } }
}

__device__ __forceinline__ void phase_h1(const Params& p, unsigned char* shm) {
    float* sm = (float*)shm;
    const int tid = threadIdx.x, wid = tid >> 6, lane = tid & 63;
    bf16_t* H = (bf16_t*)(p.ws + WS_ACT);
    for (int e = blockIdx.x * 512 + tid; e < 9 * 6144; e += gridDim.x * 512) ((float*)(p.ws + WS_MODF))[e] = mod_val(p, e / 6144, e % 6144);
    const int per16 = (NTOK / 16 + (int)gridDim.x - 1) / (int)gridDim.x; int cur_mrow = -1;
    auto body = [&](auto nr_tag, int row) { constexpr int NR = decltype(nr_tag)::value;
            f32x4 x[NR][4]; float ss[NR] = {};
            f32x4 g8[4];
#pragma unroll
            for (int i = 0; i < 4; ++i) g8[i] = *(const f32x4*)(p.in[8] + 4 * lane + 256 * i);
#pragma unroll
            for (int u = 0; u < NR; ++u)
#pragma unroll
                for (int i = 0; i < 4; ++i) x[u][i] = load_x4(p, row + (u >> 1) * 16 + (u & 1), 4 * lane + 256 * i);
#pragma unroll
            for (int u = 0; u < NR; ++u)
#pragma unroll
                for (int i = 0; i < 4; ++i) ss[u] += x[u][i][0] * x[u][i][0] + x[u][i][1] * x[u][i][1] + x[u][i][2] * x[u][i][2] + x[u][i][3] * x[u][i][3];
#pragma unroll
            for (int o = 32; o > 0; o >>= 1) {
#pragma unroll
                for (int u = 0; u < NR; ++u) ss[u] += __shfl_xor(ss[u], o); }
#pragma unroll
            for (int u = 0; u < NR; ++u) { const float rstd = rsqrtf(ss[u] * (1.0f / 1024.0f) + 1e-6f);
#pragma unroll
                for (int i = 0; i < 4; ++i) { const int j = 4 * lane + 256 * i;
                    const f32x4 g = g8[i]; float h[4];
#pragma unroll
                    for (int e = 0; e < 4; ++e) h[e] = x[u][i][e] * rstd * g[e] * (1.0f + sm[1024 + j + e]) + sm[j + e];
                    u32x2 w; w.x = pk2(h[0], h[1]); w.y = pk2(h[2], h[3]);
                    __builtin_nontemporal_store(w, (u32x2*)(H + (size_t)(row + (u >> 1) * 16 + (u & 1)) * DM + j)); } }
    };
    for (int k16 = 0; k16 < per16; ) {
        const int t16 = blockIdx.x * per16 + k16; if (t16 >= NTOK / 16) break;
        const int row = t16 * 16 + wid * 2, mrow = (t16 * 16 < NPR) ? 8 : ((t16 * 16 - NPR) >> 11);
        if (mrow != cur_mrow) { __syncthreads(); { float mv[4];
#pragma unroll
            for (int q = 0; q < 4; ++q) mv[q] = mod_val(p, mrow, tid + 512 * q);
#pragma unroll
            for (int q = 0; q < 4; ++q) sm[tid + 512 * q] = mv[q]; } __syncthreads(); cur_mrow = mrow; }
        const int t16b = t16 + 1; const bool pair = (k16 + 1 < per16) && (t16b < NTOK / 16) && (((t16b * 16 < NPR) ? 8 : ((t16b * 16 - NPR) >> 11)) == mrow);
        if (pair) { body(std::integral_constant<int, 4>{}, row); k16 += 2; } else { body(std::integral_constant<int, 2>{}, row); k16 += 1; }
    }
    __syncthreads();
}

constexpr int LO_O = 0;
constexpr int LO_XA = 87040;
constexpr int LO_PRM = 139264;
constexpr int LW_HALF = 26624 + 2 * 9216, LW_GB = 26624;
struct LruPre { u32x4 x[8]; u32x4 g[2]; };

template <int MODE>
__device__ __forceinline__ void lru_load_x(const Params& p, const TileInfo& ti, int j, int ht, LruPre& pre) {
    const bf16_t* Z = (const bf16_t*)(p.ws + WS_Z);
    const int t = ht >> 2, cq = ht & 3;
#pragma unroll
    for (int jj = 0; jj < 4; ++jj) { const int tt = ti.t0 + t + jj - 2; const bool ok = (tt >= 0) && (tt < ti.T);
        const bf16_t* src = Z + (size_t)(ti.seqrow0 + (ok ? tt : 0)) * DIN + ZXB + 64 * j + 16 * cq;
        const u32x4 z = {0u, 0u, 0u, 0u};
        pre.x[2 * jj] = ok ? *(const u32x4*)src : z; pre.x[2 * jj + 1] = ok ? *(const u32x4*)(src + 8) : z; }
    if (MODE == 1) { const bf16_t* src = Z + (size_t)(ti.row0 + t) * DIN + ZGB + 64 * j + 16 * cq; pre.g[0] = *(const u32x4*)src; pre.g[1] = *(const u32x4*)(src + 8); }
}

template <int MODE>
__device__ __forceinline__ void lru_wave_item(const Params& p, unsigned char* lh, const bf16_t* wt, const float* cp, const float (&pba)[2], const float (&pbx)[2], const float (&pc8)[2], int tile, int j, const TileInfo& ti, LruPre& pre, int ht, int next_tile, int par) {
    const bf16_t* Z = (const bf16_t*)(p.ws + WS_Z);
    bf16_t* xcb = (bf16_t*)lh; float* xcf = (float*)(lh + 9216); bf16_t* gbt = (bf16_t*)(lh + LW_GB + par * 9216);
    const int lane = ht & 63, nt = ht >> 6, fr = lane & 15, fq = lane >> 4, ch = 64 * j + 16 * nt + fr;
    {   const int t = ht >> 2, cq = ht & 3; float xc[16];
#pragma unroll
        for (int q = 0; q < 16; ++q) xc[q] = cp[4 * 64 + 16 * cq + q];
#pragma unroll
        for (int jj = 0; jj < 4; ++jj) { float f[16]; unpack8(pre.x[2 * jj], f); unpack8(pre.x[2 * jj + 1], f + 8); __builtin_amdgcn_sched_barrier(0);
#pragma unroll
            for (int q = 0; q < 16; ++q) xc[q] += f[q] * cp[jj * 64 + 16 * cq + q]; }
        *(u32x4*)(xcb + t * 72 + 16 * cq) = pack8(xc); *(u32x4*)(xcb + t * 72 + 16 * cq + 8) = pack8(xc + 8);
        if (MODE == 1) { *(u32x4*)(gbt + t * 72 + 16 * cq) = pre.g[0]; *(u32x4*)(gbt + t * 72 + 16 * cq + 8) = pre.g[1]; }
#pragma unroll
        for (int q = 0; q < 16; q += 4) *(f32x4*)(xcf + t * 68 + 16 * cq + q) = (f32x4){xc[q], xc[q + 1], xc[q + 2], xc[q + 3]}; }
    __builtin_amdgcn_sched_barrier(0);
    if (next_tile >= 0) { const TileInfo tn = tile_info(next_tile); lru_load_x<MODE>(p, tn, j, ht, pre); }
    __syncthreads();
    f32x4 A_[2][4], B_[2][4];
    bf16x8 bl[4][2];
#pragma unroll
    for (int o = 0; o < 4; ++o)
#pragma unroll
        for (int k2 = 0; k2 < 2; ++k2) bl[o][k2] = *(const bf16x8*)(wt + (o * 64 + 16 * nt + fr) * 72 + 32 * k2 + 8 * fq);
#pragma unroll
    for (int mt = 0; mt < 4; ++mt) {
        const bf16x8 a0 = *(const bf16x8*)(xcb + (16 * mt + fr) * 72 + 8 * fq), a1 = *(const bf16x8*)(xcb + (16 * mt + fr) * 72 + 32 + 8 * fq);
        f32x4 acc[4];
#pragma unroll
        for (int o = 0; o < 4; ++o) { acc[o] = (f32x4){0.f, 0.f, 0.f, 0.f};
            acc[o] = __builtin_amdgcn_mfma_f32_16x16x32_bf16(a0, bl[o][0], acc[o], 0, 0, 0); acc[o] = __builtin_amdgcn_mfma_f32_16x16x32_bf16(a1, bl[o][1], acc[o], 0, 0, 0); }
#pragma unroll
        for (int d = 0; d < 2; ++d)
#pragma unroll
            for (int e = 0; e < 4; ++e) {
                const float rg = sigmoidf_(acc[2 * d][e] + pba[d]), ig = sigmoidf_(acc[2 * d + 1][e] + pbx[d]);
                const float a = __expf(rg * pc8[d]);
                A_[d][mt][e] = a; B_[d][mt][e] = __builtin_amdgcn_sqrtf(fmaxf(1.0f - a * a, 0.0f)) * (ig * xcf[(16 * mt + 4 * fq + e) * 68 + 16 * nt + fr]); }
    }
    __syncthreads();
    float hin0 = 0.f, hin1 = 0.f;
    if (MODE == 1) {
        const int chain = lane & 31, dd = chain >> 4, part = lane >> 5;
        const float* car = (const float*)(p.ws + WS_CAR);
        float Pa = 1.0f, Ha = 0.0f;
#pragma unroll
        for (int hb = 0; hb < 2; ++hb) { float Pv[8], Hv[8];
#pragma unroll
            for (int i = 0; i < 8; ++i) { const int kk = part * 16 + hb * 8 + i; const int tl = dd ? (ti.tile0 + ti.ntile - 1 - kk) : (ti.tile0 + kk);
                const bool valid = (kk < ti.ntile) && (dd ? (tl > tile) : (tl < tile));
                const float* cc = car + (size_t)((tl * 8 + j) * 2 + dd) * 128 + 16 * nt + fr;
                Pv[i] = valid ? cc[0] : 1.0f; Hv[i] = valid ? cc[64] : 0.0f; }
#pragma unroll
            for (int i = 0; i < 8; ++i) { Ha = Pv[i] * Ha + Hv[i]; Pa = Pv[i] * Pa; }
            __builtin_amdgcn_sched_barrier(0); }
        const float P1 = __shfl(Pa, chain + 32), H1 = __shfl(Ha, chain + 32);
        const float P0 = __shfl(Pa, chain), H0 = __shfl(Ha, chain);
        float h0 = ti.sample ? p.in[4][ti.b * 1024 + dd * 512 + ch] : 0.f;
        h0 = P0 * h0 + H0; h0 = P1 * h0 + H1;
        hin0 = __shfl(h0, fr); hin1 = __shfl(h0, 16 + fr); }
    float hs[4][4];
#pragma unroll
    for (int d = 0; d < 2; ++d) {
        float R_P = 1.0f, R_H = 0.0f;
        float hin = d ? hin1 : hin0;
#pragma unroll
        for (int m_ = 0; m_ < 4; ++m_) { const int mt = d ? 3 - m_ : m_;
            float P = 1.0f, H = 0.0f;
#pragma unroll
            for (int e_ = 0; e_ < 4; ++e_) { const int e = d ? 3 - e_ : e_; H = A_[d][mt][e] * H + B_[d][mt][e]; P = A_[d][mt][e] * P; }
            const int sq = d ? 3 - fq : fq;
            {   const int src1 = d ? lane + 16 : lane - 16; const float Pp = __shfl(P, src1 & 63), Hp = __shfl(H, src1 & 63);
                if (sq >= 1) { H = P * Hp + H; P = P * Pp; } }
            {   const int src2 = d ? lane + 32 : lane - 32; const float Pp = __shfl(P, src2 & 63), Hp = __shfl(H, src2 & 63);
                if (sq >= 2) { H = P * Hp + H; P = P * Pp; } }
            const int lastl = d ? fr : 48 + fr; const float TP = __shfl(P, lastl), TH = __shfl(H, lastl);
            if (MODE == 1) {
                const int srcx = d ? lane + 16 : lane - 16; float EP = __shfl(P, srcx & 63), EH = __shfl(H, srcx & 63);
                if (sq == 0) { EP = 1.0f; EH = 0.0f; }
                float h = R_P * hin + R_H; h = EP * h + EH;
#pragma unroll
                for (int e_ = 0; e_ < 4; ++e_) { const int e = d ? 3 - e_ : e_; h = A_[d][mt][e] * h + B_[d][mt][e]; hs[mt][e] = (d == 0) ? h : hs[mt][e] + h; }
                if (!ti.sample) {
                    if (d == 0 && mt == 3 && fq == 3 && tile == ti.tile0 + ti.ntile - 1) p.out[OUT_LRU + ti.b * 1024 + ch] = h;
                    if (d == 1 && mt == 0 && fq == 0 && tile == ti.tile0) p.out[OUT_LRU + ti.b * 1024 + 512 + ch] = h; }
            }
            R_H = TP * R_H + TH; R_P = TP * R_P;
        }
        if (MODE == 0) { if (fq == 0) { float* car = (float*)(p.ws + WS_CAR) + (size_t)((tile * 8 + j) * 2 + d) * 128 + 16 * nt + fr; car[0] = R_P; car[64] = R_H; } }
    }
    if (MODE == 1) {
        bf16_t* Y = (bf16_t*)(p.ws + WS_ACT);
#pragma unroll
        for (int mt = 0; mt < 4; ++mt)
#pragma unroll
            for (int e = 0; e < 4; ++e) { const float x = bf2f(gbt[(16 * mt + 4 * fq + e) * 72 + 16 * nt + fr]);
                const float ge = 0.5f * x * (1.0f + tanhf_(0.7978845608028654f * (x + 0.044715f * x * x * x)));
                Y[(size_t)(ti.row0 + 16 * mt + 4 * fq + e) * DM + 512 + ch] = f2bf(hs[mt][e] * ge); }
    }
}

constexpr int LW_WT = 2 * LW_HALF, LW_CP = LW_WT + 4 * 64 * 72 * 2;
template <int MODE>
__device__ __forceinline__ void lru_phase(const Params& p, unsigned char* shm, int j, int tile0, int tstride, int ntiles_total) {
    const int tid = threadIdx.x, ht = tid & 255, half = tid >> 8, lane = tid & 63, nt = ht >> 6, fr = lane & 15;
    unsigned char* lh = shm + half * LW_HALF;
    bf16_t* wt = (bf16_t*)(shm + LW_WT); float* cp = (float*)(shm + LW_CP);
    {   u32x4 wv[4];
#pragma unroll
        for (int q = 0; q < 4; ++q) { const int e = tid + 512 * q, o = e >> 9, n = (e >> 3) & 63, k8 = e & 7;
            wv[q] = *(const u32x4*)((const bf16_t*)(p.ws + ((o & 1) ? WS_WXT : WS_WAT)) + (size_t)(((o >> 1) * 8 + j) * 64 + n) * 64 + 8 * k8); }
#pragma unroll
        for (int q = 0; q < 4; ++q) { const int e = tid + 512 * q, o = e >> 9, n = (e >> 3) & 63, k8 = e & 7; *(u32x4*)(wt + (o * 64 + n) * 72 + 8 * k8) = wv[q]; } }
    if (tid < 320) { const int idx = tid >> 6, c = tid & 63; cp[tid] = (idx < 4) ? p.in[23][idx * 512 + 64 * j + c] : p.in[24][64 * j + c]; }
    float pba[2], pbx[2], pc8[2];
    {   const int ch = 64 * j + 16 * nt + fr;
#pragma unroll
        for (int d = 0; d < 2; ++d) { pba[d] = p.in[26][d * 512 + ch]; pbx[d] = p.in[28][d * 512 + ch]; pc8[d] = -8.0f * softplusf_(-p.in[29][d * 512 + ch]); } }
    const int nmax = (ntiles_total + 1) / 2, n = (ntiles_total - half + 1) / 2;
    LruPre pre;
    if (n > 0) { const TileInfo ti = tile_info(tile0 + half * tstride); lru_load_x<MODE>(p, ti, j, ht, pre); }
    __syncthreads();
    for (int i = 0; i < nmax; ++i) {
        if (i < n) { const int tile = tile0 + (2 * i + half) * tstride; const TileInfo ti = tile_info(tile);
            lru_wave_item<MODE>(p, lh, wt, cp, pba, pbx, pc8, tile, j, ti, pre, ht, (i + 1 < n) ? tile + 2 * tstride : -1, i & 1); }
        else { __syncthreads(); __syncthreads(); } }
}

__device__ __forceinline__ void phase_prep(const Params& p, unsigned char* shm) {
    const int tid = threadIdx.x, wid = tid >> 6, lane = tid & 63;
    const bf16_t* Z = (const bf16_t*)(p.ws + WS_Z);
    float* O = (float*)(shm + LO_O);
    bf16_t* XW = (bf16_t*)(shm + LO_XA); bf16_t* XA = XW + 64 * 136; bf16_t* XG = XA + 64 * 136;
    bf16_t* SCAN = (bf16_t*)p.out;
    {
    const int h = blockIdx.x & 7, nbj = gridDim.x >> 3;
    bf16x8 bw[2][2], ba[2][2], bg[4];
    {   const int fr = lane & 15, fq = lane >> 4, nt = wid & 3;
#pragma unroll
        for (int d = 0; d < 2; ++d)
#pragma unroll
            for (int k2 = 0; k2 < 2; ++k2) { const size_t o = (size_t)(d * 512 + h * 64 + 16 * nt + fr) * 64 + 32 * k2 + 8 * fq;
                bw[d][k2] = *(const bf16x8*)((const bf16_t*)(p.ws + WS_WUPT) + o); ba[d][k2] = *(const bf16x8*)((const bf16_t*)(p.ws + WS_AUPT) + o); }
#pragma unroll
        for (int k4 = 0; k4 < 4; ++k4) bg[k4] = *(const bf16x8*)((const bf16_t*)(p.ws + WS_GUPT) + (size_t)(h * 64 + 16 * nt + fr) * 128 + 32 * k4 + 8 * fq); }
    float* PR = (float*)(shm + LO_PRM);
    if (tid < 448) { const int idx = tid >> 6, c = tid & 63, hc = h * 64 + c;
        PR[tid] = (idx < 2) ? p.in[13][idx * 512 + hc] : (idx < 4) ? p.in[15][(idx - 2) * 512 + hc] : (idx == 4) ? p.in[18][hc] : (idx == 5) ? p.in[19][hc] : p.in[20][hc]; }
    u32x4 nx[8];
    {   const int tile = blockIdx.x >> 3;
        if (tile < NTILE) { const int t = tid >> 3, seg = tid & 7; const size_t zr = (size_t)(tile * 64 + t) * DIN;
#pragma unroll
            for (int hh = 0; hh < 2; ++hh) { const int c0 = seg * 16 + hh * 8; nx[hh] = *(const u32x4*)(Z + zr + ZXW + c0); nx[2 + hh] = *(const u32x4*)(Z + zr + ZXA + c0); nx[4 + hh] = *(const u32x4*)(Z + zr + ZXG + c0); }
            nx[6] = *(const u32x4*)(Z + zr + h * 64 + 8 * seg + ZR); nx[7] = *(const u32x4*)(Z + zr + h * 64 + 8 * seg + ZK); } }
    __syncthreads();
    for (int tile = blockIdx.x >> 3; tile < NTILE; tile += nbj) {
        const TileInfo ti = tile_info(tile);
        u32x4 cx[8];
#pragma unroll
        for (int i = 0; i < 8; ++i) cx[i] = nx[i];
        if (tile + nbj < NTILE) { const int t = tid >> 3, seg = tid & 7; const size_t zr = (size_t)((tile + nbj) * 64 + t) * DIN;
#pragma unroll
            for (int hh = 0; hh < 2; ++hh) { const int c0 = seg * 16 + hh * 8; nx[hh] = *(const u32x4*)(Z + zr + ZXW + c0); nx[2 + hh] = *(const u32x4*)(Z + zr + ZXA + c0); nx[4 + hh] = *(const u32x4*)(Z + zr + ZXG + c0); }
            nx[6] = *(const u32x4*)(Z + zr + h * 64 + 8 * seg + ZR); nx[7] = *(const u32x4*)(Z + zr + h * 64 + 8 * seg + ZK); }
        {   const int t = tid >> 3, seg = tid & 7; float f[8];
#pragma unroll
            for (int hh = 0; hh < 2; ++hh) { const int c0 = seg * 16 + hh * 8;
                *(u32x4*)(XW + t * 136 + c0) = cx[hh]; *(u32x4*)(XA + t * 136 + c0) = cx[2 + hh]; *(u32x4*)(XG + t * 136 + c0) = cx[4 + hh]; } }
        __syncthreads();
        {   const int fr = lane & 15, fq = lane >> 4, nt = wid & 3, mtb = 2 * (wid >> 2);
#pragma unroll
            for (int mi = 0; mi < 2; ++mi) { const int mt = mtb + mi; const bf16_t* ar = XW + (16 * mt + fr) * 136 + 8 * fq;
#pragma unroll
                for (int d = 0; d < 2; ++d) { f32x4 aw = {0.f, 0.f, 0.f, 0.f}, aa = aw;
#pragma unroll
                    for (int k2 = 0; k2 < 2; ++k2) { aw = __builtin_amdgcn_mfma_f32_16x16x32_bf16(*(const bf16x8*)(ar + d * 64 + 32 * k2), bw[d][k2], aw, 0, 0, 0);
                        aa = __builtin_amdgcn_mfma_f32_16x16x32_bf16(*(const bf16x8*)(ar + 64 * 136 + d * 64 + 32 * k2), ba[d][k2], aa, 0, 0, 0); }
#pragma unroll
                    for (int i = 0; i < 4; ++i) { O[(d * 64 + 16 * mt + 4 * fq + i) * 68 + 16 * nt + fr] = aw[i]; O[((2 + d) * 64 + 16 * mt + 4 * fq + i) * 68 + 16 * nt + fr] = aa[i]; } }
                f32x4 ag = {0.f, 0.f, 0.f, 0.f};
#pragma unroll
                for (int k4 = 0; k4 < 4; ++k4) ag = __builtin_amdgcn_mfma_f32_16x16x32_bf16(*(const bf16x8*)(ar + 2 * 64 * 136 + 32 * k4), bg[k4], ag, 0, 0, 0);
#pragma unroll
                for (int i = 0; i < 4; ++i) O[(4 * 64 + 16 * mt + 4 * fq + i) * 68 + 16 * nt + fr] = ag[i]; } }
        __syncthreads();
        {   const int t = tid >> 3, cs = tid & 7, row = ti.row0 + t; const size_t zr = (size_t)row * DIN + h * 64 + 8 * cs;
            float ss = 0.f;
            float kaw[8], rkw[8];
            {   float k[8], kkw[8]; unpack8(cx[7], k);
                *(f32x4*)kkw = *(const f32x4*)(PR + 4 * 64 + 8 * cs); *(f32x4*)(kkw + 4) = *(const f32x4*)(PR + 4 * 64 + 8 * cs + 4);
                *(f32x4*)kaw = *(const f32x4*)(PR + 5 * 64 + 8 * cs); *(f32x4*)(kaw + 4) = *(const f32x4*)(PR + 5 * 64 + 8 * cs + 4);
                *(f32x4*)rkw = *(const f32x4*)(PR + 6 * 64 + 8 * cs); *(f32x4*)(rkw + 4) = *(const f32x4*)(PR + 6 * 64 + 8 * cs + 4);
#pragma unroll
                for (int q = 0; q < 8; ++q) { const float kk = k[q] * kkw[q]; ss += kk * kk; } }
            ss = sum8(ss);
            const float inv = __builtin_amdgcn_rcpf(fmaxf(__builtin_amdgcn_sqrtf(ss), 1e-12f));
            float bs = 0.f;
            float rf[8], kf[8]; unpack8(cx[6], rf); unpack8(cx[7], kf);
#pragma unroll 1
            for (int d = 0; d < 2; ++d) {
                bf16_t* sp = SCAN + ((size_t)(d * NTOK + row) * 8 + h) * 128 + 8 * cs;
                float oa[8], ow[8], pa[8], pw[8];
                *(f32x4*)oa = *(const f32x4*)(O + ((2 + d) * 64 + t) * 68 + 8 * cs); *(f32x4*)(oa + 4) = *(const f32x4*)(O + ((2 + d) * 64 + t) * 68 + 8 * cs + 4);
                *(f32x4*)ow = *(const f32x4*)(O + (d * 64 + t) * 68 + 8 * cs); *(f32x4*)(ow + 4) = *(const f32x4*)(O + (d * 64 + t) * 68 + 8 * cs + 4);
                *(f32x4*)pa = *(const f32x4*)(PR + (2 + d) * 64 + 8 * cs); *(f32x4*)(pa + 4) = *(const f32x4*)(PR + (2 + d) * 64 + 8 * cs + 4);
                *(f32x4*)pw = *(const f32x4*)(PR + d * 64 + 8 * cs); *(f32x4*)(pw + 4) = *(const f32x4*)(PR + d * 64 + 8 * cs + 4);
                float lw[8], aa[8];
#pragma unroll
                for (int q = 0; q < 8; ++q) { const float a = sigmoidf_(pa[q] + oa[q]);
                    bs += rf[q] * (kf[q] * (1.0f + (a - 1.0f) * kaw[q])) * rkw[q];
                    lw[q] = -0.60653065971f * sigmoidf_(pw[q] + ow[q]);
                    aa[q] = a; }
                *(u32x4*)sp = pack8(lw); *(u32x4*)(sp + 64) = pack8(aa); }
            bs = sum8(bs);
            if (cs == 0) { ((float*)(p.ws + WS_INV))[row * 8 + h] = inv; ((float*)(p.ws + WS_BON))[row * 8 + h] = bs; }
            float g[8];
            *(f32x4*)g = *(const f32x4*)(O + (4 * 64 + t) * 68 + 8 * cs); *(f32x4*)(g + 4) = *(const f32x4*)(O + (4 * 64 + t) * 68 + 8 * cs + 4);
            *(u32x4*)((bf16_t*)(p.ws + WS_G) + (size_t)row * 512 + h * 64 + 8 * cs) = pack8(g); }
    }
    __syncthreads();
    }
    {   const int G = gridDim.x, bid = blockIdx.x, nbj = G >> 3, t0 = bid >> 3;
        const int ntl = (t0 < NTILE) ? (NTILE - t0 + nbj - 1) / nbj : 0;
        lru_phase<0>(p, shm, bid & 7, t0, nbj, ntl); }
}

constexpr int CB_A = 0, CB_R = 2304, CB_BT = 4608, CB_KT = 6656, CB_VT = 8704, CB_T = 10752, CB_TK = 11264, CB_MT = 11776, CB_MK = 12288, CB_G = 12800, CB_BYTES = 13056;
constexpr int PS_B = 0, PS_K = 2304, PS_M = 4608  , PS_BYTES = 6144;
constexpr int LO_CB = 0, LO_PS = 8 * CB_BYTES;

__device__ __forceinline__ void wsync() { __builtin_amdgcn_wave_barrier(); asm volatile("s_waitcnt lgkmcnt(0)" ::: "memory"); __builtin_amdgcn_wave_barrier(); }
__device__ __forceinline__ bf16x8 mk8(unsigned a, unsigned b, unsigned c, unsigned d) { u32x4 w; w.x = a; w.y = b; w.z = c; w.w = d; return __builtin_bit_cast(bf16x8, w); }

__device__ __forceinline__ void produce_chunk(const Params& p, unsigned char* cb, unsigned char* ps, int seqrow0, int T, int d, int h, int tau0, int lane) {
    const bf16_t* Z = (const bf16_t*)(p.ws + WS_Z); const bf16_t* SCAN = (const bf16_t*)p.out; const float* INV = (const float*)(p.ws + WS_INV);
    bf16_t* At = (bf16_t*)(cb + CB_A); bf16_t* Rt = (bf16_t*)(cb + CB_R); bf16_t* Bs = (bf16_t*)(ps + PS_B); bf16_t* Ks = (bf16_t*)(ps + PS_K);
    const int k = lane, hc = h * 64 + k;
    const float kkw = p.in[18][hc], kaw = p.in[19][hc];
    float beta[16], kdv[16], cums[16]; unsigned short vraw[16], lwr[16], asr[16], rrw[16], krw[16]; float invv[16];
    float cum = 0.f, e_last = 1.0f;
#pragma unroll
    for (int i = 0; i < 16; ++i) {
        const int tau = tau0 + i, row = seqrow0 + (d ? T - 1 - tau : tau);
        const bf16_t* sp = SCAN + ((size_t)(d * NTOK + row) * 8 + h) * 128;
        const bf16_t* zr = Z + (size_t)row * DIN + h * 64 + k;
        lwr[i] = sp[k]; asr[i] = sp[64 + k]; rrw[i] = zr[ZR]; krw[i] = zr[ZK]; vraw[i] = zr[ZV]; invv[i] = INV[row * 8 + h];
    }
    __builtin_amdgcn_sched_barrier(0);
#pragma unroll
    for (int i = 0; i < 16; ++i) {
        const float lw = bf2f(lwr[i]), as = bf2f(asr[i]), r = bf2f(rrw[i]), kr = bf2f(krw[i]);
        const float kk = kr * kkw * invv[i], be = kk * as, kd = kr * (1.0f + (as - 1.0f) * kaw);
        const float e_prev = e_last; cum += lw; const float e_i = __expf(cum), e_neg = __builtin_amdgcn_rcpf(e_i); e_last = e_i;
        At[i * 72 + k] = f2bf(-kk * e_prev); Rt[i * 72 + k] = f2bf(r * e_i); Bs[i * 72 + k] = f2bf(be * e_neg); Ks[i * 72 + k] = f2bf(kd * e_neg);
        beta[i] = be * e_neg; kdv[i] = kd * e_neg; cums[i] = cum;
    }
    const float gam = e_last; ((float*)(cb + CB_G))[k] = gam;
    {   unsigned wb[8], wk[8], wv[8];
#pragma unroll
        for (int i = 0; i < 16; i += 2) {
            wb[i >> 1] = pk2(beta[i] * gam, beta[i + 1] * gam); wk[i >> 1] = pk2(kdv[i] * gam, kdv[i + 1] * gam); wv[i >> 1] = (unsigned)vraw[i] | ((unsigned)vraw[i + 1] << 16); }
        u32x4* bt = (u32x4*)(cb + CB_BT + k * 32); u32x4* kt = (u32x4*)(cb + CB_KT + k * 32); u32x4* vt = (u32x4*)(cb + CB_VT + k * 32);
        u32x4 w; w.x = wb[0]; w.y = wb[1]; w.z = wb[2]; w.w = wb[3]; bt[0] = w; w.x = wb[4]; w.y = wb[5]; w.z = wb[6]; w.w = wb[7]; bt[1] = w;
        w.x = wk[0]; w.y = wk[1]; w.z = wk[2]; w.w = wk[3]; kt[0] = w; w.x = wk[4]; w.y = wk[5]; w.z = wk[6]; w.w = wk[7]; kt[1] = w;
        w.x = wv[0]; w.y = wv[1]; w.z = wv[2]; w.w = wv[3]; vt[0] = w; w.x = wv[4]; w.y = wv[5]; w.z = wv[6]; w.w = wv[7]; vt[1] = w; }
    wsync();
    const int fr = lane & 15, fq = lane >> 4;
    {   f32x4 lab = {0.f, 0.f, 0.f, 0.f}, lak = lab, mrb = lab, mrk = lab;
#pragma unroll
        for (int m = 0; m < 2; ++m) {
            const bf16x8 aA = *(const bf16x8*)(At + fr * 72 + 32 * m + 8 * fq), aR = *(const bf16x8*)(Rt + fr * 72 + 32 * m + 8 * fq);
            const bf16x8 bB = *(const bf16x8*)(Bs + fr * 72 + 32 * m + 8 * fq), bK = *(const bf16x8*)(Ks + fr * 72 + 32 * m + 8 * fq);
            lab = __builtin_amdgcn_mfma_f32_16x16x32_bf16(aA, bB, lab, 0, 0, 0); lak = __builtin_amdgcn_mfma_f32_16x16x32_bf16(aA, bK, lak, 0, 0, 0);
            mrb = __builtin_amdgcn_mfma_f32_16x16x32_bf16(aR, bB, mrb, 0, 0, 0); mrk = __builtin_amdgcn_mfma_f32_16x16x32_bf16(aR, bK, mrk, 0, 0, 0); }
        bf16_t* oLK = (bf16_t*)(cb + CB_TK); bf16_t* oMB = (bf16_t*)(cb + CB_MT); bf16_t* oMK = (bf16_t*)(cb + CB_MK);
#pragma unroll
        for (int e = 0; e < 4; ++e) { const int i = 4 * fq + e, j = fr;
            oLK[i * 16 + j] = f2bf((j < i) ? lak[e] : 0.f); oMB[i * 16 + j] = f2bf((j <= i) ? mrb[e] : 0.f); oMK[i * 16 + j] = f2bf((j <= i) ? mrk[e] : 0.f); }
        float* Lab = (float*)(ps + PS_M);
#pragma unroll
        for (int e = 0; e < 4; ++e) Lab[(4 * fq + e) * 20 + fr] = lab[e];
        wsync();
        f32x4 Lr[16][4];
#pragma unroll
        for (int i = 1; i < 16; ++i)
#pragma unroll
            for (int j4 = 0; j4 < (i + 3) / 4; ++j4) Lr[i][j4] = *(const f32x4*)(Lab + i * 20 + 4 * j4);
        __builtin_amdgcn_sched_barrier(0);
        float Tc[16];
#pragma unroll
        for (int i = 0; i < 16; ++i) { float sacc = (i == fr) ? 1.0f : 0.0f;
#pragma unroll
            for (int j4 = 0; j4 < (i + 3) / 4; ++j4) {
#pragma unroll
                for (int e = 0; e < 4; ++e) if (4 * j4 + e < i) sacc += Lr[i][j4][e] * Tc[4 * j4 + e]; }
            Tc[i] = sacc; }
        bf16_t* oT = (bf16_t*)(cb + CB_T);
        if (fq == 0) {
#pragma unroll
            for (int i = 0; i < 16; ++i) oT[i * 16 + fr] = f2bf(Tc[i]); } }
}

__device__ __forceinline__ void consume_chunk(const unsigned char* cb, int vt, int lane, f32x4 (&S)[4], bf16_t* ybase  , int seqrow0, int T, int d, int tau0) {
    const int fr = lane & 15, fq = lane >> 4;
    const bf16_t* At = (const bf16_t*)(cb + CB_A); const bf16_t* Rt = (const bf16_t*)(cb + CB_R);
    const bf16x8 bS0 = mk8(pg8::cvt_pk_bf16(S[0][0], S[0][1]), pg8::cvt_pk_bf16(S[0][2], S[0][3]), pg8::cvt_pk_bf16(S[1][0], S[1][1]), pg8::cvt_pk_bf16(S[1][2], S[1][3]));
    const bf16x8 bS1 = mk8(pg8::cvt_pk_bf16(S[2][0], S[2][1]), pg8::cvt_pk_bf16(S[2][2], S[2][3]), pg8::cvt_pk_bf16(S[3][0], S[3][1]), pg8::cvt_pk_bf16(S[3][2], S[3][3]));
    const u32x2 a00 = *(const u32x2*)(At + fr * 72 + 4 * fq), a01 = *(const u32x2*)(At + fr * 72 + 16 + 4 * fq), a10 = *(const u32x2*)(At + fr * 72 + 32 + 4 * fq), a11 = *(const u32x2*)(At + fr * 72 + 48 + 4 * fq);
    const u32x2 r00 = *(const u32x2*)(Rt + fr * 72 + 4 * fq), r01 = *(const u32x2*)(Rt + fr * 72 + 16 + 4 * fq), r10 = *(const u32x2*)(Rt + fr * 72 + 32 + 4 * fq), r11 = *(const u32x2*)(Rt + fr * 72 + 48 + 4 * fq);
    const f32x4 zero = {0.f, 0.f, 0.f, 0.f};
    f32x4 A0 = __builtin_amdgcn_mfma_f32_16x16x32_bf16(mk8(a00.x, a00.y, a01.x, a01.y), bS0, zero, 0, 0, 0);
    A0 = __builtin_amdgcn_mfma_f32_16x16x32_bf16(mk8(a10.x, a10.y, a11.x, a11.y), bS1, A0, 0, 0, 0);
    f32x4 Y = __builtin_amdgcn_mfma_f32_16x16x32_bf16(mk8(r00.x, r00.y, r01.x, r01.y), bS0, zero, 0, 0, 0);
    Y = __builtin_amdgcn_mfma_f32_16x16x32_bf16(mk8(r10.x, r10.y, r11.x, r11.y), bS1, Y, 0, 0, 0);
    const u32x2 vf = *(const u32x2*)(cb + CB_VT + (16 * vt + fr) * 32 + 8 * fq);
    const u32x2 tt = *(const u32x2*)(cb + CB_T + fr * 32 + 8 * fq), lk = *(const u32x2*)(cb + CB_TK + fr * 32 + 8 * fq);
    const u32x2 mb = *(const u32x2*)(cb + CB_MT + fr * 32 + 8 * fq), mk = *(const u32x2*)(cb + CB_MK + fr * 32 + 8 * fq);
    const bf16x8 bAV = mk8(pg8::cvt_pk_bf16(A0[0], A0[1]), pg8::cvt_pk_bf16(A0[2], A0[3]), vf.x, vf.y);
    const f32x4 X = __builtin_amdgcn_mfma_f32_16x16x32_bf16(mk8(0u, 0u, lk.x, lk.y), bAV, A0, 0, 0, 0);
    const bf16x8 bXV = mk8(pg8::cvt_pk_bf16(X[0], X[1]), pg8::cvt_pk_bf16(X[2], X[3]), vf.x, vf.y);
    const f32x4 U = __builtin_amdgcn_mfma_f32_16x16x32_bf16(mk8(tt.x, tt.y, 0u, 0u), bXV, zero, 0, 0, 0);
    const bf16x8 bUV = mk8(pg8::cvt_pk_bf16(U[0], U[1]), pg8::cvt_pk_bf16(U[2], U[3]), vf.x, vf.y);
    Y = __builtin_amdgcn_mfma_f32_16x16x32_bf16(mk8(mb.x, mb.y, mk.x, mk.y), bUV, Y, 0, 0, 0);
#pragma unroll
    for (int kt = 0; kt < 4; ++kt) {
        const f32x4 g4 = *(const f32x4*)(cb + CB_G + (16 * kt + 4 * fq) * 4);
        const u32x2 bf = *(const u32x2*)(cb + CB_BT + (16 * kt + fr) * 32 + 8 * fq), kf = *(const u32x2*)(cb + CB_KT + (16 * kt + fr) * 32 + 8 * fq);
        S[kt] = __builtin_amdgcn_mfma_f32_16x16x32_bf16(mk8(bf.x, bf.y, kf.x, kf.y), bUV, S[kt] * g4, 0, 0, 0); }
#pragma unroll
    for (int e = 0; e < 4; ++e) { const int tau = tau0 + 4 * fq + e, row = seqrow0 + (d ? T - 1 - tau : tau); ybase[(size_t)row * 512] = f2bf(Y[e]); }
}

__device__ __forceinline__ void rwkv_scan_item(const Params& p, unsigned char* shm, int item) {
    const int tid = threadIdx.x, wid = tid >> 6, lane = tid & 63, fr = lane & 15, fq = lane >> 4;
    int sample, b, h, d;
    if (item < 128) { sample = 1; b = item >> 4; h = (item >> 1) & 7; d = item & 1; }
    else { const int ii = item - 128; sample = 0; b = ii >> 4; h = (ii >> 1) & 7; d = ii & 1; }
    const int T = sample ? 2048 : 256, seqrow0 = sample ? NPR + b * 2048 : b * 256, nsc = T / 64;
    const bool consumer = wid < 4; const int vt = wid & 3;
    f32x4 S[4];
    if (consumer) {
        if (sample) { const float* s0 = p.in[3] + ((size_t)((b * 2 + d) * 8 + h)) * 4096 + (16 * vt + fr) * 64 + 4 * fq;
#pragma unroll
            for (int kt = 0; kt < 4; ++kt) S[kt] = *(const f32x4*)(s0 + 16 * kt); }
        else {
#pragma unroll
            for (int kt = 0; kt < 4; ++kt) S[kt] = (f32x4){0.f, 0.f, 0.f, 0.f}; }
    }
    bf16_t* ybase = (bf16_t*)(p.ws + WS_YA) + (size_t)d * NTOK * 512 + h * 64 + 16 * vt + fr;
    for (int s = 0; s < nsc / 2; ++s) {
        produce_chunk(p, shm + LO_CB + wid * CB_BYTES, shm + LO_PS + wid * PS_BYTES, seqrow0, T, d, h, s * 128 + wid * 16, lane);
        __syncthreads();
        if (consumer) {
#pragma unroll 1
            for (int c = 0; c < 8; ++c) consume_chunk(shm + LO_CB + c * CB_BYTES, vt, lane, S, ybase, seqrow0, T, d, s * 128 + c * 16);
        }
        __syncthreads();
    }
    if (consumer && !sample) { float* so = p.out + OUT_RWKV + ((size_t)((b * 2 + d) * 8 + h)) * 4096 + (16 * vt + fr) * 64 + 4 * fq;
#pragma unroll
        for (int kt = 0; kt < 4; ++kt) *(f32x4*)(so + 16 * kt) = S[kt]; }
    __syncthreads();
}

__device__ __forceinline__ void phase_scan(const Params& p, unsigned char* shm) {
    const int bid = blockIdx.x, G = gridDim.x;
    if (G == 256) { if (bid < 128) rwkv_scan_item(p, shm, bid); else { rwkv_scan_item(p, shm, 128 + (bid - 128) * 2); rwkv_scan_item(p, shm, 129 + (bid - 128) * 2); } }
    else for (int item = bid; item < 384; item += G) rwkv_scan_item(p, shm, item);
    {   const int nlb = G >> 1, lb = bid - (G - nlb);
        if (lb >= 0) { const int nbj = nlb >> 3, t0 = lb >> 3; const int ntl = (t0 < NTILE) ? (NTILE - t0 + nbj - 1) / nbj : 0;
            lru_phase<1>(p, shm, lb & 7, t0, nbj, ntl); } }
}

__device__ __forceinline__ void phase_combine(const Params& p) {
    const int tid = threadIdx.x, wid = tid >> 6, lane = tid & 63, h = lane >> 3;
    const bf16_t* Z = (const bf16_t*)(p.ws + WS_Z); const bf16_t* YA = (const bf16_t*)(p.ws + WS_YA); const bf16_t* G = (const bf16_t*)(p.ws + WS_G);
    const float* BON = (const float*)(p.ws + WS_BON);
    bf16_t* Y = (bf16_t*)(p.ws + WS_ACT);
    float lg[8], lb[8];
#pragma unroll
    for (int q = 0; q < 8; ++q) { lg[q] = p.in[21][8 * lane + q]; lb[q] = p.in[22][8 * lane + q]; }
    const int per16 = (NTOK / 16 + (int)gridDim.x - 1) / (int)gridDim.x;
    for (int k16 = 0; k16 < per16; ++k16) { const int t16 = blockIdx.x * per16 + k16; if (t16 >= NTOK / 16) break;
        {
            u32x4 w0[2], w1[2], wv[2], wg[2]; float bon[2];
#pragma unroll
            for (int u = 0; u < 2; ++u) { const int row = t16 * 16 + wid * 2 + u;
                w0[u] = *(const u32x4*)(YA + (size_t)row * 512 + 8 * lane); w1[u] = *(const u32x4*)(YA + (size_t)(NTOK + row) * 512 + 8 * lane);
                wv[u] = *(const u32x4*)(Z + (size_t)row * DIN + ZV + 8 * lane); wg[u] = *(const u32x4*)(G + (size_t)row * 512 + 8 * lane); bon[u] = BON[row * 8 + h]; }
#pragma unroll
            for (int u = 0; u < 2; ++u) { const int row = t16 * 16 + wid * 2 + u;
                float a[8], b[8], vv[8], g[8], o[8]; unpack8(w0[u], a); unpack8(w1[u], b); unpack8(wv[u], vv); unpack8(wg[u], g);
                float s1 = 0.f;
#pragma unroll
                for (int q = 0; q < 8; ++q) { a[q] += b[q]; s1 += a[q]; }
                s1 = sum8(s1);
                const float mu = s1 * (1.0f / 64.0f);
                float s2 = 0.f;
#pragma unroll
                for (int q = 0; q < 8; ++q) { a[q] -= mu; s2 += a[q] * a[q]; }
                s2 = sum8(s2);
                const float rstd = rsqrtf(s2 * (1.0f / 64.0f) + 64e-5f);
#pragma unroll
                for (int q = 0; q < 8; ++q) o[q] = (a[q] * rstd * lg[q] + lb[q] + bon[u] * vv[q]) * g[q];
                *(u32x4*)(Y + (size_t)row * DM + 8 * lane) = pack8(o); }
        }
    }
}

__device__ __forceinline__ void phase_res1(const Params& p, unsigned char* shm) {
    float* sm = (float*)shm;
    const int tid = threadIdx.x, wid = tid >> 6, lane = tid & 63;
    const bf16_t* O1 = (const bf16_t*)(p.ws + WS_O1); const bf16_t* O1P = (const bf16_t*)(p.ws + WS_O1P); const bool split = false; bf16_t* H = (bf16_t*)(p.ws + WS_ACT);
    const int per16 = (NTOK / 16 + (int)gridDim.x - 1) / (int)gridDim.x; int cur_mrow = -1;
    auto body = [&](auto nr_tag, int row) { constexpr int NR = decltype(nr_tag)::value;
            f32x4 o[NR][4], x1[NR][4]; float ss[NR] = {}, s2[NR] = {};
            f32x4 g9[4], g10[4];
#pragma unroll
            for (int i = 0; i < 4; ++i) { g9[i] = *(const f32x4*)(p.in[9] + 4 * lane + 256 * i); g10[i] = *(const f32x4*)(p.in[10] + 4 * lane + 256 * i); }
#pragma unroll
            for (int u = 0; u < NR; ++u)
#pragma unroll
                for (int i = 0; i < 4; ++i) { const int r = row + (u >> 1) * 16 + (u & 1), j = 4 * lane + 256 * i;
                    if (!split || r < 16384) { const u32x2 w = *(const u32x2*)(O1 + (size_t)r * DM + j);
                        o[u][i] = (f32x4){__uint_as_float(w.x << 16), __uint_as_float(w.x & 0xffff0000u), __uint_as_float(w.y << 16), __uint_as_float(w.y & 0xffff0000u)}; }
                    else { f32x4 a = {0.f, 0.f, 0.f, 0.f};
#pragma unroll
                        for (int pp = 0; pp < 4; ++pp) { const u32x2 w = *(const u32x2*)(O1P + ((size_t)pp * 4096 + (r - 16384)) * DM + j);
                            a += (f32x4){__uint_as_float(w.x << 16), __uint_as_float(w.x & 0xffff0000u), __uint_as_float(w.y << 16), __uint_as_float(w.y & 0xffff0000u)}; }
                        o[u][i] = a; }
                    x1[u][i] = load_x4(p, r, j); }
#pragma unroll
            for (int u = 0; u < NR; ++u)
#pragma unroll
                for (int i = 0; i < 4; ++i) ss[u] += o[u][i][0] * o[u][i][0] + o[u][i][1] * o[u][i][1] + o[u][i][2] * o[u][i][2] + o[u][i][3] * o[u][i][3];
#pragma unroll
            for (int sh = 32; sh > 0; sh >>= 1) {
#pragma unroll
                for (int u = 0; u < NR; ++u) ss[u] += __shfl_xor(ss[u], sh); }
#pragma unroll
            for (int u = 0; u < NR; ++u) { const float rstd = rsqrtf(ss[u] * (1.0f / 1024.0f) + 1e-6f);
#pragma unroll
                for (int i = 0; i < 4; ++i) { const int j = 4 * lane + 256 * i; const f32x4 g = g9[i];
#pragma unroll
                    for (int e = 0; e < 4; ++e) { x1[u][i][e] += sm[j + e] * (o[u][i][e] * rstd * g[e]); s2[u] += x1[u][i][e] * x1[u][i][e]; }
                    __builtin_nontemporal_store(x1[u][i], (f32x4*)(p.out + (size_t)(row + (u >> 1) * 16 + (u & 1)) * DM + j)); } }
#pragma unroll
            for (int sh = 32; sh > 0; sh >>= 1) {
#pragma unroll
                for (int u = 0; u < NR; ++u) s2[u] += __shfl_xor(s2[u], sh); }
#pragma unroll
            for (int u = 0; u < NR; ++u) { const float rstd2 = rsqrtf(s2[u] * (1.0f / 1024.0f) + 1e-6f);
#pragma unroll
                for (int i = 0; i < 4; ++i) { const int j = 4 * lane + 256 * i; const f32x4 g = g10[i]; float h[4];
#pragma unroll
                    for (int e = 0; e < 4; ++e) h[e] = x1[u][i][e] * rstd2 * g[e] * (1.0f + sm[2048 + j + e]) + sm[1024 + j + e];
                    u32x2 w; w.x = pk2(h[0], h[1]); w.y = pk2(h[2], h[3]);
                    __builtin_nontemporal_store(w, (u32x2*)(H + (size_t)(row + (u >> 1) * 16 + (u & 1)) * DM + j)); } }
    };
    for (int k16 = 0; k16 < per16; ) {
        const int t16 = blockIdx.x * per16 + k16; if (t16 >= NTOK / 16) break;
        const int row = t16 * 16 + wid * 2, mrow = (t16 * 16 < NPR) ? 8 : ((t16 * 16 - NPR) >> 11);
        if (mrow != cur_mrow) { __syncthreads(); { float mv[6];
#pragma unroll
            for (int q = 0; q < 6; ++q) mv[q] = ((const float*)(p.ws + WS_MODF))[mrow * 6144 + 2048 + tid + 512 * q];
#pragma unroll
            for (int q = 0; q < 6; ++q) sm[tid + 512 * q] = mv[q]; } __syncthreads(); cur_mrow = mrow; }
        const int t16b = t16 + 1; const bool pair = (k16 + 1 < per16) && (t16b < NTOK / 16) && (((t16b * 16 < NPR) ? 8 : ((t16b * 16 - NPR) >> 11)) == mrow);
        if (pair) { body(std::integral_constant<int, 4>{}, row); k16 += 2; } else { body(std::integral_constant<int, 2>{}, row); k16 += 1; }
    }
    __syncthreads();
}

__device__ __forceinline__ void phase_final(const Params& p, unsigned char* shm) {
    float* sm = (float*)shm;
    const int tid = threadIdx.x, wid = tid >> 6, lane = tid & 63;
    const bf16_t* O2 = (const bf16_t*)(p.ws + WS_O2); const bf16_t* O2P = (const bf16_t*)(p.ws + WS_O2P); const bool split = (gridDim.x == 256);
    const int per16 = (NTOK / 16 + (int)gridDim.x - 1) / (int)gridDim.x; int cur_mrow = -1;
    auto body = [&](auto nr_tag, int row) { constexpr int NR = decltype(nr_tag)::value;
            f32x4 o[NR][4], x1[NR][4]; float ss[NR] = {};
            f32x4 g11[4];
#pragma unroll
            for (int i = 0; i < 4; ++i) g11[i] = *(const f32x4*)(p.in[11] + 4 * lane + 256 * i);
#pragma unroll
            for (int u = 0; u < NR; ++u)
#pragma unroll
                for (int i = 0; i < 4; ++i) { const int r = row + (u >> 1) * 16 + (u & 1), j = 4 * lane + 256 * i;
                    if (!split || r < 16384) { const u32x2 w = *(const u32x2*)(O2 + (size_t)r * DM + j);
                        o[u][i] = (f32x4){__uint_as_float(w.x << 16), __uint_as_float(w.x & 0xffff0000u), __uint_as_float(w.y << 16), __uint_as_float(w.y & 0xffff0000u)}; }
                    else { f32x4 a = {0.f, 0.f, 0.f, 0.f};
#pragma unroll
                        for (int pp = 0; pp < 4; ++pp) { const u32x2 w = *(const u32x2*)(O2P + ((size_t)pp * 4096 + (r - 16384)) * DM + j);
                            a += (f32x4){__uint_as_float(w.x << 16), __uint_as_float(w.x & 0xffff0000u), __uint_as_float(w.y << 16), __uint_as_float(w.y & 0xffff0000u)}; }
                        o[u][i] = a; }
                    x1[u][i] = *(const f32x4*)(p.out + (size_t)r * DM + j); }
#pragma unroll
            for (int u = 0; u < NR; ++u)
#pragma unroll
                for (int i = 0; i < 4; ++i) ss[u] += o[u][i][0] * o[u][i][0] + o[u][i][1] * o[u][i][1] + o[u][i][2] * o[u][i][2] + o[u][i][3] * o[u][i][3];
#pragma unroll
            for (int sh = 32; sh > 0; sh >>= 1) {
#pragma unroll
                for (int u = 0; u < NR; ++u) ss[u] += __shfl_xor(ss[u], sh); }
#pragma unroll
            for (int u = 0; u < NR; ++u) { const float rstd = rsqrtf(ss[u] * (1.0f / 1024.0f) + 1e-6f);
#pragma unroll
                for (int i = 0; i < 4; ++i) { const int j = 4 * lane + 256 * i; const f32x4 g = g11[i];
#pragma unroll
                    for (int e = 0; e < 4; ++e) x1[u][i][e] += sm[j + e] * (o[u][i][e] * rstd * g[e]);
                    __builtin_nontemporal_store(x1[u][i], (f32x4*)(p.out + (size_t)(row + (u >> 1) * 16 + (u & 1)) * DM + j)); } }
    };
    for (int k16 = 0; k16 < per16; ) {
        const int t16 = blockIdx.x * per16 + k16; if (t16 >= NTOK / 16) break;
        const int row = t16 * 16 + wid * 2, mrow = (t16 * 16 < NPR) ? 8 : ((t16 * 16 - NPR) >> 11);
        if (mrow != cur_mrow) { __syncthreads(); { float mv[2];
#pragma unroll
            for (int q = 0; q < 2; ++q) mv[q] = ((const float*)(p.ws + WS_MODF))[mrow * 6144 + 5120 + tid + 512 * q];
#pragma unroll
            for (int q = 0; q < 2; ++q) sm[tid + 512 * q] = mv[q]; } __syncthreads(); cur_mrow = mrow; }
        const int t16b = t16 + 1; const bool pair = (k16 + 1 < per16) && (t16b < NTOK / 16) && (((t16b * 16 < NPR) ? 8 : ((t16b * 16 - NPR) >> 11)) == mrow);
        if (pair) { body(std::integral_constant<int, 4>{}, row); k16 += 2; } else { body(std::integral_constant<int, 2>{}, row); k16 += 1; }
    }
    __syncthreads();
}

template <class Epi>
__device__ __forceinline__ void run_gemm(unsigned char* shm, const bf16_t* A, const bf16_t* Bt, int M, int N, int K, const Epi& E) {
    pg8::Gemm g; g.A = A; g.Bt = Bt; g.M = M; g.N = N; g.K = K;
    pg8::StaticOrder S; S.init(M, N, (int)gridDim.x, (int)blockIdx.x, K);
    pg8::gemm_phase<Epi, pg8::StaticOrder>((PG8_LAS unsigned char*)shm, g, S, E);
}

template <class Epi>
__device__ __forceinline__ void run_gemm_split(unsigned char* shm, const bf16_t* A, const bf16_t* Bt, int M, int N, int K, const Epi& E) {
    pg8::Gemm g; g.A = A; g.Bt = Bt; g.M = M; g.N = N; g.K = K;
    pg8::SplitTailOrder S; S.init((int)blockIdx.x, K);
    pg8::gemm_phase<Epi, pg8::SplitTailOrder>((PG8_LAS unsigned char*)shm, g, S, E);
}

__global__ void __launch_bounds__(512, 2) fwd_megakernel(Params p, int ph_lo, int ph_hi, int coop) {
    extern __shared__ __attribute__((aligned(16))) unsigned char shm[];
    cg::grid_group grid = cg::this_grid();
    volatile LAS unsigned* xbst = (volatile LAS unsigned*)(shm + LDS_BYTES - 16);
    if (threadIdx.x == 0) { xbst[0] = 0u; xbst[1] = 0u; }
    __syncthreads();
    XcdBarrier xb = xcd_barrier_post((unsigned*)(p.ws + WS_BAR), xbst);
    if (coop == 2) grid.sync();
#ifndef PH_MASK
#define PH_MASK 0x7ff
#endif
#define PH_ON(k) ((PH_MASK & (1 << (k))) && ph_lo <= (k) && (k) < ph_hi)
#define PH_R(k) ((PH_REP >> (k)) & 1)
#define PH_SYNC(k) do { if (coop && (k) + 1 < ph_hi && ph_lo <= (k)) { xcd_barrier(xb); } } while (0)
    if (PH_ON(0)) for (int rep = 0; rep <= PH_R(0); ++rep) phase0(p, shm);
    PH_SYNC(0);
    if (PH_ON(1)) for (int rep = 0; rep <= PH_R(1); ++rep) phase_h1(p, shm);
    PH_SYNC(1);
    if (PH_ON(2)) for (int rep = 0; rep <= PH_R(2); ++rep) { EpiB16<2> E; E.O = (bf16_t*)(p.ws + WS_Z); E.ldc = DIN; E.ncols = DIN;
        run_gemm(shm, (const bf16_t*)(p.ws + WS_ACT), (const bf16_t*)(p.ws + WS_WINT), NTOK, DINP, 1024, E);
        if (gridDim.x == 256 && blockIdx.x >= 192) deferred_transposes(p, shm, 0, (int)blockIdx.x - 192, 64); }
    PH_SYNC(2);
    if (PH_ON(3)) for (int rep = 0; rep <= PH_R(3); ++rep) phase_prep(p, shm);
    PH_SYNC(3);
    if (PH_ON(4)) for (int rep = 0; rep <= PH_R(4); ++rep) phase_scan(p, shm);
    PH_SYNC(4);
    if (PH_ON(5)) for (int rep = 0; rep <= PH_R(5); ++rep) phase_combine(p);
    PH_SYNC(5);
    if (PH_ON(6)) for (int rep = 0; rep <= PH_R(6); ++rep) { EpiSplitB16 E; E.O = (bf16_t*)(p.ws + WS_O1); E.P = (bf16_t*)(p.ws + WS_O1P);
        run_gemm(shm, (const bf16_t*)(p.ws + WS_ACT), (const bf16_t*)(p.ws + WS_WOUTT), NTOK, 1024, 1024, E);
        if (gridDim.x == 256 && blockIdx.x >= 64) deferred_transposes(p, shm, 1, (int)blockIdx.x - 64, 192); }
    PH_SYNC(6);
    if (PH_ON(7)) for (int rep = 0; rep <= PH_R(7); ++rep) phase_res1(p, shm);
    PH_SYNC(7);
    if (PH_ON(8)) for (int rep = 0; rep <= PH_R(8); ++rep) { EpiB16<1> E; E.O = (bf16_t*)(p.ws + WS_F); E.ldc = DFF; E.ncols = DFF;
        run_gemm(shm, (const bf16_t*)(p.ws + WS_ACT), (const bf16_t*)(p.ws + WS_W1T), NTOK, DFF, 1024, E); }
    PH_SYNC(8);
    if (PH_ON(9)) for (int rep = 0; rep <= PH_R(9); ++rep) { EpiSplitB16 E; E.O = (bf16_t*)(p.ws + WS_O2); E.P = (bf16_t*)(p.ws + WS_O2P);
        if (gridDim.x == 256) run_gemm_split(shm, (const bf16_t*)(p.ws + WS_F), (const bf16_t*)(p.ws + WS_W2T), NTOK, 1024, DFF, E);
        else run_gemm(shm, (const bf16_t*)(p.ws + WS_F), (const bf16_t*)(p.ws + WS_W2T), NTOK, 1024, DFF, E); }
    PH_SYNC(9);
    if (PH_ON(10)) phase_final(p, shm);
}
}

extern "C" void kernel_launch(void* const* d_in, const int* in_sizes, int n_in, void* d_out, int out_size, void* d_ws, size_t ws_size, hipStream_t stream) {
    static int grid_blocks = 0;
    if (grid_blocks == 0) {
        int dev = 0, cus = 0, per_cu = 0;
        hipGetDevice(&dev);
        hipDeviceGetAttribute(&cus, hipDeviceAttributeMultiprocessorCount, dev);
        if (hipFuncSetAttribute((const void*)fwd_megakernel, hipFuncAttributeMaxDynamicSharedMemorySize, LDS_BYTES) != hipSuccess) { fprintf(stderr, "hipFuncSetAttribute failed\n"); }
        if (hipOccupancyMaxActiveBlocksPerMultiprocessor(&per_cu, (const void*)fwd_megakernel, 512, LDS_BYTES) != hipSuccess || per_cu < 1) { fprintf(stderr, "occupancy query: %d\n", per_cu); per_cu = 1; }
        (void)hipGetLastError();
        grid_blocks = cus * per_cu;
        if (n_in != 33 || ws_size < 256 * MiB) fprintf(stderr, "unexpected n_in %d / ws_size %zu\n", n_in, ws_size);
    }
    Params p{};
    for (int i = 0; i < 33; ++i) p.in[i] = (const float*)d_in[i];
    p.out = (float*)d_out; p.ws = (unsigned char*)d_ws;
#if MK_LAUNCHES == 1
    (void)hipMemsetAsync((unsigned char*)d_ws + WS_BAR, 0, XCD_BAR_WORDS * sizeof(unsigned), stream);
    int lo = 0, hi = 11, coop = 1;
    void* args[] = {&p, &lo, &hi, &coop};
    hipError_t e = hipLaunchCooperativeKernel((const void*)fwd_megakernel, dim3(grid_blocks), dim3(512), args, LDS_BYTES, stream);
    if (e != hipSuccess) fprintf(stderr, "cooperative launch failed: %s (grid %d)\n", hipGetErrorString(e), grid_blocks);
#else
    for (int ph = 0; ph < 11; ++ph) for (int rep = 0; rep <= ((HOST_REP >> ph) & 1); ++rep) hipLaunchKernelGGL(fwd_megakernel, dim3(grid_blocks), dim3(512), LDS_BYTES, stream, p, ph, ph + 1, 0);
#endif
}
```

```cpp
#include <hip/hip_runtime.h>
#include <hip/hip_cooperative_groups.h>
#include <cstdio>
#include <type_traits>
namespace cg = cooperative_groups;
#ifndef PH_REP
#define PH_REP 0
#endif
#define PH_R(k) ((PH_REP >> (k)) & 1)
#ifndef HOST_REP
#define HOST_REP 0
#endif
#ifndef LRU_LO
#define LRU_LO 3
#endif
#ifndef MK_LAUNCHES
#define MK_LAUNCHES 1
#endif
namespace pg8 {
#define PG8_LAS __attribute__((address_space(3)))
typedef unsigned short bf16_t;
typedef short bf16x8 __attribute__((ext_vector_type(8)));
typedef float f32x4 __attribute__((ext_vector_type(4)));
typedef unsigned u32x4 __attribute__((ext_vector_type(4)));
constexpr int BM = 256, BK = 64, HALF = 128, HTB = HALF * BK * 2  , STAGE_BYTES = 8 * HTB, NXCD = 8, WGM = 8;

__host__ __device__ __forceinline__ int lds_byte(int r, int c) { const int st = (r >> 4) * 2 + (c >> 5), rr = r & 15, cc = c & 31, ob = rr * 64 + cc * 2; return st * 1024 + (ob ^ (((ob >> 9) & 1) << 5)); }
__host__ __device__ __forceinline__ void stage_rc(int b, int& R, int& C) { const int st = b / 1024, sb = b % 1024, swz = sb ^ (((sb >> 9) & 1) << 5); R = (st >> 1) * 16 + swz / 64; C = (st & 1) * 32 + (swz % 64) / 2; }
__host__ __device__ __forceinline__ int perm32(int rho) { const int n = rho >> 4, i = rho & 15; return 8 * (i >> 2) + 4 * n + (i & 3); }

struct Unit { int pm, pn, k0, nk, part; };
struct Gemm { const bf16_t* A; const bf16_t* Bt; int M, N, K; };

struct StaticOrder {
    int nM, nN, nwg, G, c;
    int nkt;
    __host__ __device__ void init(int M, int N, int G_, int c_, int K_) { nM = M / BM; nN = N / BM; nwg = nM * nN; G = G_; c = c_; nkt = K_ / BK; }
    __host__ __device__ bool next(int i, Unit& u) const {
        const long L = (long)i * G + c; if (L >= nwg) return false;
        int wgid = (int)L; { const int q = nwg / NXCD, r = nwg % NXCD, xcd = wgid % NXCD, off = wgid / NXCD; wgid = (xcd < r ? xcd * (q + 1) : r * (q + 1) + (xcd - r) * q) + off; }
        const int nig = WGM * nN, gid = wgid / nig, fm = gid * WGM, gsz = (nM - fm) < WGM ? (nM - fm) : WGM;
        u.pm = fm + ((wgid % nig) % gsz); u.pn = (wgid % nig) / gsz; u.k0 = 0; u.nk = nkt; u.part = -1; return true;
    }
    __device__ __forceinline__ void a_ready(const Unit&) const {}
    __device__ __forceinline__ void done(const Unit&) const {}
};
typedef __bf16 bf16v2_t __attribute__((ext_vector_type(2)));
__device__ __forceinline__ unsigned cvt_pk_bf16(float lo, float hi) { bf16v2_t v; v.x = (__bf16)lo; v.y = (__bf16)hi; return __builtin_bit_cast(unsigned, v); }
struct SplitTailOrder {
    int c, nkt;
    __host__ __device__ void init(int c_, int K_) { c = c_; nkt = K_ / BK; }
    __host__ __device__ bool next(int i, Unit& u) const {
        const int x = c & 7, idx = c >> 3;
        if (i == 0) { const int w = x * 32 + idx; u.pm = w >> 2; u.pn = w & 3; u.k0 = 0; u.nk = nkt; u.part = -1; return true; }
        if (i == 1) { const int t = x * 8 + (idx >> 2), part = idx & 3; u.pm = 64 + (t >> 2); u.pn = t & 3; u.nk = nkt / 4; u.k0 = part * (nkt / 4) * BK; u.part = part; return true; }
        return false;
    }
    __device__ __forceinline__ void a_ready(const Unit&) const {}
    __device__ __forceinline__ void done(const Unit&) const {}
};
template <class Epi, class Sched>
__device__ __forceinline__ void gemm_phase(PG8_LAS unsigned char* lds, const Gemm g, const Sched& S, const Epi& E) {
    const int tid = threadIdx.x, wid = __builtin_amdgcn_readfirstlane(tid >> 6), lane = tid & 63, wr = wid >> 2, wc = wid & 3, fr = lane & 15, fq = lane >> 4;
    const int K = g.K;
    unsigned voffA[2], voffB[2];
#pragma unroll
    for (int i = 0; i < 2; ++i) { int R, C; stage_rc(tid * 16 + i * 8192, R, C); const int Rb = Epi::PERM ? ((R & ~31) + perm32(R & 31)) : R;
        voffA[i] = (unsigned)(R * K + C) * 2u; voffB[i] = (unsigned)(Rb * K + C) * 2u; }
    const size_t kstep = (size_t)(BK * 2);
    const size_t hstep = (size_t)HALF * K * 2;
    const size_t tstep = 2 * hstep;
    const unsigned ldsw = (unsigned)wid * 1024u;
    const int aoff = lds_byte(wr * 64 + fr, fq * 8), boff = lds_byte(wc * 32 + fr, fq * 8);
#define PG8_SA(b, h) (((b) * 2 + (h)) * HTB)
#define PG8_SB(b, h) ((4 + (b) * 2 + (h)) * HTB)
#define PG8_STAGE(bufoff, gbase, voff) do { _Pragma("unroll") for (int _i = 0; _i < 2; ++_i) \
        __builtin_amdgcn_global_load_lds((const unsigned*)((const char*)(gbase) + (voff)[_i]), (PG8_LAS unsigned*)(lds + (bufoff) + ldsw + _i * 8192), 16, 0, 0); } while (0)
#define PG8_LDA(dst, b, h) do { _Pragma("unroll") for (int m = 0; m < 4; ++m) _Pragma("unroll") for (int k = 0; k < 2; ++k) dst[m][k] = *(const PG8_LAS bf16x8*)(lds + PG8_SA(b, h) + aoff + m * 2048 + k * 1024); } while (0)
#define PG8_LDB(dst, b, h) do { _Pragma("unroll") for (int n = 0; n < 2; ++n) _Pragma("unroll") for (int k = 0; k < 2; ++k) dst[n][k] = *(const PG8_LAS bf16x8*)(lds + PG8_SB(b, h) + boff + n * 2048 + k * 1024); } while (0)
#define PG8_MMA(ai, bj, At, Bt) do { __builtin_amdgcn_s_setprio(1); _Pragma("unroll") for (int m = 0; m < 4; ++m) _Pragma("unroll") for (int n = 0; n < 2; ++n) _Pragma("unroll") for (int k = 0; k < 2; ++k) \
        acc[ai][bj][m][n] = __builtin_amdgcn_mfma_f32_16x16x32_bf16(Bt[n][k], At[m][k], acc[ai][bj][m][n], 0, 0, 0); __builtin_amdgcn_s_setprio(0); } while (0)
#define PG8_WAIT_V(n) asm volatile("s_waitcnt vmcnt(" #n ")" ::: "memory")
#define PG8_WAIT_L(n) asm volatile("s_waitcnt lgkmcnt(" #n ")" ::: "memory")
#define PG8_BAR __builtin_amdgcn_s_barrier()
#define PG8_SCHED __builtin_amdgcn_sched_barrier(0)
    Unit cur, nxt; int ui = 0;
    if (!S.next(0, cur)) return;
    f32x4 acc[2][2][4][2];
#pragma unroll
    for (int a = 0; a < 2; ++a)
#pragma unroll
        for (int b = 0; b < 2; ++b)
#pragma unroll
            for (int m = 0; m < 4; ++m)
#pragma unroll
                for (int n = 0; n < 2; ++n) acc[a][b][m][n] = (f32x4){0.f, 0.f, 0.f, 0.f};
    bf16x8 At[4][2], B0[2][2], B1[2][2];
    const char* cA = (const char*)g.A + (size_t)cur.pm * tstep + (size_t)cur.k0 * 2; const char* cB = (const char*)g.Bt + (size_t)cur.pn * tstep + (size_t)cur.k0 * 2;
    S.a_ready(cur);
    PG8_STAGE(PG8_SB(0, 0), cB, voffB); PG8_STAGE(PG8_SA(0, 0), cA, voffA); PG8_STAGE(PG8_SB(0, 1), cB + hstep, voffB); PG8_STAGE(PG8_SA(0, 1), cA + hstep, voffA);
    if (wr == 1) PG8_BAR;
    PG8_WAIT_V(4); PG8_BAR;
    PG8_STAGE(PG8_SB(1, 0), cB + kstep, voffB); PG8_STAGE(PG8_SA(1, 0), cA + kstep, voffA); PG8_STAGE(PG8_SB(1, 1), cB + hstep + kstep, voffB);
    PG8_WAIT_V(6); PG8_BAR;
    for (;;) {
        const bool has_next = S.next(ui + 1, nxt);
        const char* nA = has_next ? (const char*)g.A + (size_t)nxt.pm * tstep + (size_t)nxt.k0 * 2 : cA; const char* nB = has_next ? (const char*)g.Bt + (size_t)nxt.pn * tstep + (size_t)nxt.k0 * 2 : cB;
        const int nt = cur.nk;
        for (int t = 0; t < nt; t += 2) {
            const bool last = (t == nt - 2);
            const char* a1 = cA + (size_t)(t + 1) * kstep;
            const char* a2 = last ? nA : cA + (size_t)(t + 2) * kstep; const char* b2 = last ? nB : cB + (size_t)(t + 2) * kstep;
            const char* a3 = a2 + kstep; const char* b3 = b2 + kstep;
            if (last && has_next) S.a_ready(nxt);
            PG8_LDB(B0, 0, 0); PG8_SCHED; PG8_LDA(At, 0, 0); PG8_STAGE(PG8_SA(1, 1), a1 + hstep, voffA);
            PG8_WAIT_L(8); PG8_BAR; PG8_WAIT_L(0); PG8_MMA(0, 0, At, B0); PG8_BAR; PG8_SCHED;
            PG8_LDB(B1, 0, 1); PG8_STAGE(PG8_SB(0, 0), b2, voffB);
            PG8_BAR; PG8_WAIT_L(0); PG8_MMA(0, 1, At, B1); PG8_BAR;
            PG8_LDA(At, 0, 1); PG8_STAGE(PG8_SA(0, 0), a2, voffA);
            PG8_BAR; PG8_WAIT_L(0); PG8_MMA(1, 0, At, B0); PG8_BAR; PG8_SCHED;
            PG8_STAGE(PG8_SB(0, 1), b2 + hstep, voffB);
            PG8_WAIT_V(6); PG8_BAR; PG8_MMA(1, 1, At, B1); PG8_BAR;
            PG8_LDB(B0, 1, 0); PG8_SCHED; PG8_LDA(At, 1, 0); PG8_STAGE(PG8_SA(0, 1), a2 + hstep, voffA);
            PG8_WAIT_L(8); PG8_BAR; PG8_WAIT_L(0); PG8_MMA(0, 0, At, B0); PG8_BAR; PG8_SCHED;
            PG8_LDB(B1, 1, 1); PG8_STAGE(PG8_SB(1, 0), b3, voffB);
            PG8_BAR; PG8_WAIT_L(0); PG8_MMA(0, 1, At, B1); PG8_BAR;
            PG8_LDA(At, 1, 1); PG8_STAGE(PG8_SA(1, 0), a3, voffA);
            PG8_BAR; PG8_WAIT_L(0); PG8_MMA(1, 0, At, B0); PG8_BAR; PG8_SCHED;
            PG8_STAGE(PG8_SB(1, 1), b3 + hstep, voffB);
            PG8_WAIT_V(6); PG8_BAR; PG8_MMA(1, 1, At, B1); PG8_BAR;
        }
        if constexpr (!Epi::AFTER_DRAIN) { E(acc, cur, wr, wc, fr, fq); S.done(cur); }
        if (!has_next) break;
#pragma unroll
        for (int a = 0; a < 2; ++a)
#pragma unroll
            for (int b = 0; b < 2; ++b)
#pragma unroll
                for (int m = 0; m < 4; ++m)
#pragma unroll
                    for (int n = 0; n < 2; ++n) acc[a][b][m][n] = (f32x4){0.f, 0.f, 0.f, 0.f};
        cur = nxt; cA = nA; cB = nB; ++ui;
    }
    PG8_WAIT_V(0);
    if (wr == 0) PG8_BAR;
    PG8_BAR;
    if constexpr (Epi::AFTER_DRAIN) { E.fused(acc, cur, wr, wc, fr, fq, lds, wid, lane); S.done(cur); }
#undef PG8_SA
#undef PG8_SB
#undef PG8_STAGE
#undef PG8_LDA
#undef PG8_LDB
#undef PG8_MMA
#undef PG8_WAIT_V
#undef PG8_WAIT_L
#undef PG8_BAR
#undef PG8_SCHED
}
}

#define XB_TMO      128
#define XB_XCNT(j)  (256  + 64 * (j))
#define XB_XSUB(j)  (1280 + 64 * (j))
#define XB_XGEN(j)  (2304 + 64 * (j))
#define XB_TOP      3328
#define XB_TOPGEN   3392
#define XCD_BAR_WORDS 3456
#define XB_SPIN_CAP (1u << 18)
#define LAS __attribute__((address_space(3)))

__device__ __forceinline__ unsigned xb_ld(unsigned* p)              { return __hip_atomic_load(p, __ATOMIC_RELAXED, __HIP_MEMORY_SCOPE_AGENT); }
__device__ __forceinline__ unsigned xb_add(unsigned* p, unsigned v) { return __hip_atomic_fetch_add(p, v, __ATOMIC_RELAXED, __HIP_MEMORY_SCOPE_AGENT); }
__device__ __forceinline__ unsigned xb_xcc_id() { return (unsigned)__builtin_amdgcn_s_getreg((3 << 11) | 20) & 0xFu; }
#define XB_SPIN(cond, bar) do { unsigned _sp = 0; while (cond) { __builtin_amdgcn_s_sleep(1); \
    if ((++_sp & 255u) == 0u) { if (xb_ld(&(bar)[XB_TMO])) break; if (_sp > XB_SPIN_CAP) { atomicAdd(&(bar)[XB_TMO], 1u); break; } } } } while (0)

struct XcdBarrier {
    unsigned* bar; unsigned x;
    volatile LAS unsigned* st;
};

__device__ __forceinline__ XcdBarrier xcd_barrier_post(unsigned* bar, volatile LAS unsigned* st) {
    XcdBarrier b; b.bar = bar; b.x = xb_xcc_id(); b.st = st;
    if (threadIdx.x == 0) (void)xb_add(&bar[XB_XCNT(b.x)], 1u);
    return b;
}
__device__ __forceinline__ void xcd_barrier_complete(unsigned* bar, unsigned x, unsigned& nloc, unsigned& nx) {
    const unsigned G = gridDim.x * gridDim.y * gridDim.z;
    unsigned sum, cnt, mine, sp = 0u;
    for (;;) {
        sum = 0u; cnt = 0u; mine = 0u;
#pragma unroll
        for (unsigned j = 0; j < 16; ++j) { const unsigned c = xb_ld(&bar[XB_XCNT(j)]); sum += c; cnt += (c > 0u) ? 1u : 0u; mine = (j == x) ? c : mine; }
        if (sum == G) break;
        __builtin_amdgcn_s_sleep(1);
        if ((++sp & 255u) == 0u) { if (xb_ld(&bar[XB_TMO])) break; if (sp > XB_SPIN_CAP) { atomicAdd(&bar[XB_TMO], 1u); break; } }
    }
    nloc = mine > 0u ? mine : 1u; nx = cnt > 0u ? cnt : 1u;
}

__device__ __forceinline__ void xcd_barrier(const XcdBarrier& b) {
    asm volatile("s_waitcnt vmcnt(0)" ::: "memory");
    __syncthreads();
    if (threadIdx.x == 0) {
        unsigned* bar = b.bar;
        __builtin_amdgcn_s_waitcnt(0);
        unsigned nloc = b.st[0], nx = b.st[1];
        if (nloc == 0u) { xcd_barrier_complete(bar, b.x, nloc, nx); b.st[0] = nloc; b.st[1] = nx; }
        const unsigned old = xb_add(&bar[XB_XSUB(b.x)], 1u);
        const unsigned gen = old / nloc;
        if (old + 1u == (gen + 1u) * nloc) {
            __builtin_amdgcn_fence(__ATOMIC_RELEASE, "agent");
            asm volatile("s_waitcnt vmcnt(0)" ::: "memory");
            const unsigned og = xb_add(&bar[XB_TOP], 1u);
            const unsigned tg = og / nx;
            if (og + 1u == (tg + 1u) * nx) xb_add(&bar[XB_TOPGEN], 1u);
            else XB_SPIN(xb_ld(&bar[XB_TOPGEN]) == tg, bar);
            __builtin_amdgcn_fence(__ATOMIC_ACQUIRE, "agent");
            xb_add(&bar[XB_XGEN(b.x)], 1u);
            asm volatile("s_waitcnt vmcnt(0)" ::: "memory");
        } else {
            XB_SPIN(xb_ld(&bar[XB_XGEN(b.x)]) == gen, bar);
            __builtin_amdgcn_fence(__ATOMIC_ACQUIRE, "agent");
            asm volatile("s_waitcnt vmcnt(0)" ::: "memory");
        }
    }
    __syncthreads();
}

namespace {
using pg8::bf16_t; using pg8::bf16x8; using pg8::f32x4; using pg8::u32x4;
typedef unsigned u32x2 __attribute__((ext_vector_type(2)));

constexpr int DM = 1024, NTOK = 20480, NPR = 4096, DIN = 2944, DINP = 3072, DFF = 4096;
constexpr int ZR = 0, ZK = 512, ZV = 1024, ZXW = 1536, ZXA = 1664, ZXG = 1792, ZXB = 1920, ZGB = 2432;
constexpr int NTILE = NTOK / 64;
constexpr size_t MiB = 1048576;
constexpr size_t WS_W2T = 0;
constexpr size_t WS_WUPT = 8 * MiB;
constexpr size_t WS_AUPT = WS_WUPT + 131072;
constexpr size_t WS_GUPT = WS_AUPT + 131072;
constexpr size_t WS_WAT = WS_GUPT + 131072;
constexpr size_t WS_WXT = WS_WAT + 131072;
constexpr size_t WS_ROWTAB = WS_WXT + 131072;
constexpr size_t WS_COLTAB = WS_ROWTAB + 65536;
constexpr size_t WS_MODPART = 9 * MiB;
constexpr size_t WS_BAR = 12 * MiB + 512 * 1024;
constexpr size_t WS_MODF = WS_BAR + 65536;
constexpr size_t WS_F = 13 * MiB;
constexpr size_t WS_Z = WS_F;
constexpr size_t WS_YA = WS_F + 115 * MiB;
constexpr size_t WS_O1 = WS_F;
constexpr size_t WS_O1P = WS_F + 40 * MiB;
constexpr size_t WS_C = 173 * MiB;
constexpr size_t WS_WINT = WS_C;
constexpr size_t WS_WOUTT = WS_C + 6 * MiB;
constexpr size_t WS_W1T = WS_C + 8 * MiB;
constexpr size_t WS_ACT = WS_C + 16 * MiB;
constexpr size_t WS_G = WS_C + 56 * MiB;
constexpr size_t WS_INV = WS_C + 76 * MiB;
constexpr size_t WS_BON = WS_INV + 655360;
constexpr size_t WS_CAR = WS_BON + 655360;
constexpr size_t WS_O2 = WS_C;
constexpr size_t WS_O2P = WS_C + 40 * MiB;
constexpr size_t OUT_RWKV = (size_t)NTOK * DM;
constexpr size_t OUT_LRU = OUT_RWKV + 16 * 2 * 8 * 4096;

constexpr int LDS_BYTES = 154 * 1024;

struct Params {
    const float* in[33];
    float* out;
    unsigned char* ws;
};

__device__ __forceinline__ float bf2f(unsigned short b) { return __uint_as_float(((unsigned)b) << 16); }
__device__ __forceinline__ unsigned short f2bf(float f) { return __builtin_bit_cast(unsigned short, (__bf16)f); }
__device__ __forceinline__ unsigned pk2(float lo, float hi) { return pg8::cvt_pk_bf16(lo, hi); }
__device__ __forceinline__ void unpack8(const u32x4 w, float* f) {
    f[0] = __uint_as_float(w.x << 16); f[1] = __uint_as_float(w.x & 0xffff0000u);
    f[2] = __uint_as_float(w.y << 16); f[3] = __uint_as_float(w.y & 0xffff0000u);
    f[4] = __uint_as_float(w.z << 16); f[5] = __uint_as_float(w.z & 0xffff0000u);
    f[6] = __uint_as_float(w.w << 16); f[7] = __uint_as_float(w.w & 0xffff0000u);
}
__device__ __forceinline__ u32x4 pack8(const float* f) { u32x4 w; w.x = pk2(f[0], f[1]); w.y = pk2(f[2], f[3]); w.z = pk2(f[4], f[5]); w.w = pk2(f[6], f[7]); return w; }
__device__ __forceinline__ float sigmoidf_(float x) { return __builtin_amdgcn_rcpf(1.0f + __expf(-x)); }
__device__ __forceinline__ float softplusf_(float y) {
    if (y > 15.0f) return y;
    const float e = __expf(y), u = 1.0f + e;
    return (u == 1.0f) ? e : __logf(u) * (e * __builtin_amdgcn_rcpf(u - 1.0f));
}
__device__ __forceinline__ float tanhf_(float x) { const float e = __expf(2.0f * x); return 1.0f - 2.0f * __builtin_amdgcn_rcpf(e + 1.0f); }
__device__ __forceinline__ float wave_sum(float v) {
#pragma unroll
    for (int o = 32; o > 0; o >>= 1) v += __shfl_xor(v, o);
    return v;
}
__device__ __forceinline__ float sum8(float v) { v += __shfl_xor(v, 1); v += __shfl_xor(v, 2); v += __shfl_xor(v, 4); return v; }

struct TileInfo { int row0; int mrow; int b; int t0; int T; int seqrow0; int sample; int tile0; int ntile; };
__device__ __forceinline__ TileInfo tile_info(int tile) {
    TileInfo ti; ti.row0 = tile * 64;
    if (tile < 64) { ti.sample = 0; ti.b = tile >> 2; ti.t0 = (tile & 3) * 64; ti.T = 256; ti.mrow = 8; ti.seqrow0 = ti.b * 256; ti.tile0 = ti.b * 4; ti.ntile = 4; }
    else { const int s = tile - 64; ti.sample = 1; ti.b = s >> 5; ti.t0 = (s & 31) * 64; ti.T = 2048; ti.mrow = ti.b; ti.seqrow0 = NPR + ti.b * 2048; ti.tile0 = 64 + ti.b * 32; ti.ntile = 32; }
    return ti;
}
__device__ __forceinline__ f32x4 load_x4(const Params& p, int row, int j) {
    if (row < NPR) return __builtin_nontemporal_load((const f32x4*)(p.in[0] + (size_t)row * DM + j));
    const int r = row - NPR, t = r & 2047;
    f32x4 x = __builtin_nontemporal_load((const f32x4*)(p.in[1] + (size_t)r * DM + j));
    const float* tab = (j < 512) ? (const float*)(p.ws + WS_ROWTAB) + (t >> 6) * 512 + j : (const float*)(p.ws + WS_COLTAB) + (t & 63) * 512 + (j - 512);
    const f32x4 e = *(const f32x4*)tab;
    return x + e;
}
__device__ __forceinline__ float mod_val(const Params& p, int mrow, int col) {
    const float* mp = (const float*)(p.ws + WS_MODPART);
    float s = p.in[7][col];
#pragma unroll
    for (int ks = 0; ks < 16; ++ks) s += mp[(size_t)(ks * 9 + mrow) * 6144 + col];
    return s;
}

__device__ __forceinline__ f32x4 mm16(const bf16_t* A, int lda, const bf16_t* BT, int ldb, int K, int lane) {
    const int fr = lane & 15, fq = lane >> 4;
    f32x4 acc = {0.f, 0.f, 0.f, 0.f};
    for (int kk = 0; kk < K; kk += 32) {
        const bf16x8 a = *(const bf16x8*)(A + fr * lda + kk + 8 * fq);
        const bf16x8 b = *(const bf16x8*)(BT + (size_t)fr * ldb + kk + 8 * fq);
        acc = __builtin_amdgcn_mfma_f32_16x16x32_bf16(a, b, acc, 0, 0, 0);
    }
    return acc;
}

template <int ACT> struct EpiB16 {
    static constexpr bool PERM = true, AFTER_DRAIN = false;
    bf16_t* O; int ldc; int ncols;
    __device__ __forceinline__ void operator()(const f32x4 (&acc)[2][2][4][2], const pg8::Unit& u, int wr, int wc, int fr, int fq) const {
        const int row0 = u.pm * 256 + wr * 64 + fr; const int col0 = u.pn * 256 + wc * 32 + 8 * fq;
#pragma unroll
        for (int ai = 0; ai < 2; ++ai)
#pragma unroll
            for (int m = 0; m < 4; ++m) { bf16_t* rowp = O + (size_t)(row0 + ai * 128 + m * 16) * ldc + col0;
#pragma unroll
                for (int bj = 0; bj < 2; ++bj) { f32x4 v0 = acc[ai][bj][m][0], v1 = acc[ai][bj][m][1];
                    if (ACT == 1) {
#pragma unroll
                        for (int j = 0; j < 4; ++j) { const float a = fmaxf(v0[j], 0.f), b = fmaxf(v1[j], 0.f); v0[j] = a * a; v1[j] = b * b; } }
                    if (ACT == 2 && bj == 0) {
                        if (u.pn == 6) {
#pragma unroll
                            for (int j = 0; j < 4; ++j) { v0[j] = tanhf_(v0[j]); v1[j] = tanhf_(v1[j]); } }
                        if (u.pn == 7) {
#pragma unroll
                            for (int j = 0; j < 4; ++j) { v0[j] = sigmoidf_(v0[j]); v1[j] = sigmoidf_(v1[j]); } } }
                    u32x4 w; w.x = pg8::cvt_pk_bf16(v0[0], v0[1]); w.y = pg8::cvt_pk_bf16(v0[2], v0[3]); w.z = pg8::cvt_pk_bf16(v1[0], v1[1]); w.w = pg8::cvt_pk_bf16(v1[2], v1[3]);
                    if (col0 + bj * 128 < ncols) *(u32x4*)(rowp + bj * 128) = w; } }
    }
};
struct EpiSplitB16 {
    static constexpr bool PERM = true, AFTER_DRAIN = false;
    bf16_t* O; bf16_t* P;
    __device__ __forceinline__ void operator()(const f32x4 (&acc)[2][2][4][2], const pg8::Unit& u, int wr, int wc, int fr, int fq) const {
        const int row0 = u.pm * 256 + wr * 64 + fr; const int col0 = u.pn * 256 + wc * 32 + 8 * fq;
        bf16_t* base = (u.part < 0) ? O + (size_t)row0 * 1024 : P + ((size_t)u.part * 4096 + (row0 - 16384)) * 1024;
#pragma unroll
        for (int ai = 0; ai < 2; ++ai)
#pragma unroll
            for (int m = 0; m < 4; ++m) { bf16_t* rowp = base + (size_t)(ai * 128 + m * 16) * 1024 + col0;
#pragma unroll
                for (int bj = 0; bj < 2; ++bj) { const f32x4 v0 = acc[ai][bj][m][0], v1 = acc[ai][bj][m][1];
                    u32x4 w; w.x = pg8::cvt_pk_bf16(v0[0], v0[1]); w.y = pg8::cvt_pk_bf16(v0[2], v0[3]); w.z = pg8::cvt_pk_bf16(v1[0], v1[1]); w.w = pg8::cvt_pk_bf16(v1[2], v1[3]);
                    *(u32x4*)(rowp + bj * 128) = w; } }
    }
};
struct EpiF {
    static constexpr bool PERM = false, AFTER_DRAIN = false;
    float* C; int ldc;
    __device__ __forceinline__ void operator()(const f32x4 (&acc)[2][2][4][2], const pg8::Unit& u, int wr, int wc, int fr, int fq) const {
        const int row0 = u.pm * 256 + wr * 64 + fr, col0 = u.pn * 256 + wc * 32 + 4 * fq;
#pragma unroll
        for (int ai = 0; ai < 2; ++ai)
#pragma unroll
            for (int m = 0; m < 4; ++m) { float* rowp = C + (size_t)(row0 + ai * 128 + m * 16) * ldc + col0;
#pragma unroll
                for (int bj = 0; bj < 2; ++bj)
#pragma unroll
                    for (int n = 0; n < 2; ++n) *(f32x4*)(rowp + bj * 128 + n * 16) = acc[ai][bj][m][n]; }
    }
};

__device__ __forceinline__ void transpose_tile(const float* src, int N, int Nvalid, bf16_t* dst, int K, int n0, int k0, float* tile) {
    const int tid = threadIdx.x;
    {   const int r = tid >> 4, c4 = (tid & 15) * 4;
#pragma unroll
        for (int pss = 0; pss < 2; ++pss) { const int rr = r + pss * 32;
            f32x4 v = {0.f, 0.f, 0.f, 0.f};
            if (n0 < Nvalid) v = *(const f32x4*)(src + (size_t)(k0 + rr) * N + n0 + c4);
            tile[rr * 65 + c4 + 0] = v[0]; tile[rr * 65 + c4 + 1] = v[1]; tile[rr * 65 + c4 + 2] = v[2]; tile[rr * 65 + c4 + 3] = v[3]; } }
    __syncthreads();
    {   const int rr = tid >> 3, kc = (tid & 7) * 8; float f[8];
#pragma unroll
        for (int j = 0; j < 8; ++j) f[j] = tile[(kc + j) * 65 + rr];
        *(u32x4*)(dst + (size_t)(n0 + rr) * K + k0 + kc) = pack8(f); }
    __syncthreads();
}

__device__ __forceinline__ void phase0(const Params& p, unsigned char* shm) {
    float* tile = (float*)shm;
    const int tid = threadIdx.x;
    const bool defer = (gridDim.x == 256);
    constexpr int N_TR = 3072, N_MOD = 192, N_SW = 160, N_TAB = 24;
    for (int it0 = blockIdx.x; it0 < (defer ? 768 : N_TR) + N_MOD + N_SW + N_TAB; it0 += gridDim.x) {
        const int it = (defer && it0 >= 768) ? it0 + (N_TR - 768) : it0;
        if (it < N_TR) {
            if (it < 768) transpose_tile(p.in[12], DIN, DIN, (bf16_t*)(p.ws + WS_WINT), 1024, (it >> 4) * 64, (it & 15) * 64, tile);
            else if (it < 1024) { const int i = it - 768; transpose_tile(p.in[30], 1024, 1024, (bf16_t*)(p.ws + WS_WOUTT), 1024, (i >> 4) * 64, (i & 15) * 64, tile); }
            else if (it < 2048) { const int i = it - 1024; transpose_tile(p.in[31], 4096, 4096, (bf16_t*)(p.ws + WS_W1T), 1024, (i >> 4) * 64, (i & 15) * 64, tile); }
            else { const int i = it - 2048; transpose_tile(p.in[32], 1024, 1024, (bf16_t*)(p.ws + WS_W2T), 4096, (i >> 6) * 64, (i & 63) * 64, tile); }
        } else if (it < N_TR + N_MOD) {
            const int i = it - N_TR, cgp = i % 12, ks = i / 12, k0 = ks * 64;
            for (int e = tid; e < 576; e += 512) { const int b = e >> 6, kk = e & 63; const float cv = (b < 8) ? p.in[2][b * 1024 + k0 + kk] : p.in[5][k0 + kk]; tile[e] = cv * __builtin_amdgcn_rcpf(1.0f + __expf(-cv)); }
            __syncthreads();
            const int col = cgp * 512 + tid;
            float a0 = 0, a1 = 0, a2 = 0, a3 = 0, a4 = 0, a5 = 0, a6 = 0, a7 = 0, a8 = 0;
            const float* wm = p.in[6] + (size_t)k0 * 6144 + col;
#pragma unroll
            for (int hb = 0; hb < 2; ++hb) { float wv[32];
#pragma unroll
                for (int q = 0; q < 32; ++q) wv[q] = wm[(size_t)(hb * 32 + q) * 6144];
                __builtin_amdgcn_sched_barrier(0);
#pragma unroll
                for (int q = 0; q < 32; ++q) { const int kk = hb * 32 + q; const float w = wv[q];
                    a0 += tile[kk] * w; a1 += tile[64 + kk] * w; a2 += tile[128 + kk] * w; a3 += tile[192 + kk] * w; a4 += tile[256 + kk] * w;
                    a5 += tile[320 + kk] * w; a6 += tile[384 + kk] * w; a7 += tile[448 + kk] * w; a8 += tile[512 + kk] * w; } }
            float* mp = (float*)(p.ws + WS_MODPART) + (size_t)(ks * 9) * 6144 + col;
            mp[0] = a0; mp[6144] = a1; mp[2 * 6144] = a2; mp[3 * 6144] = a3; mp[4 * 6144] = a4; mp[5 * 6144] = a5; mp[6 * 6144] = a6; mp[7 * 6144] = a7; mp[8 * 6144] = a8;
            __syncthreads();
        } else if (it < N_TR + N_MOD + N_SW) {
            const int i = it - N_TR - N_MOD;
float vq[4]; bf16_t* dq[4]; int rq[4];
#pragma unroll
            for (int q = 0; q < 4; ++q) {
                const int e = i * 2048 + q * 512 + tid, which = e >> 16, r = e & 65535;
                float v; bf16_t* dst;
                if (which < 2) { const int d = r >> 15, n = (r >> 6) & 511, k = r & 63; v = p.in[which == 0 ? 14 : 16][d * 32768 + k * 512 + n]; dst = (bf16_t*)(p.ws + (which == 0 ? WS_WUPT : WS_AUPT)); }
                else if (which == 2) { const int n = r >> 7, k = r & 127; v = p.in[17][k * 512 + n]; dst = (bf16_t*)(p.ws + WS_GUPT); }
                else { const int dn = r >> 12, o = (r >> 6) & 63, c = r & 63; v = p.in[which == 3 ? 25 : 27][dn * 4096 + c * 64 + o]; dst = (bf16_t*)(p.ws + (which == 3 ? WS_WAT : WS_WXT)); }
                vq[q] = v; dq[q] = dst; rq[q] = r;
            }
#pragma unroll
            for (int q = 0; q < 4; ++q) dq[q][rq[q]] = f2bf(vq[q]);
        } else {
            const int i = it - N_TR - N_MOD - N_SW;
#pragma unroll
            for (int q = 0; q < 4; ++q) {
                const int e = i * 2048 + q * 512 + tid;
                const int isrow = e < 16384, e2 = isrow ? e : e - 16384, pos = e2 >> 9, j = e2 & 511, ii = j & 255;
                const float omega = 1.0f / powf(10000.0f, (float)ii / 256.0f);
                const float ang = (float)pos * omega;
                const float v = (j < 256) ? sinf(ang) : cosf(ang);
                ((float*)(p.ws + (isrow ? WS_ROWTAB : WS_COLTAB)))[e2] = v;
            }
        }
    }
}

__device__ __forceinline__ void deferred_transposes(const Params& p, unsigned char* shm, int which, int rank, int nranks) {
    float* tile = (float*)shm;
    if (which == 0) { for (int i = rank; i < 256; i += nranks) transpose_tile(p.in[30], 1024, 1024, (bf16_t*)(p.ws + WS_WOUTT), 1024, (i >> 4) * 64, (i & 15) * 64, tile); }
    else { for (int it = rank; it < 2048; it += nranks) {
            if (it < 1024) transpose_tile(p.in[31], 4096, 4096, (bf16_t*)(p.ws + WS_W1T), 1024, (it >> 4) * 64, (it & 15) * 64, tile);
            else { const int i = it - 1024; transpose_tile(p.in[32], 1024, 1024, (bf16_t*)(p.ws + WS_W2T), 4096, (i >> 6) * 64, (i & 63) * 64, tile); } } }
}

__device__ __forceinline__ void phase_h1(const Params& p, unsigned char* shm) {
    float* sm = (float*)shm;
    const int tid = threadIdx.x, wid = tid >> 6, lane = tid & 63;
    bf16_t* H = (bf16_t*)(p.ws + WS_ACT);
    for (int e = blockIdx.x * 512 + tid; e < 9 * 6144; e += gridDim.x * 512) ((float*)(p.ws + WS_MODF))[e] = mod_val(p, e / 6144, e % 6144);
    const int per16 = (NTOK / 16 + (int)gridDim.x - 1) / (int)gridDim.x; int cur_mrow = -1;
    auto body = [&](auto nr_tag, int row) { constexpr int NR = decltype(nr_tag)::value;
            f32x4 x[NR][4]; float ss[NR] = {};
            f32x4 g8[4];
#pragma unroll
            for (int i = 0; i < 4; ++i) g8[i] = *(const f32x4*)(p.in[8] + 4 * lane + 256 * i);
#pragma unroll
            for (int u = 0; u < NR; ++u)
#pragma unroll
                for (int i = 0; i < 4; ++i) x[u][i] = load_x4(p, row + (u >> 1) * 16 + (u & 1), 4 * lane + 256 * i);
#pragma unroll
            for (int u = 0; u < NR; ++u)
#pragma unroll
                for (int i = 0; i < 4; ++i) ss[u] += x[u][i][0] * x[u][i][0] + x[u][i][1] * x[u][i][1] + x[u][i][2] * x[u][i][2] + x[u][i][3] * x[u][i][3];
#pragma unroll
            for (int o = 32; o > 0; o >>= 1) {
#pragma unroll
                for (int u = 0; u < NR; ++u) ss[u] += __shfl_xor(ss[u], o); }
#pragma unroll
            for (int u = 0; u < NR; ++u) { const float rstd = rsqrtf(ss[u] * (1.0f / 1024.0f) + 1e-6f);
#pragma unroll
                for (int i = 0; i < 4; ++i) { const int j = 4 * lane + 256 * i;
                    const f32x4 g = g8[i]; float h[4];
#pragma unroll
                    for (int e = 0; e < 4; ++e) h[e] = x[u][i][e] * rstd * g[e] * (1.0f + sm[1024 + j + e]) + sm[j + e];
                    u32x2 w; w.x = pk2(h[0], h[1]); w.y = pk2(h[2], h[3]);
                    __builtin_nontemporal_store(w, (u32x2*)(H + (size_t)(row + (u >> 1) * 16 + (u & 1)) * DM + j)); } }
    };
    for (int k16 = 0; k16 < per16; ) {
        const int t16 = blockIdx.x * per16 + k16; if (t16 >= NTOK / 16) break;
        const int row = t16 * 16 + wid * 2, mrow = (t16 * 16 < NPR) ? 8 : ((t16 * 16 - NPR) >> 11);
        if (mrow != cur_mrow) { __syncthreads(); { float mv[4];
#pragma unroll
            for (int q = 0; q < 4; ++q) mv[q] = mod_val(p, mrow, tid + 512 * q);
#pragma unroll
            for (int q = 0; q < 4; ++q) sm[tid + 512 * q] = mv[q]; } __syncthreads(); cur_mrow = mrow; }
        const int t16b = t16 + 1; const bool pair = (k16 + 1 < per16) && (t16b < NTOK / 16) && (((t16b * 16 < NPR) ? 8 : ((t16b * 16 - NPR) >> 11)) == mrow);
        if (pair) { body(std::integral_constant<int, 4>{}, row); k16 += 2; } else { body(std::integral_constant<int, 2>{}, row); k16 += 1; }
    }
    __syncthreads();
}

constexpr int LO_O = 0;
constexpr int LO_XA = 87040;
constexpr int LO_PRM = 139264;
constexpr int LW_HALF = 26624 + 2 * 9216, LW_GB = 26624;
struct LruPre { u32x4 x[8]; u32x4 g[2]; };

template <int MODE>
__device__ __forceinline__ void lru_load_x(const Params& p, const TileInfo& ti, int j, int ht, LruPre& pre) {
    const bf16_t* Z = (const bf16_t*)(p.ws + WS_Z);
    const int t = ht >> 2, cq = ht & 3;
#pragma unroll
    for (int jj = 0; jj < 4; ++jj) { const int tt = ti.t0 + t + jj - 2; const bool ok = (tt >= 0) && (tt < ti.T);
        const bf16_t* src = Z + (size_t)(ti.seqrow0 + (ok ? tt : 0)) * DIN + ZXB + 64 * j + 16 * cq;
        const u32x4 z = {0u, 0u, 0u, 0u};
        pre.x[2 * jj] = ok ? *(const u32x4*)src : z; pre.x[2 * jj + 1] = ok ? *(const u32x4*)(src + 8) : z; }
    if (MODE == 1) { const bf16_t* src = Z + (size_t)(ti.row0 + t) * DIN + ZGB + 64 * j + 16 * cq; pre.g[0] = *(const u32x4*)src; pre.g[1] = *(const u32x4*)(src + 8); }
}

template <int MODE>
__device__ __forceinline__ void lru_wave_item(const Params& p, unsigned char* lh, const bf16_t* wt, const float* cp, const float (&pba)[2], const float (&pbx)[2], const float (&pc8)[2], int tile, int j, const TileInfo& ti, LruPre& pre, int ht, int next_tile, int par) {
    const bf16_t* Z = (const bf16_t*)(p.ws + WS_Z);
    bf16_t* xcb = (bf16_t*)lh; float* xcf = (float*)(lh + 9216); bf16_t* gbt = (bf16_t*)(lh + LW_GB + par * 9216);
    const int lane = ht & 63, nt = ht >> 6, fr = lane & 15, fq = lane >> 4, ch = 64 * j + 16 * nt + fr;
    {   const int t = ht >> 2, cq = ht & 3; float xc[16];
#pragma unroll
        for (int q = 0; q < 16; ++q) xc[q] = cp[4 * 64 + 16 * cq + q];
#pragma unroll
        for (int jj = 0; jj < 4; ++jj) { float f[16]; unpack8(pre.x[2 * jj], f); unpack8(pre.x[2 * jj + 1], f + 8); __builtin_amdgcn_sched_barrier(0);
#pragma unroll
            for (int q = 0; q < 16; ++q) xc[q] += f[q] * cp[jj * 64 + 16 * cq + q]; }
        *(u32x4*)(xcb + t * 72 + 16 * cq) = pack8(xc); *(u32x4*)(xcb + t * 72 + 16 * cq + 8) = pack8(xc + 8);
        if (MODE == 1) { *(u32x4*)(gbt + t * 72 + 16 * cq) = pre.g[0]; *(u32x4*)(gbt + t * 72 + 16 * cq + 8) = pre.g[1]; }
#pragma unroll
        for (int q = 0; q < 16; q += 4) *(f32x4*)(xcf + t * 68 + 16 * cq + q) = (f32x4){xc[q], xc[q + 1], xc[q + 2], xc[q + 3]}; }
    __builtin_amdgcn_sched_barrier(0);
    if (next_tile >= 0) { const TileInfo tn = tile_info(next_tile); lru_load_x<MODE>(p, tn, j, ht, pre); }
    __syncthreads();
    f32x4 A_[2][4], B_[2][4];
    bf16x8 bl[4][2];
#pragma unroll
    for (int o = 0; o < 4; ++o)
#pragma unroll
        for (int k2 = 0; k2 < 2; ++k2) bl[o][k2] = *(const bf16x8*)(wt + (o * 64 + 16 * nt + fr) * 72 + 32 * k2 + 8 * fq);
#pragma unroll
    for (int mt = 0; mt < 4; ++mt) {
        const bf16x8 a0 = *(const bf16x8*)(xcb + (16 * mt + fr) * 72 + 8 * fq), a1 = *(const bf16x8*)(xcb + (16 * mt + fr) * 72 + 32 + 8 * fq);
        f32x4 acc[4];
#pragma unroll
        for (int o = 0; o < 4; ++o) { acc[o] = (f32x4){0.f, 0.f, 0.f, 0.f};
            acc[o] = __builtin_amdgcn_mfma_f32_16x16x32_bf16(a0, bl[o][0], acc[o], 0, 0, 0); acc[o] = __builtin_amdgcn_mfma_f32_16x16x32_bf16(a1, bl[o][1], acc[o], 0, 0, 0); }
#pragma unroll
        for (int d = 0; d < 2; ++d)
#pragma unroll
            for (int e = 0; e < 4; ++e) {
                const float rg = sigmoidf_(acc[2 * d][e] + pba[d]), ig = sigmoidf_(acc[2 * d + 1][e] + pbx[d]);
                const float a = __expf(rg * pc8[d]);
                A_[d][mt][e] = a; B_[d][mt][e] = __builtin_amdgcn_sqrtf(fmaxf(1.0f - a * a, 0.0f)) * (ig * xcf[(16 * mt + 4 * fq + e) * 68 + 16 * nt + fr]); }
    }
    __syncthreads();
    float hin0 = 0.f, hin1 = 0.f;
    if (MODE == 1) {
        const int chain = lane & 31, dd = chain >> 4, part = lane >> 5;
        const float* car = (const float*)(p.ws + WS_CAR);
        float Pa = 1.0f, Ha = 0.0f;
#pragma unroll
        for (int hb = 0; hb < 2; ++hb) { float Pv[8], Hv[8];
#pragma unroll
            for (int i = 0; i < 8; ++i) { const int kk = part * 16 + hb * 8 + i; const int tl = dd ? (ti.tile0 + ti.ntile - 1 - kk) : (ti.tile0 + kk);
                const bool valid = (kk < ti.ntile) && (dd ? (tl > tile) : (tl < tile));
                const float* cc = car + (size_t)((tl * 8 + j) * 2 + dd) * 128 + 16 * nt + fr;
                Pv[i] = valid ? cc[0] : 1.0f; Hv[i] = valid ? cc[64] : 0.0f; }
#pragma unroll
            for (int i = 0; i < 8; ++i) { Ha = Pv[i] * Ha + Hv[i]; Pa = Pv[i] * Pa; }
            __builtin_amdgcn_sched_barrier(0); }
        const float P1 = __shfl(Pa, chain + 32), H1 = __shfl(Ha, chain + 32);
        const float P0 = __shfl(Pa, chain), H0 = __shfl(Ha, chain);
        float h0 = ti.sample ? p.in[4][ti.b * 1024 + dd * 512 + ch] : 0.f;
        h0 = P0 * h0 + H0; h0 = P1 * h0 + H1;
        hin0 = __shfl(h0, fr); hin1 = __shfl(h0, 16 + fr); }
    float hs[4][4];
#pragma unroll
    for (int d = 0; d < 2; ++d) {
        float R_P = 1.0f, R_H = 0.0f;
        float hin = d ? hin1 : hin0;
#pragma unroll
        for (int m_ = 0; m_ < 4; ++m_) { const int mt = d ? 3 - m_ : m_;
            float P = 1.0f, H = 0.0f;
#pragma unroll
            for (int e_ = 0; e_ < 4; ++e_) { const int e = d ? 3 - e_ : e_; H = A_[d][mt][e] * H + B_[d][mt][e]; P = A_[d][mt][e] * P; }
            const int sq = d ? 3 - fq : fq;
            {   const int src1 = d ? lane + 16 : lane - 16; const float Pp = __shfl(P, src1 & 63), Hp = __shfl(H, src1 & 63);
                if (sq >= 1) { H = P * Hp + H; P = P * Pp; } }
            {   const int src2 = d ? lane + 32 : lane - 32; const float Pp = __shfl(P, src2 & 63), Hp = __shfl(H, src2 & 63);
                if (sq >= 2) { H = P * Hp + H; P = P * Pp; } }
            const int lastl = d ? fr : 48 + fr; const float TP = __shfl(P, lastl), TH = __shfl(H, lastl);
            if (MODE == 1) {
                const int srcx = d ? lane + 16 : lane - 16; float EP = __shfl(P, srcx & 63), EH = __shfl(H, srcx & 63);
                if (sq == 0) { EP = 1.0f; EH = 0.0f; }
                float h = R_P * hin + R_H; h = EP * h + EH;
#pragma unroll
                for (int e_ = 0; e_ < 4; ++e_) { const int e = d ? 3 - e_ : e_; h = A_[d][mt][e] * h + B_[d][mt][e]; hs[mt][e] = (d == 0) ? h : hs[mt][e] + h; }
                if (!ti.sample) {
                    if (d == 0 && mt == 3 && fq == 3 && tile == ti.tile0 + ti.ntile - 1) p.out[OUT_LRU + ti.b * 1024 + ch] = h;
                    if (d == 1 && mt == 0 && fq == 0 && tile == ti.tile0) p.out[OUT_LRU + ti.b * 1024 + 512 + ch] = h; }
            }
            R_H = TP * R_H + TH; R_P = TP * R_P;
        }
        if (MODE == 0) { if (fq == 0) { float* car = (float*)(p.ws + WS_CAR) + (size_t)((tile * 8 + j) * 2 + d) * 128 + 16 * nt + fr; car[0] = R_P; car[64] = R_H; } }
    }
    if (MODE == 1) {
        bf16_t* Y = (bf16_t*)(p.ws + WS_ACT);
#pragma unroll
        for (int mt = 0; mt < 4; ++mt)
#pragma unroll
            for (int e = 0; e < 4; ++e) { const float x = bf2f(gbt[(16 * mt + 4 * fq + e) * 72 + 16 * nt + fr]);
                const float ge = 0.5f * x * (1.0f + tanhf_(0.7978845608028654f * (x + 0.044715f * x * x * x)));
                Y[(size_t)(ti.row0 + 16 * mt + 4 * fq + e) * DM + 512 + ch] = f2bf(hs[mt][e] * ge); }
    }
}

constexpr int LW_WT = 2 * LW_HALF, LW_CP = LW_WT + 4 * 64 * 72 * 2;
template <int MODE>
__device__ __forceinline__ void lru_phase(const Params& p, unsigned char* shm, int j, int tile0, int tstride, int ntiles_total) {
    const int tid = threadIdx.x, ht = tid & 255, half = tid >> 8, lane = tid & 63, nt = ht >> 6, fr = lane & 15;
    unsigned char* lh = shm + half * LW_HALF;
    bf16_t* wt = (bf16_t*)(shm + LW_WT); float* cp = (float*)(shm + LW_CP);
    {   u32x4 wv[4];
#pragma unroll
        for (int q = 0; q < 4; ++q) { const int e = tid + 512 * q, o = e >> 9, n = (e >> 3) & 63, k8 = e & 7;
            wv[q] = *(const u32x4*)((const bf16_t*)(p.ws + ((o & 1) ? WS_WXT : WS_WAT)) + (size_t)(((o >> 1) * 8 + j) * 64 + n) * 64 + 8 * k8); }
#pragma unroll
        for (int q = 0; q < 4; ++q) { const int e = tid + 512 * q, o = e >> 9, n = (e >> 3) & 63, k8 = e & 7; *(u32x4*)(wt + (o * 64 + n) * 72 + 8 * k8) = wv[q]; } }
    if (tid < 320) { const int idx = tid >> 6, c = tid & 63; cp[tid] = (idx < 4) ? p.in[23][idx * 512 + 64 * j + c] : p.in[24][64 * j + c]; }
    float pba[2], pbx[2], pc8[2];
    {   const int ch = 64 * j + 16 * nt + fr;
#pragma unroll
        for (int d = 0; d < 2; ++d) { pba[d] = p.in[26][d * 512 + ch]; pbx[d] = p.in[28][d * 512 + ch]; pc8[d] = -8.0f * softplusf_(-p.in[29][d * 512 + ch]); } }
    const int nmax = (ntiles_total + 1) / 2, n = (ntiles_total - half + 1) / 2;
    LruPre pre;
    if (n > 0) { const TileInfo ti = tile_info(tile0 + half * tstride); lru_load_x<MODE>(p, ti, j, ht, pre); }
    __syncthreads();
    for (int i = 0; i < nmax; ++i) {
        if (i < n) { const int tile = tile0 + (2 * i + half) * tstride; const TileInfo ti = tile_info(tile);
            lru_wave_item<MODE>(p, lh, wt, cp, pba, pbx, pc8, tile, j, ti, pre, ht, (i + 1 < n) ? tile + 2 * tstride : -1, i & 1); }
        else { __syncthreads(); __syncthreads(); } }
}

__device__ __forceinline__ void phase_prep(const Params& p, unsigned char* shm) {
    const int tid = threadIdx.x, wid = tid >> 6, lane = tid & 63;
    const bf16_t* Z = (const bf16_t*)(p.ws + WS_Z);
    float* O = (float*)(shm + LO_O);
    bf16_t* XW = (bf16_t*)(shm + LO_XA); bf16_t* XA = XW + 64 * 136; bf16_t* XG = XA + 64 * 136;
    bf16_t* SCAN = (bf16_t*)p.out;
    {
    const int h = blockIdx.x & 7, nbj = gridDim.x >> 3;
    bf16x8 bw[2][2], ba[2][2], bg[4];
    {   const int fr = lane & 15, fq = lane >> 4, nt = wid & 3;
#pragma unroll
        for (int d = 0; d < 2; ++d)
#pragma unroll
            for (int k2 = 0; k2 < 2; ++k2) { const size_t o = (size_t)(d * 512 + h * 64 + 16 * nt + fr) * 64 + 32 * k2 + 8 * fq;
                bw[d][k2] = *(const bf16x8*)((const bf16_t*)(p.ws + WS_WUPT) + o); ba[d][k2] = *(const bf16x8*)((const bf16_t*)(p.ws + WS_AUPT) + o); }
#pragma unroll
        for (int k4 = 0; k4 < 4; ++k4) bg[k4] = *(const bf16x8*)((const bf16_t*)(p.ws + WS_GUPT) + (size_t)(h * 64 + 16 * nt + fr) * 128 + 32 * k4 + 8 * fq); }
    float* PR = (float*)(shm + LO_PRM);
    if (tid < 448) { const int idx = tid >> 6, c = tid & 63, hc = h * 64 + c;
        PR[tid] = (idx < 2) ? p.in[13][idx * 512 + hc] : (idx < 4) ? p.in[15][(idx - 2) * 512 + hc] : (idx == 4) ? p.in[18][hc] : (idx == 5) ? p.in[19][hc] : p.in[20][hc]; }
    u32x4 nx[8];
    {   const int tile = blockIdx.x >> 3;
        if (tile < NTILE) { const int t = tid >> 3, seg = tid & 7; const size_t zr = (size_t)(tile * 64 + t) * DIN;
#pragma unroll
            for (int hh = 0; hh < 2; ++hh) { const int c0 = seg * 16 + hh * 8; nx[hh] = *(const u32x4*)(Z + zr + ZXW + c0); nx[2 + hh] = *(const u32x4*)(Z + zr + ZXA + c0); nx[4 + hh] = *(const u32x4*)(Z + zr + ZXG + c0); }
            nx[6] = *(const u32x4*)(Z + zr + h * 64 + 8 * seg + ZR); nx[7] = *(const u32x4*)(Z + zr + h * 64 + 8 * seg + ZK); } }
    __syncthreads();
    for (int tile = blockIdx.x >> 3; tile < NTILE; tile += nbj) {
        const TileInfo ti = tile_info(tile);
        u32x4 cx[8];
#pragma unroll
        for (int i = 0; i < 8; ++i) cx[i] = nx[i];
        if (tile + nbj < NTILE) { const int t = tid >> 3, seg = tid & 7; const size_t zr = (size_t)((tile + nbj) * 64 + t) * DIN;
#pragma unroll
            for (int hh = 0; hh < 2; ++hh) { const int c0 = seg * 16 + hh * 8; nx[hh] = *(const u32x4*)(Z + zr + ZXW + c0); nx[2 + hh] = *(const u32x4*)(Z + zr + ZXA + c0); nx[4 + hh] = *(const u32x4*)(Z + zr + ZXG + c0); }
            nx[6] = *(const u32x4*)(Z + zr + h * 64 + 8 * seg + ZR); nx[7] = *(const u32x4*)(Z + zr + h * 64 + 8 * seg + ZK); }
        {   const int t = tid >> 3, seg = tid & 7; float f[8];
#pragma unroll
            for (int hh = 0; hh < 2; ++hh) { const int c0 = seg * 16 + hh * 8;
                *(u32x4*)(XW + t * 136 + c0) = cx[hh]; *(u32x4*)(XA + t * 136 + c0) = cx[2 + hh]; *(u32x4*)(XG + t * 136 + c0) = cx[4 + hh]; } }
        __syncthreads();
        {   const int fr = lane & 15, fq = lane >> 4, nt = wid & 3, mtb = 2 * (wid >> 2);
#pragma unroll
            for (int mi = 0; mi < 2; ++mi) { const int mt = mtb + mi; const bf16_t* ar = XW + (16 * mt + fr) * 136 + 8 * fq;
#pragma unroll
                for (int d = 0; d < 2; ++d) { f32x4 aw = {0.f, 0.f, 0.f, 0.f}, aa = aw;
#pragma unroll
                    for (int k2 = 0; k2 < 2; ++k2) { aw = __builtin_amdgcn_mfma_f32_16x16x32_bf16(*(const bf16x8*)(ar + d * 64 + 32 * k2), bw[d][k2], aw, 0, 0, 0);
                        aa = __builtin_amdgcn_mfma_f32_16x16x32_bf16(*(const bf16x8*)(ar + 64 * 136 + d * 64 + 32 * k2), ba[d][k2], aa, 0, 0, 0); }
#pragma unroll
                    for (int i = 0; i < 4; ++i) { O[(d * 64 + 16 * mt + 4 * fq + i) * 68 + 16 * nt + fr] = aw[i]; O[((2 + d) * 64 + 16 * mt + 4 * fq + i) * 68 + 16 * nt + fr] = aa[i]; } }
                f32x4 ag = {0.f, 0.f, 0.f, 0.f};
#pragma unroll
                for (int k4 = 0; k4 < 4; ++k4) ag = __builtin_amdgcn_mfma_f32_16x16x32_bf16(*(const bf16x8*)(ar + 2 * 64 * 136 + 32 * k4), bg[k4], ag, 0, 0, 0);
#pragma unroll
                for (int i = 0; i < 4; ++i) O[(4 * 64 + 16 * mt + 4 * fq + i) * 68 + 16 * nt + fr] = ag[i]; } }
        __syncthreads();
        {   const int t = tid >> 3, cs = tid & 7, row = ti.row0 + t; const size_t zr = (size_t)row * DIN + h * 64 + 8 * cs;
            float ss = 0.f;
            float kaw[8], rkw[8];
            {   float k[8], kkw[8]; unpack8(cx[7], k);
                *(f32x4*)kkw = *(const f32x4*)(PR + 4 * 64 + 8 * cs); *(f32x4*)(kkw + 4) = *(const f32x4*)(PR + 4 * 64 + 8 * cs + 4);
                *(f32x4*)kaw = *(const f32x4*)(PR + 5 * 64 + 8 * cs); *(f32x4*)(kaw + 4) = *(const f32x4*)(PR + 5 * 64 + 8 * cs + 4);
                *(f32x4*)rkw = *(const f32x4*)(PR + 6 * 64 + 8 * cs); *(f32x4*)(rkw + 4) = *(const f32x4*)(PR + 6 * 64 + 8 * cs + 4);
#pragma unroll
                for (int q = 0; q < 8; ++q) { const float kk = k[q] * kkw[q]; ss += kk * kk; } }
            ss = sum8(ss);
            const float inv = __builtin_amdgcn_rcpf(fmaxf(__builtin_amdgcn_sqrtf(ss), 1e-12f));
            float bs = 0.f;
            float rf[8], kf[8]; unpack8(cx[6], rf); unpack8(cx[7], kf);
#pragma unroll 1
            for (int d = 0; d < 2; ++d) {
                bf16_t* sp = SCAN + ((size_t)(d * NTOK + row) * 8 + h) * 128 + 8 * cs;
                float oa[8], ow[8], pa[8], pw[8];
                *(f32x4*)oa = *(const f32x4*)(O + ((2 + d) * 64 + t) * 68 + 8 * cs); *(f32x4*)(oa + 4) = *(const f32x4*)(O + ((2 + d) * 64 + t) * 68 + 8 * cs + 4);
                *(f32x4*)ow = *(const f32x4*)(O + (d * 64 + t) * 68 + 8 * cs); *(f32x4*)(ow + 4) = *(const f32x4*)(O + (d * 64 + t) * 68 + 8 * cs + 4);
                *(f32x4*)pa = *(const f32x4*)(PR + (2 + d) * 64 + 8 * cs); *(f32x4*)(pa + 4) = *(const f32x4*)(PR + (2 + d) * 64 + 8 * cs + 4);
                *(f32x4*)pw = *(const f32x4*)(PR + d * 64 + 8 * cs); *(f32x4*)(pw + 4) = *(const f32x4*)(PR + d * 64 + 8 * cs + 4);
                float lw[8], aa[8];
#pragma unroll
                for (int q = 0; q < 8; ++q) { const float a = sigmoidf_(pa[q] + oa[q]);
                    bs += rf[q] * (kf[q] * (1.0f + (a - 1.0f) * kaw[q])) * rkw[q];
                    lw[q] = -0.60653065971f * sigmoidf_(pw[q] + ow[q]);
                    aa[q] = a; }
                *(u32x4*)sp = pack8(lw); *(u32x4*)(sp + 64) = pack8(aa); }
            bs = sum8(bs);
            if (cs == 0) { ((float*)(p.ws + WS_INV))[row * 8 + h] = inv; ((float*)(p.ws + WS_BON))[row * 8 + h] = bs; }
            float g[8];
            *(f32x4*)g = *(const f32x4*)(O + (4 * 64 + t) * 68 + 8 * cs); *(f32x4*)(g + 4) = *(const f32x4*)(O + (4 * 64 + t) * 68 + 8 * cs + 4);
            *(u32x4*)((bf16_t*)(p.ws + WS_G) + (size_t)row * 512 + h * 64 + 8 * cs) = pack8(g); }
    }
    __syncthreads();
    }
    {   const int G = gridDim.x, bid = blockIdx.x, nbj = G >> 3, t0 = bid >> 3;
        const int ntl = (t0 < NTILE) ? (NTILE - t0 + nbj - 1) / nbj : 0;
        lru_phase<0>(p, shm, bid & 7, t0, nbj, ntl); }
}

constexpr int CB_A = 0, CB_R = 2304, CB_BT = 4608, CB_KT = 6656, CB_VT = 8704, CB_T = 10752, CB_TK = 11264, CB_MT = 11776, CB_MK = 12288, CB_G = 12800, CB_BYTES = 13056;
constexpr int PS_B = 0, PS_K = 2304, PS_M = 4608  , PS_BYTES = 6144;
constexpr int LO_CB = 0, LO_PS = 8 * CB_BYTES;

__device__ __forceinline__ void wsync() { __builtin_amdgcn_wave_barrier(); asm volatile("s_waitcnt lgkmcnt(0)" ::: "memory"); __builtin_amdgcn_wave_barrier(); }
__device__ __forceinline__ bf16x8 mk8(unsigned a, unsigned b, unsigned c, unsigned d) { u32x4 w; w.x = a; w.y = b; w.z = c; w.w = d; return __builtin_bit_cast(bf16x8, w); }

__device__ __forceinline__ void produce_chunk(const Params& p, unsigned char* cb, unsigned char* ps, int seqrow0, int T, int d, int h, int tau0, int lane) {
    const bf16_t* Z = (const bf16_t*)(p.ws + WS_Z); const bf16_t* SCAN = (const bf16_t*)p.out; const float* INV = (const float*)(p.ws + WS_INV);
    bf16_t* At = (bf16_t*)(cb + CB_A); bf16_t* Rt = (bf16_t*)(cb + CB_R); bf16_t* Bs = (bf16_t*)(ps + PS_B); bf16_t* Ks = (bf16_t*)(ps + PS_K);
    const int k = lane, hc = h * 64 + k;
    const float kkw = p.in[18][hc], kaw = p.in[19][hc];
    float beta[16], kdv[16], cums[16]; unsigned short vraw[16], lwr[16], asr[16], rrw[16], krw[16]; float invv[16];
    float cum = 0.f, e_last = 1.0f;
#pragma unroll
    for (int i = 0; i < 16; ++i) {
        const int tau = tau0 + i, row = seqrow0 + (d ? T - 1 - tau : tau);
        const bf16_t* sp = SCAN + ((size_t)(d * NTOK + row) * 8 + h) * 128;
        const bf16_t* zr = Z + (size_t)row * DIN + h * 64 + k;
        lwr[i] = sp[k]; asr[i] = sp[64 + k]; rrw[i] = zr[ZR]; krw[i] = zr[ZK]; vraw[i] = zr[ZV]; invv[i] = INV[row * 8 + h];
    }
    __builtin_amdgcn_sched_barrier(0);
#pragma unroll
    for (int i = 0; i < 16; ++i) {
        const float lw = bf2f(lwr[i]), as = bf2f(asr[i]), r = bf2f(rrw[i]), kr = bf2f(krw[i]);
        const float kk = kr * kkw * invv[i], be = kk * as, kd = kr * (1.0f + (as - 1.0f) * kaw);
        const float e_prev = e_last; cum += lw; const float e_i = __expf(cum), e_neg = __builtin_amdgcn_rcpf(e_i); e_last = e_i;
        At[i * 72 + k] = f2bf(-kk * e_prev); Rt[i * 72 + k] = f2bf(r * e_i); Bs[i * 72 + k] = f2bf(be * e_neg); Ks[i * 72 + k] = f2bf(kd * e_neg);
        beta[i] = be * e_neg; kdv[i] = kd * e_neg; cums[i] = cum;
    }
    const float gam = e_last; ((float*)(cb + CB_G))[k] = gam;
    {   unsigned wb[8], wk[8], wv[8];
#pragma unroll
        for (int i = 0; i < 16; i += 2) {
            wb[i >> 1] = pk2(beta[i] * gam, beta[i + 1] * gam); wk[i >> 1] = pk2(kdv[i] * gam, kdv[i + 1] * gam); wv[i >> 1] = (unsigned)vraw[i] | ((unsigned)vraw[i + 1] << 16); }
        u32x4* bt = (u32x4*)(cb + CB_BT + k * 32); u32x4* kt = (u32x4*)(cb + CB_KT + k * 32); u32x4* vt = (u32x4*)(cb + CB_VT + k * 32);
        u32x4 w; w.x = wb[0]; w.y = wb[1]; w.z = wb[2]; w.w = wb[3]; bt[0] = w; w.x = wb[4]; w.y = wb[5]; w.z = wb[6]; w.w = wb[7]; bt[1] = w;
        w.x = wk[0]; w.y = wk[1]; w.z = wk[2]; w.w = wk[3]; kt[0] = w; w.x = wk[4]; w.y = wk[5]; w.z = wk[6]; w.w = wk[7]; kt[1] = w;
        w.x = wv[0]; w.y = wv[1]; w.z = wv[2]; w.w = wv[3]; vt[0] = w; w.x = wv[4]; w.y = wv[5]; w.z = wv[6]; w.w = wv[7]; vt[1] = w; }
    wsync();
    const int fr = lane & 15, fq = lane >> 4;
    {   f32x4 lab = {0.f, 0.f, 0.f, 0.f}, lak = lab, mrb = lab, mrk = lab;
#pragma unroll
        for (int m = 0; m < 2; ++m) {
            const bf16x8 aA = *(const bf16x8*)(At + fr * 72 + 32 * m + 8 * fq), aR = *(const bf16x8*)(Rt + fr * 72 + 32 * m + 8 * fq);
            const bf16x8 bB = *(const bf16x8*)(Bs + fr * 72 + 32 * m + 8 * fq), bK = *(const bf16x8*)(Ks + fr * 72 + 32 * m + 8 * fq);
            lab = __builtin_amdgcn_mfma_f32_16x16x32_bf16(aA, bB, lab, 0, 0, 0); lak = __builtin_amdgcn_mfma_f32_16x16x32_bf16(aA, bK, lak, 0, 0, 0);
            mrb = __builtin_amdgcn_mfma_f32_16x16x32_bf16(aR, bB, mrb, 0, 0, 0); mrk = __builtin_amdgcn_mfma_f32_16x16x32_bf16(aR, bK, mrk, 0, 0, 0); }
        bf16_t* oLK = (bf16_t*)(cb + CB_TK); bf16_t* oMB = (bf16_t*)(cb + CB_MT); bf16_t* oMK = (bf16_t*)(cb + CB_MK);
#pragma unroll
        for (int e = 0; e < 4; ++e) { const int i = 4 * fq + e, j = fr;
            oLK[i * 16 + j] = f2bf((j < i) ? lak[e] : 0.f); oMB[i * 16 + j] = f2bf((j <= i) ? mrb[e] : 0.f); oMK[i * 16 + j] = f2bf((j <= i) ? mrk[e] : 0.f); }
        float* Lab = (float*)(ps + PS_M);
#pragma unroll
        for (int e = 0; e < 4; ++e) Lab[(4 * fq + e) * 20 + fr] = lab[e];
        wsync();
        f32x4 Lr[16][4];
#pragma unroll
        for (int i = 1; i < 16; ++i)
#pragma unroll
            for (int j4 = 0; j4 < (i + 3) / 4; ++j4) Lr[i][j4] = *(const f32x4*)(Lab + i * 20 + 4 * j4);
        __builtin_amdgcn_sched_barrier(0);
        float Tc[16];
#pragma unroll
        for (int i = 0; i < 16; ++i) { float sacc = (i == fr) ? 1.0f : 0.0f;
#pragma unroll
            for (int j4 = 0; j4 < (i + 3) / 4; ++j4) {
#pragma unroll
                for (int e = 0; e < 4; ++e) if (4 * j4 + e < i) sacc += Lr[i][j4][e] * Tc[4 * j4 + e]; }
            Tc[i] = sacc; }
        bf16_t* oT = (bf16_t*)(cb + CB_T);
        if (fq == 0) {
#pragma unroll
            for (int i = 0; i < 16; ++i) oT[i * 16 + fr] = f2bf(Tc[i]); } }
}

__device__ __forceinline__ void consume_chunk(const unsigned char* cb, int vt, int lane, f32x4 (&S)[4], bf16_t* ybase  , int seqrow0, int T, int d, int tau0) {
    const int fr = lane & 15, fq = lane >> 4;
    const bf16_t* At = (const bf16_t*)(cb + CB_A); const bf16_t* Rt = (const bf16_t*)(cb + CB_R);
    const bf16x8 bS0 = mk8(pg8::cvt_pk_bf16(S[0][0], S[0][1]), pg8::cvt_pk_bf16(S[0][2], S[0][3]), pg8::cvt_pk_bf16(S[1][0], S[1][1]), pg8::cvt_pk_bf16(S[1][2], S[1][3]));
    const bf16x8 bS1 = mk8(pg8::cvt_pk_bf16(S[2][0], S[2][1]), pg8::cvt_pk_bf16(S[2][2], S[2][3]), pg8::cvt_pk_bf16(S[3][0], S[3][1]), pg8::cvt_pk_bf16(S[3][2], S[3][3]));
    const u32x2 a00 = *(const u32x2*)(At + fr * 72 + 4 * fq), a01 = *(const u32x2*)(At + fr * 72 + 16 + 4 * fq), a10 = *(const u32x2*)(At + fr * 72 + 32 + 4 * fq), a11 = *(const u32x2*)(At + fr * 72 + 48 + 4 * fq);
    const u32x2 r00 = *(const u32x2*)(Rt + fr * 72 + 4 * fq), r01 = *(const u32x2*)(Rt + fr * 72 + 16 + 4 * fq), r10 = *(const u32x2*)(Rt + fr * 72 + 32 + 4 * fq), r11 = *(const u32x2*)(Rt + fr * 72 + 48 + 4 * fq);
    const f32x4 zero = {0.f, 0.f, 0.f, 0.f};
    f32x4 A0 = __builtin_amdgcn_mfma_f32_16x16x32_bf16(mk8(a00.x, a00.y, a01.x, a01.y), bS0, zero, 0, 0, 0);
    A0 = __builtin_amdgcn_mfma_f32_16x16x32_bf16(mk8(a10.x, a10.y, a11.x, a11.y), bS1, A0, 0, 0, 0);
    f32x4 Y = __builtin_amdgcn_mfma_f32_16x16x32_bf16(mk8(r00.x, r00.y, r01.x, r01.y), bS0, zero, 0, 0, 0);
    Y = __builtin_amdgcn_mfma_f32_16x16x32_bf16(mk8(r10.x, r10.y, r11.x, r11.y), bS1, Y, 0, 0, 0);
    const u32x2 vf = *(const u32x2*)(cb + CB_VT + (16 * vt + fr) * 32 + 8 * fq);
    const u32x2 tt = *(const u32x2*)(cb + CB_T + fr * 32 + 8 * fq), lk = *(const u32x2*)(cb + CB_TK + fr * 32 + 8 * fq);
    const u32x2 mb = *(const u32x2*)(cb + CB_MT + fr * 32 + 8 * fq), mk = *(const u32x2*)(cb + CB_MK + fr * 32 + 8 * fq);
    const bf16x8 bAV = mk8(pg8::cvt_pk_bf16(A0[0], A0[1]), pg8::cvt_pk_bf16(A0[2], A0[3]), vf.x, vf.y);
    const f32x4 X = __builtin_amdgcn_mfma_f32_16x16x32_bf16(mk8(0u, 0u, lk.x, lk.y), bAV, A0, 0, 0, 0);
    const bf16x8 bXV = mk8(pg8::cvt_pk_bf16(X[0], X[1]), pg8::cvt_pk_bf16(X[2], X[3]), vf.x, vf.y);
    const f32x4 U = __builtin_amdgcn_mfma_f32_16x16x32_bf16(mk8(tt.x, tt.y, 0u, 0u), bXV, zero, 0, 0, 0);
    const bf16x8 bUV = mk8(pg8::cvt_pk_bf16(U[0], U[1]), pg8::cvt_pk_bf16(U[2], U[3]), vf.x, vf.y);
    Y = __builtin_amdgcn_mfma_f32_16x16x32_bf16(mk8(mb.x, mb.y, mk.x, mk.y), bUV, Y, 0, 0, 0);
#pragma unroll
    for (int kt = 0; kt < 4; ++kt) {
        const f32x4 g4 = *(const f32x4*)(cb + CB_G + (16 * kt + 4 * fq) * 4);
        const u32x2 bf = *(const u32x2*)(cb + CB_BT + (16 * kt + fr) * 32 + 8 * fq), kf = *(const u32x2*)(cb + CB_KT + (16 * kt + fr) * 32 + 8 * fq);
        S[kt] = __builtin_amdgcn_mfma_f32_16x16x32_bf16(mk8(bf.x, bf.y, kf.x, kf.y), bUV, S[kt] * g4, 0, 0, 0); }
#pragma unroll
    for (int e = 0; e < 4; ++e) { const int tau = tau0 + 4 * fq + e, row = seqrow0 + (d ? T - 1 - tau : tau); ybase[(size_t)row * 512] = f2bf(Y[e]); }
}

__device__ __forceinline__ void rwkv_scan_item(const Params& p, unsigned char* shm, int item) {
    const int tid = threadIdx.x, wid = tid >> 6, lane = tid & 63, fr = lane & 15, fq = lane >> 4;
    int sample, b, h, d;
    if (item < 128) { sample = 1; b = item >> 4; h = (item >> 1) & 7; d = item & 1; }
    else { const int ii = item - 128; sample = 0; b = ii >> 4; h = (ii >> 1) & 7; d = ii & 1; }
    const int T = sample ? 2048 : 256, seqrow0 = sample ? NPR + b * 2048 : b * 256, nsc = T / 64;
    const bool consumer = wid < 4; const int vt = wid & 3;
    f32x4 S[4];
    if (consumer) {
        if (sample) { const float* s0 = p.in[3] + ((size_t)((b * 2 + d) * 8 + h)) * 4096 + (16 * vt + fr) * 64 + 4 * fq;
#pragma unroll
            for (int kt = 0; kt < 4; ++kt) S[kt] = *(const f32x4*)(s0 + 16 * kt); }
        else {
#pragma unroll
            for (int kt = 0; kt < 4; ++kt) S[kt] = (f32x4){0.f, 0.f, 0.f, 0.f}; }
    }
    bf16_t* ybase = (bf16_t*)(p.ws + WS_YA) + (size_t)d * NTOK * 512 + h * 64 + 16 * vt + fr;
    for (int s = 0; s < nsc / 2; ++s) {
        produce_chunk(p, shm + LO_CB + wid * CB_BYTES, shm + LO_PS + wid * PS_BYTES, seqrow0, T, d, h, s * 128 + wid * 16, lane);
        __syncthreads();
        if (consumer) {
#pragma unroll 1
            for (int c = 0; c < 8; ++c) consume_chunk(shm + LO_CB + c * CB_BYTES, vt, lane, S, ybase, seqrow0, T, d, s * 128 + c * 16);
        }
        __syncthreads();
    }
    if (consumer && !sample) { float* so = p.out + OUT_RWKV + ((size_t)((b * 2 + d) * 8 + h)) * 4096 + (16 * vt + fr) * 64 + 4 * fq;
#pragma unroll
        for (int kt = 0; kt < 4; ++kt) *(f32x4*)(so + 16 * kt) = S[kt]; }
    __syncthreads();
}

__device__ __forceinline__ void phase_scan(const Params& p, unsigned char* shm) {
    const int bid = blockIdx.x, G = gridDim.x;
    if (G == 256) { if (bid < 128) rwkv_scan_item(p, shm, bid); else { rwkv_scan_item(p, shm, 128 + (bid - 128) * 2); rwkv_scan_item(p, shm, 129 + (bid - 128) * 2); } }
    else for (int item = bid; item < 384; item += G) rwkv_scan_item(p, shm, item);
    {   const int nlb = G >> 1, lb = bid - (G - nlb);
        if (lb >= 0) { const int nbj = nlb >> 3, t0 = lb >> 3; const int ntl = (t0 < NTILE) ? (NTILE - t0 + nbj - 1) / nbj : 0;
            lru_phase<1>(p, shm, lb & 7, t0, nbj, ntl); } }
}

__device__ __forceinline__ void phase_combine(const Params& p) {
    const int tid = threadIdx.x, wid = tid >> 6, lane = tid & 63, h = lane >> 3;
    const bf16_t* Z = (const bf16_t*)(p.ws + WS_Z); const bf16_t* YA = (const bf16_t*)(p.ws + WS_YA); const bf16_t* G = (const bf16_t*)(p.ws + WS_G);
    const float* BON = (const float*)(p.ws + WS_BON);
    bf16_t* Y = (bf16_t*)(p.ws + WS_ACT);
    float lg[8], lb[8];
#pragma unroll
    for (int q = 0; q < 8; ++q) { lg[q] = p.in[21][8 * lane + q]; lb[q] = p.in[22][8 * lane + q]; }
    const int per16 = (NTOK / 16 + (int)gridDim.x - 1) / (int)gridDim.x;
    for (int k16 = 0; k16 < per16; ++k16) { const int t16 = blockIdx.x * per16 + k16; if (t16 >= NTOK / 16) break;
        {
            u32x4 w0[2], w1[2], wv[2], wg[2]; float bon[2];
#pragma unroll
            for (int u = 0; u < 2; ++u) { const int row = t16 * 16 + wid * 2 + u;
                w0[u] = *(const u32x4*)(YA + (size_t)row * 512 + 8 * lane); w1[u] = *(const u32x4*)(YA + (size_t)(NTOK + row) * 512 + 8 * lane);
                wv[u] = *(const u32x4*)(Z + (size_t)row * DIN + ZV + 8 * lane); wg[u] = *(const u32x4*)(G + (size_t)row * 512 + 8 * lane); bon[u] = BON[row * 8 + h]; }
#pragma unroll
            for (int u = 0; u < 2; ++u) { const int row = t16 * 16 + wid * 2 + u;
                float a[8], b[8], vv[8], g[8], o[8]; unpack8(w0[u], a); unpack8(w1[u], b); unpack8(wv[u], vv); unpack8(wg[u], g);
                float s1 = 0.f;
#pragma unroll
                for (int q = 0; q < 8; ++q) { a[q] += b[q]; s1 += a[q]; }
                s1 = sum8(s1);
                const float mu = s1 * (1.0f / 64.0f);
                float s2 = 0.f;
#pragma unroll
                for (int q = 0; q < 8; ++q) { a[q] -= mu; s2 += a[q] * a[q]; }
                s2 = sum8(s2);
                const float rstd = rsqrtf(s2 * (1.0f / 64.0f) + 64e-5f);
#pragma unroll
                for (int q = 0; q < 8; ++q) o[q] = (a[q] * rstd * lg[q] + lb[q] + bon[u] * vv[q]) * g[q];
                *(u32x4*)(Y + (size_t)row * DM + 8 * lane) = pack8(o); }
        }
    }
}

__device__ __forceinline__ void phase_res1(const Params& p, unsigned char* shm) {
    float* sm = (float*)shm;
    const int tid = threadIdx.x, wid = tid >> 6, lane = tid & 63;
    const bf16_t* O1 = (const bf16_t*)(p.ws + WS_O1); const bf16_t* O1P = (const bf16_t*)(p.ws + WS_O1P); const bool split = false; bf16_t* H = (bf16_t*)(p.ws + WS_ACT);
    const int per16 = (NTOK / 16 + (int)gridDim.x - 1) / (int)gridDim.x; int cur_mrow = -1;
    auto body = [&](auto nr_tag, int row) { constexpr int NR = decltype(nr_tag)::value;
            f32x4 o[NR][4], x1[NR][4]; float ss[NR] = {}, s2[NR] = {};
            f32x4 g9[4], g10[4];
#pragma unroll
            for (int i = 0; i < 4; ++i) { g9[i] = *(const f32x4*)(p.in[9] + 4 * lane + 256 * i); g10[i] = *(const f32x4*)(p.in[10] + 4 * lane + 256 * i); }
#pragma unroll
            for (int u = 0; u < NR; ++u)
#pragma unroll
                for (int i = 0; i < 4; ++i) { const int r = row + (u >> 1) * 16 + (u & 1), j = 4 * lane + 256 * i;
                    if (!split || r < 16384) { const u32x2 w = *(const u32x2*)(O1 + (size_t)r * DM + j);
                        o[u][i] = (f32x4){__uint_as_float(w.x << 16), __uint_as_float(w.x & 0xffff0000u), __uint_as_float(w.y << 16), __uint_as_float(w.y & 0xffff0000u)}; }
                    else { f32x4 a = {0.f, 0.f, 0.f, 0.f};
#pragma unroll
                        for (int pp = 0; pp < 4; ++pp) { const u32x2 w = *(const u32x2*)(O1P + ((size_t)pp * 4096 + (r - 16384)) * DM + j);
                            a += (f32x4){__uint_as_float(w.x << 16), __uint_as_float(w.x & 0xffff0000u), __uint_as_float(w.y << 16), __uint_as_float(w.y & 0xffff0000u)}; }
                        o[u][i] = a; }
                    x1[u][i] = load_x4(p, r, j); }
#pragma unroll
            for (int u = 0; u < NR; ++u)
#pragma unroll
                for (int i = 0; i < 4; ++i) ss[u] += o[u][i][0] * o[u][i][0] + o[u][i][1] * o[u][i][1] + o[u][i][2] * o[u][i][2] + o[u][i][3] * o[u][i][3];
#pragma unroll
            for (int sh = 32; sh > 0; sh >>= 1) {
#pragma unroll
                for (int u = 0; u < NR; ++u) ss[u] += __shfl_xor(ss[u], sh); }
#pragma unroll
            for (int u = 0; u < NR; ++u) { const float rstd = rsqrtf(ss[u] * (1.0f / 1024.0f) + 1e-6f);
#pragma unroll
                for (int i = 0; i < 4; ++i) { const int j = 4 * lane + 256 * i; const f32x4 g = g9[i];
#pragma unroll
                    for (int e = 0; e < 4; ++e) { x1[u][i][e] += sm[j + e] * (o[u][i][e] * rstd * g[e]); s2[u] += x1[u][i][e] * x1[u][i][e]; }
                    __builtin_nontemporal_store(x1[u][i], (f32x4*)(p.out + (size_t)(row + (u >> 1) * 16 + (u & 1)) * DM + j)); } }
#pragma unroll
            for (int sh = 32; sh > 0; sh >>= 1) {
#pragma unroll
                for (int u = 0; u < NR; ++u) s2[u] += __shfl_xor(s2[u], sh); }
#pragma unroll
            for (int u = 0; u < NR; ++u) { const float rstd2 = rsqrtf(s2[u] * (1.0f / 1024.0f) + 1e-6f);
#pragma unroll
                for (int i = 0; i < 4; ++i) { const int j = 4 * lane + 256 * i; const f32x4 g = g10[i]; float h[4];
#pragma unroll
                    for (int e = 0; e < 4; ++e) h[e] = x1[u][i][e] * rstd2 * g[e] * (1.0f + sm[2048 + j + e]) + sm[1024 + j + e];
                    u32x2 w; w.x = pk2(h[0], h[1]); w.y = pk2(h[2], h[3]);
                    __builtin_nontemporal_store(w, (u32x2*)(H + (size_t)(row + (u >> 1) * 16 + (u & 1)) * DM + j)); } }
    };
    for (int k16 = 0; k16 < per16; ) {
        const int t16 = blockIdx.x * per16 + k16; if (t16 >= NTOK / 16) break;
        const int row = t16 * 16 + wid * 2, mrow = (t16 * 16 < NPR) ? 8 : ((t16 * 16 - NPR) >> 11);
        if (mrow != cur_mrow) { __syncthreads(); { float mv[6];
#pragma unroll
            for (int q = 0; q < 6; ++q) mv[q] = ((const float*)(p.ws + WS_MODF))[mrow * 6144 + 2048 + tid + 512 * q];
#pragma unroll
            for (int q = 0; q < 6; ++q) sm[tid + 512 * q] = mv[q]; } __syncthreads(); cur_mrow = mrow; }
        const int t16b = t16 + 1; const bool pair = (k16 + 1 < per16) && (t16b < NTOK / 16) && (((t16b * 16 < NPR) ? 8 : ((t16b * 16 - NPR) >> 11)) == mrow);
        if (pair) { body(std::integral_constant<int, 4>{}, row); k16 += 2; } else { body(std::integral_constant<int, 2>{}, row); k16 += 1; }
    }
    __syncthreads();
}

__device__ __forceinline__ void phase_final(const Params& p, unsigned char* shm) {
    float* sm = (float*)shm;
    const int tid = threadIdx.x, wid = tid >> 6, lane = tid & 63;
    const bf16_t* O2 = (const bf16_t*)(p.ws + WS_O2); const bf16_t* O2P = (const bf16_t*)(p.ws + WS_O2P); const bool split = (gridDim.x == 256);
    const int per16 = (NTOK / 16 + (int)gridDim.x - 1) / (int)gridDim.x; int cur_mrow = -1;
    auto body = [&](auto nr_tag, int row) { constexpr int NR = decltype(nr_tag)::value;
            f32x4 o[NR][4], x1[NR][4]; float ss[NR] = {};
            f32x4 g11[4];
#pragma unroll
            for (int i = 0; i < 4; ++i) g11[i] = *(const f32x4*)(p.in[11] + 4 * lane + 256 * i);
#pragma unroll
            for (int u = 0; u < NR; ++u)
#pragma unroll
                for (int i = 0; i < 4; ++i) { const int r = row + (u >> 1) * 16 + (u & 1), j = 4 * lane + 256 * i;
                    if (!split || r < 16384) { const u32x2 w = *(const u32x2*)(O2 + (size_t)r * DM + j);
                        o[u][i] = (f32x4){__uint_as_float(w.x << 16), __uint_as_float(w.x & 0xffff0000u), __uint_as_float(w.y << 16), __uint_as_float(w.y & 0xffff0000u)}; }
                    else { f32x4 a = {0.f, 0.f, 0.f, 0.f};
#pragma unroll
                        for (int pp = 0; pp < 4; ++pp) { const u32x2 w = *(const u32x2*)(O2P + ((size_t)pp * 4096 + (r - 16384)) * DM + j);
                            a += (f32x4){__uint_as_float(w.x << 16), __uint_as_float(w.x & 0xffff0000u), __uint_as_float(w.y << 16), __uint_as_float(w.y & 0xffff0000u)}; }
                        o[u][i] = a; }
                    x1[u][i] = *(const f32x4*)(p.out + (size_t)r * DM + j); }
#pragma unroll
            for (int u = 0; u < NR; ++u)
#pragma unroll
                for (int i = 0; i < 4; ++i) ss[u] += o[u][i][0] * o[u][i][0] + o[u][i][1] * o[u][i][1] + o[u][i][2] * o[u][i][2] + o[u][i][3] * o[u][i][3];
#pragma unroll
            for (int sh = 32; sh > 0; sh >>= 1) {
#pragma unroll
                for (int u = 0; u < NR; ++u) ss[u] += __shfl_xor(ss[u], sh); }
#pragma unroll
            for (int u = 0; u < NR; ++u) { const float rstd = rsqrtf(ss[u] * (1.0f / 1024.0f) + 1e-6f);
#pragma unroll
                for (int i = 0; i < 4; ++i) { const int j = 4 * lane + 256 * i; const f32x4 g = g11[i];
#pragma unroll
                    for (int e = 0; e < 4; ++e) x1[u][i][e] += sm[j + e] * (o[u][i][e] * rstd * g[e]);
                    __builtin_nontemporal_store(x1[u][i], (f32x4*)(p.out + (size_t)(row + (u >> 1) * 16 + (u & 1)) * DM + j)); } }
    };
    for (int k16 = 0; k16 < per16; ) {
        const int t16 = blockIdx.x * per16 + k16; if (t16 >= NTOK / 16) break;
        const int row = t16 * 16 + wid * 2, mrow = (t16 * 16 < NPR) ? 8 : ((t16 * 16 - NPR) >> 11);
        if (mrow != cur_mrow) { __syncthreads(); { float mv[2];
#pragma unroll
            for (int q = 0; q < 2; ++q) mv[q] = ((const float*)(p.ws + WS_MODF))[mrow * 6144 + 5120 + tid + 512 * q];
#pragma unroll
            for (int q = 0; q < 2; ++q) sm[tid + 512 * q] = mv[q]; } __syncthreads(); cur_mrow = mrow; }
        const int t16b = t16 + 1; const bool pair = (k16 + 1 < per16) && (t16b < NTOK / 16) && (((t16b * 16 < NPR) ? 8 : ((t16b * 16 - NPR) >> 11)) == mrow);
        if (pair) { body(std::integral_constant<int, 4>{}, row); k16 += 2; } else { body(std::integral_constant<int, 2>{}, row); k16 += 1; }
    }
    __syncthreads();
}

template <class Epi>
__device__ __forceinline__ void run_gemm(unsigned char* shm, const bf16_t* A, const bf16_t* Bt, int M, int N, int K, const Epi& E) {
    pg8::Gemm g; g.A = A; g.Bt = Bt; g.M = M; g.N = N; g.K = K;
    pg8::StaticOrder S; S.init(M, N, (int)gridDim.x, (int)blockIdx.x, K);
    pg8::gemm_phase<Epi, pg8::StaticOrder>((PG8_LAS unsigned char*)shm, g, S, E);
}

template <class Epi>
__device__ __forceinline__ void run_gemm_split(unsigned char* shm, const bf16_t* A, const bf16_t* Bt, int M, int N, int K, const Epi& E) {
    pg8::Gemm g; g.A = A; g.Bt = Bt; g.M = M; g.N = N; g.K = K;
    pg8::SplitTailOrder S; S.init((int)blockIdx.x, K);
    pg8::gemm_phase<Epi, pg8::SplitTailOrder>((PG8_LAS unsigned char*)shm, g, S, E);
}

__global__ void __launch_bounds__(512, 2) fwd_megakernel(Params p, int ph_lo, int ph_hi, int coop) {
    extern __shared__ __attribute__((aligned(16))) unsigned char shm[];
    cg::grid_group grid = cg::this_grid();
    volatile LAS unsigned* xbst = (volatile LAS unsigned*)(shm + LDS_BYTES - 16);
    if (threadIdx.x == 0) { xbst[0] = 0u; xbst[1] = 0u; }
    __syncthreads();
    XcdBarrier xb = xcd_barrier_post((unsigned*)(p.ws + WS_BAR), xbst);
    if (coop == 2) grid.sync();
#ifndef PH_MASK
#define PH_MASK 0x7ff
#endif
#define PH_ON(k) ((PH_MASK & (1 << (k))) && ph_lo <= (k) && (k) < ph_hi)
#define PH_R(k) ((PH_REP >> (k)) & 1)
#define PH_SYNC(k) do { if (coop && (k) + 1 < ph_hi && ph_lo <= (k)) { xcd_barrier(xb); } } while (0)
    if (PH_ON(0)) for (int rep = 0; rep <= PH_R(0); ++rep) phase0(p, shm);
    PH_SYNC(0);
    if (PH_ON(1)) for (int rep = 0; rep <= PH_R(1); ++rep) phase_h1(p, shm);
    PH_SYNC(1);
    if (PH_ON(2)) for (int rep = 0; rep <= PH_R(2); ++rep) { EpiB16<2> E; E.O = (bf16_t*)(p.ws + WS_Z); E.ldc = DIN; E.ncols = DIN;
        run_gemm(shm, (const bf16_t*)(p.ws + WS_ACT), (const bf16_t*)(p.ws + WS_WINT), NTOK, DINP, 1024, E);
        if (gridDim.x == 256 && blockIdx.x >= 192) deferred_transposes(p, shm, 0, (int)blockIdx.x - 192, 64); }
    PH_SYNC(2);
    if (PH_ON(3)) for (int rep = 0; rep <= PH_R(3); ++rep) phase_prep(p, shm);
    PH_SYNC(3);
    if (PH_ON(4)) for (int rep = 0; rep <= PH_R(4); ++rep) phase_scan(p, shm);
    PH_SYNC(4);
    if (PH_ON(5)) for (int rep = 0; rep <= PH_R(5); ++rep) phase_combine(p);
    PH_SYNC(5);
    if (PH_ON(6)) for (int rep = 0; rep <= PH_R(6); ++rep) { EpiSplitB16 E; E.O = (bf16_t*)(p.ws + WS_O1); E.P = (bf16_t*)(p.ws + WS_O1P);
        run_gemm(shm, (const bf16_t*)(p.ws + WS_ACT), (const bf16_t*)(p.ws + WS_WOUTT), NTOK, 1024, 1024, E);
        if (gridDim.x == 256 && blockIdx.x >= 64) deferred_transposes(p, shm, 1, (int)blockIdx.x - 64, 192); }
    PH_SYNC(6);
    if (PH_ON(7)) for (int rep = 0; rep <= PH_R(7); ++rep) phase_res1(p, shm);
    PH_SYNC(7);
    if (PH_ON(8)) for (int rep = 0; rep <= PH_R(8); ++rep) { EpiB16<1> E; E.O = (bf16_t*)(p.ws + WS_F); E.ldc = DFF; E.ncols = DFF;
        run_gemm(shm, (const bf16_t*)(p.ws + WS_ACT), (const bf16_t*)(p.ws + WS_W1T), NTOK, DFF, 1024, E); }
    PH_SYNC(8);
    if (PH_ON(9)) for (int rep = 0; rep <= PH_R(9); ++rep) { EpiSplitB16 E; E.O = (bf16_t*)(p.ws + WS_O2); E.P = (bf16_t*)(p.ws + WS_O2P);
        if (gridDim.x == 256) run_gemm_split(shm, (const bf16_t*)(p.ws + WS_F), (const bf16_t*)(p.ws + WS_W2T), NTOK, 1024, DFF, E);
        else run_gemm(shm, (const bf16_t*)(p.ws + WS_F), (const bf16_t*)(p.ws + WS_W2T), NTOK, 1024, DFF, E); }
    PH_SYNC(9);
    if (PH_ON(10)) phase_final(p, shm);
}
}

extern "C" void kernel_launch(void* const* d_in, const int* in_sizes, int n_in, void* d_out, int out_size, void* d_ws, size_t ws_size, hipStream_t stream) {
    static int grid_blocks = 0;
    if (grid_blocks == 0) {
        int dev = 0, cus = 0, per_cu = 0;
        hipGetDevice(&dev);
        hipDeviceGetAttribute(&cus, hipDeviceAttributeMultiprocessorCount, dev);
        if (hipFuncSetAttribute((const void*)fwd_megakernel, hipFuncAttributeMaxDynamicSharedMemorySize, LDS_BYTES) != hipSuccess) { fprintf(stderr, "hipFuncSetAttribute failed\n"); }
        if (hipOccupancyMaxActiveBlocksPerMultiprocessor(&per_cu, (const void*)fwd_megakernel, 512, LDS_BYTES) != hipSuccess || per_cu < 1) { fprintf(stderr, "occupancy query: %d\n", per_cu); per_cu = 1; }
        (void)hipGetLastError();
        grid_blocks = cus * per_cu;
        if (n_in != 33 || ws_size < 256 * MiB) fprintf(stderr, "unexpected n_in %d / ws_size %zu\n", n_in, ws_size);
    }
    Params p{};
    for (int i = 0; i < 33; ++i) p.in[i] = (const float*)d_in[i];
    p.out = (float*)d_out; p.ws = (unsigned char*)d_ws;
#if MK_LAUNCHES == 1
    (void)hipMemsetAsync((unsigned char*)d_ws + WS_BAR, 0, XCD_BAR_WORDS * sizeof(unsigned), stream);
    int lo = 0, hi = 11, coop = 1;
    void* args[] = {&p, &lo, &hi, &coop};
    hipError_t e = hipLaunchCooperativeKernel((const void*)fwd_megakernel, dim3(grid_blocks), dim3(512), args, LDS_BYTES, stream);
    if (e != hipSuccess) fprintf(stderr, "cooperative launch failed: %s (grid %d)\n", hipGetErrorString(e), grid_blocks);
#else
    for (int ph = 0; ph < 11; ++ph) for (int rep = 0; rep <= ((HOST_REP >> ph) & 1); ++rep) hipLaunchKernelGGL(fwd_megakernel, dim3(grid_blocks), dim3(512), LDS_BYTES, stream, p, ph, ph + 1, 0);
#endif
}
```

```cpp
#include <hip/hip_runtime.h>
#include <hip/hip_cooperative_groups.h>
#include <cstdio>
#include <type_traits>
namespace cg = cooperative_groups;
#ifndef PH_REP
#define PH_REP 0
#endif
#define PH_R(k) ((PH_REP >> (k)) & 1)
#ifndef HOST_REP
#define HOST_REP 0
#endif
#ifndef LRU_LO
#define LRU_LO 3
#endif
#ifndef MK_LAUNCHES
#define MK_LAUNCHES 1
#endif
namespace pg8 {
#define PG8_LAS __attribute__((address_space(3)))
typedef unsigned short bf16_t;
typedef short bf16x8 __attribute__((ext_vector_type(8)));
typedef float f32x4 __attribute__((ext_vector_type(4)));
typedef unsigned u32x4 __attribute__((ext_vector_type(4)));
constexpr int BM = 256, BK = 64, HALF = 128, HTB = HALF * BK * 2  , STAGE_BYTES = 8 * HTB, NXCD = 8, WGM = 8;

__host__ __device__ __forceinline__ int lds_byte(int r, int c) { const int st = (r >> 4) * 2 + (c >> 5), rr = r & 15, cc = c & 31, ob = rr * 64 + cc * 2; return st * 1024 + (ob ^ (((ob >> 9) & 1) << 5)); }
__host__ __device__ __forceinline__ void stage_rc(int b, int& R, int& C) { const int st = b / 1024, sb = b % 1024, swz = sb ^ (((sb >> 9) & 1) << 5); R = (st >> 1) * 16 + swz / 64; C = (st & 1) * 32 + (swz % 64) / 2; }
__host__ __device__ __forceinline__ int perm32(int rho) { const int n = rho >> 4, i = rho & 15; return 8 * (i >> 2) + 4 * n + (i & 3); }

struct Unit { int pm, pn, k0, nk, part; };
struct Gemm { const bf16_t* A; const bf16_t* Bt; int M, N, K; };

struct StaticOrder {
    int nM, nN, nwg, G, c;
    int nkt;
    __host__ __device__ void init(int M, int N, int G_, int c_, int K_) { nM = M / BM; nN = N / BM; nwg = nM * nN; G = G_; c = c_; nkt = K_ / BK; }
    __host__ __device__ bool next(int i, Unit& u) const {
        const long L = (long)i * G + c; if (L >= nwg) return false;
        int wgid = (int)L; { const int q = nwg / NXCD, r = nwg % NXCD, xcd = wgid % NXCD, off = wgid / NXCD; wgid = (xcd < r ? xcd * (q + 1) : r * (q + 1) + (xcd - r) * q) + off; }
        const int nig = WGM * nN, gid = wgid / nig, fm = gid * WGM, gsz = (nM - fm) < WGM ? (nM - fm) : WGM;
        u.pm = fm + ((wgid % nig) % gsz); u.pn = (wgid % nig) / gsz; u.k0 = 0; u.nk = nkt; u.part = -1; return true;
    }
    __device__ __forceinline__ void a_ready(const Unit&) const {}
    __device__ __forceinline__ void done(const Unit&) const {}
};
typedef __bf16 bf16v2_t __attribute__((ext_vector_type(2)));
__device__ __forceinline__ unsigned cvt_pk_bf16(float lo, float hi) { bf16v2_t v; v.x = (__bf16)lo; v.y = (__bf16)hi; return __builtin_bit_cast(unsigned, v); }
struct SplitTailOrder {
    int c, nkt;
    __host__ __device__ void init(int c_, int K_) { c = c_; nkt = K_ / BK; }
    __host__ __device__ bool next(int i, Unit& u) const {
        const int x = c & 7, idx = c >> 3;
        if (i == 0) { const int w = x * 32 + idx; u.pm = w >> 2; u.pn = w & 3; u.k0 = 0; u.nk = nkt; u.part = -1; return true; }
        if (i == 1) { const int t = x * 8 + (idx >> 2), part = idx & 3; u.pm = 64 + (t >> 2); u.pn = t & 3; u.nk = nkt / 4; u.k0 = part * (nkt / 4) * BK; u.part = part; return true; }
        return false;
    }
    __device__ __forceinline__ void a_ready(const Unit&) const {}
    __device__ __forceinline__ void done(const Unit&) const {}
};
template <class Epi, class Sched>
__device__ __forceinline__ void gemm_phase(PG8_LAS unsigned char* lds, const Gemm g, const Sched& S, const Epi& E) {
    const int tid = threadIdx.x, wid = __builtin_amdgcn_readfirstlane(tid >> 6), lane = tid & 63, wr = wid >> 2, wc = wid & 3, fr = lane & 15, fq = lane >> 4;
    const int K = g.K;
    unsigned voffA[2], voffB[2];
#pragma unroll
    for (int i = 0; i < 2; ++i) { int R, C; stage_rc(tid * 16 + i * 8192, R, C); const int Rb = Epi::PERM ? ((R & ~31) + perm32(R & 31)) : R;
        voffA[i] = (unsigned)(R * K + C) * 2u; voffB[i] = (unsigned)(Rb * K + C) * 2u; }
    const size_t kstep = (size_t)(BK * 2);
    const size_t hstep = (size_t)HALF * K * 2;
    const size_t tstep = 2 * hstep;
    const unsigned ldsw = (unsigned)wid * 1024u;
    const int aoff = lds_byte(wr * 64 + fr, fq * 8), boff = lds_byte(wc * 32 + fr, fq * 8);
#define PG8_SA(b, h) (((b) * 2 + (h)) * HTB)
#define PG8_SB(b, h) ((4 + (b) * 2 + (h)) * HTB)
#define PG8_STAGE(bufoff, gbase, voff) do { _Pragma("unroll") for (int _i = 0; _i < 2; ++_i) \
        __builtin_amdgcn_global_load_lds((const unsigned*)((const char*)(gbase) + (voff)[_i]), (PG8_LAS unsigned*)(lds + (bufoff) + ldsw + _i * 8192), 16, 0, 0); } while (0)
#define PG8_LDA(dst, b, h) do { _Pragma("unroll") for (int m = 0; m < 4; ++m) _Pragma("unroll") for (int k = 0; k < 2; ++k) dst[m][k] = *(const PG8_LAS bf16x8*)(lds + PG8_SA(b, h) + aoff + m * 2048 + k * 1024); } while (0)
#define PG8_LDB(dst, b, h) do { _Pragma("unroll") for (int n = 0; n < 2; ++n) _Pragma("unroll") for (int k = 0; k < 2; ++k) dst[n][k] = *(const PG8_LAS bf16x8*)(lds + PG8_SB(b, h) + boff + n * 2048 + k * 1024); } while (0)
#define PG8_MMA(ai, bj, At, Bt) do { __builtin_amdgcn_s_setprio(1); _Pragma("unroll") for (int m = 0; m < 4; ++m) _Pragma("unroll") for (int n = 0; n < 2; ++n) _Pragma("unroll") for (int k = 0; k < 2; ++k) \
        acc[ai][bj][m][n] = __builtin_amdgcn_mfma_f32_16x16x32_bf16(Bt[n][k], At[m][k], acc[ai][bj][m][n], 0, 0, 0); __builtin_amdgcn_s_setprio(0); } while (0)
#define PG8_WAIT_V(n) asm volatile("s_waitcnt vmcnt(" #n ")" ::: "memory")
#define PG8_WAIT_L(n) asm volatile("s_waitcnt lgkmcnt(" #n ")" ::: "memory")
#define PG8_BAR __builtin_amdgcn_s_barrier()
#define PG8_SCHED __builtin_amdgcn_sched_barrier(0)
    Unit cur, nxt; int ui = 0;
    if (!S.next(0, cur)) return;
    f32x4 acc[2][2][4][2];
#pragma unroll
    for (int a = 0; a < 2; ++a)
#pragma unroll
        for (int b = 0; b < 2; ++b)
#pragma unroll
            for (int m = 0; m < 4; ++m)
#pragma unroll
                for (int n = 0; n < 2; ++n) acc[a][b][m][n] = (f32x4){0.f, 0.f, 0.f, 0.f};
    bf16x8 At[4][2], B0[2][2], B1[2][2];
    const char* cA = (const char*)g.A + (size_t)cur.pm * tstep + (size_t)cur.k0 * 2; const char* cB = (const char*)g.Bt + (size_t)cur.pn * tstep + (size_t)cur.k0 * 2;
    S.a_ready(cur);
    PG8_STAGE(PG8_SB(0, 0), cB, voffB); PG8_STAGE(PG8_SA(0, 0), cA, voffA); PG8_STAGE(PG8_SB(0, 1), cB + hstep, voffB); PG8_STAGE(PG8_SA(0, 1), cA + hstep, voffA);
    if (wr == 1) PG8_BAR;
    PG8_WAIT_V(4); PG8_BAR;
    PG8_STAGE(PG8_SB(1, 0), cB + kstep, voffB); PG8_STAGE(PG8_SA(1, 0), cA + kstep, voffA); PG8_STAGE(PG8_SB(1, 1), cB + hstep + kstep, voffB);
    PG8_WAIT_V(6); PG8_BAR;
    for (;;) {
        const bool has_next = S.next(ui + 1, nxt);
        const char* nA = has_next ? (const char*)g.A + (size_t)nxt.pm * tstep + (size_t)nxt.k0 * 2 : cA; const char* nB = has_next ? (const char*)g.Bt + (size_t)nxt.pn * tstep + (size_t)nxt.k0 * 2 : cB;
        const int nt = cur.nk;
        for (int t = 0; t < nt; t += 2) {
            const bool last = (t == nt - 2);
            const char* a1 = cA + (size_t)(t + 1) * kstep;
            const char* a2 = last ? nA : cA + (size_t)(t + 2) * kstep; const char* b2 = last ? nB : cB + (size_t)(t + 2) * kstep;
            const char* a3 = a2 + kstep; const char* b3 = b2 + kstep;
            if (last && has_next) S.a_ready(nxt);
            PG8_LDB(B0, 0, 0); PG8_SCHED; PG8_LDA(At, 0, 0); PG8_STAGE(PG8_SA(1, 1), a1 + hstep, voffA);
            PG8_WAIT_L(8); PG8_BAR; PG8_WAIT_L(0); PG8_MMA(0, 0, At, B0); PG8_BAR; PG8_SCHED;
            PG8_LDB(B1, 0, 1); PG8_STAGE(PG8_SB(0, 0), b2, voffB);
            PG8_BAR; PG8_WAIT_L(0); PG8_MMA(0, 1, At, B1); PG8_BAR;
            PG8_LDA(At, 0, 1); PG8_STAGE(PG8_SA(0, 0), a2, voffA);
            PG8_BAR; PG8_WAIT_L(0); PG8_MMA(1, 0, At, B0); PG8_BAR; PG8_SCHED;
            PG8_STAGE(PG8_SB(0, 1), b2 + hstep, voffB);
            PG8_WAIT_V(6); PG8_BAR; PG8_MMA(1, 1, At, B1); PG8_BAR;
            PG8_LDB(B0, 1, 0); PG8_SCHED; PG8_LDA(At, 1, 0); PG8_STAGE(PG8_SA(0, 1), a2 + hstep, voffA);
            PG8_WAIT_L(8); PG8_BAR; PG8_WAIT_L(0); PG8_MMA(0, 0, At, B0); PG8_BAR; PG8_SCHED;
            PG8_LDB(B1, 1, 1); PG8_STAGE(PG8_SB(1, 0), b3, voffB);
            PG8_BAR; PG8_WAIT_L(0); PG8_MMA(0, 1, At, B1); PG8_BAR;
            PG8_LDA(At, 1, 1); PG8_STAGE(PG8_SA(1, 0), a3, voffA);
            PG8_BAR; PG8_WAIT_L(0); PG8_MMA(1, 0, At, B0); PG8_BAR; PG8_SCHED;
            PG8_STAGE(PG8_SB(1, 1), b3 + hstep, voffB);
            PG8_WAIT_V(6); PG8_BAR; PG8_MMA(1, 1, At, B1); PG8_BAR;
        }
        if constexpr (!Epi::AFTER_DRAIN) { E(acc, cur, wr, wc, fr, fq); S.done(cur); }
        if (!has_next) break;
#pragma unroll
        for (int a = 0; a < 2; ++a)
#pragma unroll
            for (int b = 0; b < 2; ++b)
#pragma unroll
                for (int m = 0; m < 4; ++m)
#pragma unroll
                    for (int n = 0; n < 2; ++n) acc[a][b][m][n] = (f32x4){0.f, 0.f, 0.f, 0.f};
        cur = nxt; cA = nA; cB = nB; ++ui;
    }
    PG8_WAIT_V(0);
    if (wr == 0) PG8_BAR;
    PG8_BAR;
    if constexpr (Epi::AFTER_DRAIN) { E.fused(acc, cur, wr, wc, fr, fq, lds, wid, lane); S.done(cur); }
#undef PG8_SA
#undef PG8_SB
#undef PG8_STAGE
#undef PG8_LDA
#undef PG8_LDB
#undef PG8_MMA
#undef PG8_WAIT_V
#undef PG8_WAIT_L
#undef PG8_BAR
#undef PG8_SCHED
}
}

#define XB_TMO      128
#define XB_XCNT(j)  (256  + 64 * (j))
#define XB_XSUB(j)  (1280 + 64 * (j))
#define XB_XGEN(j)  (2304 + 64 * (j))
#define XB_TOP      3328
#define XB_TOPGEN   3392
#define XCD_BAR_WORDS 3456
#define XB_SPIN_CAP (1u << 18)
#define LAS __attribute__((address_space(3)))

__device__ __forceinline__ unsigned xb_ld(unsigned* p)              { return __hip_atomic_load(p, __ATOMIC_RELAXED, __HIP_MEMORY_SCOPE_AGENT); }
__device__ __forceinline__ unsigned xb_add(unsigned* p, unsigned v) { return __hip_atomic_fetch_add(p, v, __ATOMIC_RELAXED, __HIP_MEMORY_SCOPE_AGENT); }
__device__ __forceinline__ unsigned xb_xcc_id() { return (unsigned)__builtin_amdgcn_s_getreg((3 << 11) | 20) & 0xFu; }
#define XB_SPIN(cond, bar) do { unsigned _sp = 0; while (cond) { __builtin_amdgcn_s_sleep(1); \
    if ((++_sp & 255u) == 0u) { if (xb_ld(&(bar)[XB_TMO])) break; if (_sp > XB_SPIN_CAP) { atomicAdd(&(bar)[XB_TMO], 1u); break; } } } } while (0)

struct XcdBarrier {
    unsigned* bar; unsigned x;
    volatile LAS unsigned* st;
};

__device__ __forceinline__ XcdBarrier xcd_barrier_post(unsigned* bar, volatile LAS unsigned* st) {
    XcdBarrier b; b.bar = bar; b.x = xb_xcc_id(); b.st = st;
    if (threadIdx.x == 0) (void)xb_add(&bar[XB_XCNT(b.x)], 1u);
    return b;
}
__device__ __forceinline__ void xcd_barrier_complete(unsigned* bar, unsigned x, unsigned& nloc, unsigned& nx) {
    const unsigned G = gridDim.x * gridDim.y * gridDim.z;
    unsigned sum, cnt, mine, sp = 0u;
    for (;;) {
        sum = 0u; cnt = 0u; mine = 0u;
#pragma unroll
        for (unsigned j = 0; j < 16; ++j) { const unsigned c = xb_ld(&bar[XB_XCNT(j)]); sum += c; cnt += (c > 0u) ? 1u : 0u; mine = (j == x) ? c : mine; }
        if (sum == G) break;
        __builtin_amdgcn_s_sleep(1);
        if ((++sp & 255u) == 0u) { if (xb_ld(&bar[XB_TMO])) break; if (sp > XB_SPIN_CAP) { atomicAdd(&bar[XB_TMO], 1u); break; } }
    }
    nloc = mine > 0u ? mine : 1u; nx = cnt > 0u ? cnt : 1u;
}

__device__ __forceinline__ void xcd_barrier(const XcdBarrier& b) {
    asm volatile("s_waitcnt vmcnt(0)" ::: "memory");
    __syncthreads();
    if (threadIdx.x == 0) {
        unsigned* bar = b.bar;
        __builtin_amdgcn_s_waitcnt(0);
        unsigned nloc = b.st[0], nx = b.st[1];
        if (nloc == 0u) { xcd_barrier_complete(bar, b.x, nloc, nx); b.st[0] = nloc; b.st[1] = nx; }
        const unsigned old = xb_add(&bar[XB_XSUB(b.x)], 1u);
        const unsigned gen = old / nloc;
        if (old + 1u == (gen + 1u) * nloc) {
            __builtin_amdgcn_fence(__ATOMIC_RELEASE, "agent");
            asm volatile("s_waitcnt vmcnt(0)" ::: "memory");
            const unsigned og = xb_add(&bar[XB_TOP], 1u);
            const unsigned tg = og / nx;
            if (og + 1u == (tg + 1u) * nx) xb_add(&bar[XB_TOPGEN], 1u);
            else XB_SPIN(xb_ld(&bar[XB_TOPGEN]) == tg, bar);
            __builtin_amdgcn_fence(__ATOMIC_ACQUIRE, "agent");
            xb_add(&bar[XB_XGEN(b.x)], 1u);
            asm volatile("s_waitcnt vmcnt(0)" ::: "memory");
        } else {
            XB_SPIN(xb_ld(&bar[XB_XGEN(b.x)]) == gen, bar);
            __builtin_amdgcn_fence(__ATOMIC_ACQUIRE, "agent");
            asm volatile("s_waitcnt vmcnt(0)" ::: "memory");
        }
    }
    __syncthreads();
}

namespace {
using pg8::bf16_t; using pg8::bf16x8; using pg8::f32x4; using pg8::u32x4;
typedef unsigned u32x2 __attribute__((ext_vector_type(2)));

constexpr int DM = 1024, NTOK = 20480, NPR = 4096, DIN = 2944, DINP = 3072, DFF = 4096;
constexpr int ZR = 0, ZK = 512, ZV = 1024, ZXW = 1536, ZXA = 1664, ZXG = 1792, ZXB = 1920, ZGB = 2432;
constexpr int NTILE = NTOK / 64;
constexpr size_t MiB = 1048576;
constexpr size_t WS_W2T = 0;
constexpr size_t WS_WUPT = 8 * MiB;
constexpr size_t WS_AUPT = WS_WUPT + 131072;
constexpr size_t WS_GUPT = WS_AUPT + 131072;
constexpr size_t WS_WAT = WS_GUPT + 131072;
constexpr size_t WS_WXT = WS_WAT + 131072;
constexpr size_t WS_ROWTAB = WS_WXT + 131072;
constexpr size_t WS_COLTAB = WS_ROWTAB + 65536;
constexpr size_t WS_MODPART = 9 * MiB;
constexpr size_t WS_BAR = 12 * MiB + 512 * 1024;
constexpr size_t WS_MODF = WS_BAR + 65536;
constexpr size_t WS_F = 13 * MiB;
constexpr size_t WS_Z = WS_F;
constexpr size_t WS_YA = WS_F + 115 * MiB;
constexpr size_t WS_O1 = WS_F;
constexpr size_t WS_O1P = WS_F + 40 * MiB;
constexpr size_t WS_C = 173 * MiB;
constexpr size_t WS_WINT = WS_C;
constexpr size_t WS_WOUTT = WS_C + 6 * MiB;
constexpr size_t WS_W1T = WS_C + 8 * MiB;
constexpr size_t WS_ACT = WS_C + 16 * MiB;
constexpr size_t WS_G = WS_C + 56 * MiB;
constexpr size_t WS_INV = WS_C + 76 * MiB;
constexpr size_t WS_BON = WS_INV + 655360;
constexpr size_t WS_CAR = WS_BON + 655360;
constexpr size_t WS_O2 = WS_C;
constexpr size_t WS_O2P = WS_C + 40 * MiB;
constexpr size_t OUT_RWKV = (size_t)NTOK * DM;
constexpr size_t OUT_LRU = OUT_RWKV + 16 * 2 * 8 * 4096;

constexpr int LDS_BYTES = 154 * 1024;

struct Params {
    const float* in[33];
    float* out;
    unsigned char* ws;
};

__device__ __forceinline__ float bf2f(unsigned short b) { return __uint_as_float(((unsigned)b) << 16); }
__device__ __forceinline__ unsigned short f2bf(float f) { return __builtin_bit_cast(unsigned short, (__bf16)f); }
__device__ __forceinline__ unsigned pk2(float lo, float hi) { return pg8::cvt_pk_bf16(lo, hi); }
__device__ __forceinline__ void unpack8(const u32x4 w, float* f) {
    f[0] = __uint_as_float(w.x << 16); f[1] = __uint_as_float(w.x & 0xffff0000u);
    f[2] = __uint_as_float(w.y << 16); f[3] = __uint_as_float(w.y & 0xffff0000u);
    f[4] = __uint_as_float(w.z << 16); f[5] = __uint_as_float(w.z & 0xffff0000u);
    f[6] = __uint_as_float(w.w << 16); f[7] = __uint_as_float(w.w & 0xffff0000u);
}
__device__ __forceinline__ u32x4 pack8(const float* f) { u32x4 w; w.x = pk2(f[0], f[1]); w.y = pk2(f[2], f[3]); w.z = pk2(f[4], f[5]); w.w = pk2(f[6], f[7]); return w; }
__device__ __forceinline__ float sigmoidf_(float x) { return __builtin_amdgcn_rcpf(1.0f + __expf(-x)); }
__device__ __forceinline__ float softplusf_(float y) {
    if (y > 15.0f) return y;
    const float e = __expf(y), u = 1.0f + e;
    return (u == 1.0f) ? e : __logf(u) * (e * __builtin_amdgcn_rcpf(u - 1.0f));
}
__device__ __forceinline__ float tanhf_(float x) { const float e = __expf(2.0f * x); return 1.0f - 2.0f * __builtin_amdgcn_rcpf(e + 1.0f); }
__device__ __forceinline__ float wave_sum(float v) {
#pragma unroll
    for (int o = 32; o > 0; o >>= 1) v += __shfl_xor(v, o);
    return v;
}
__device__ __forceinline__ float sum8(float v) { v += __shfl_xor(v, 1); v += __shfl_xor(v, 2); v += __shfl_xor(v, 4); return v; }

struct TileInfo { int row0; int mrow; int b; int t0; int T; int seqrow0; int sample; int tile0; int ntile; };
__device__ __forceinline__ TileInfo tile_info(int tile) {
    TileInfo ti; ti.row0 = tile * 64;
    if (tile < 64) { ti.sample = 0; ti.b = tile >> 2; ti.t0 = (tile & 3) * 64; ti.T = 256; ti.mrow = 8; ti.seqrow0 = ti.b * 256; ti.tile0 = ti.b * 4; ti.ntile = 4; }
    else { const int s = tile - 64; ti.sample = 1; ti.b = s >> 5; ti.t0 = (s & 31) * 64; ti.T = 2048; ti.mrow = ti.b; ti.seqrow0 = NPR + ti.b * 2048; ti.tile0 = 64 + ti.b * 32; ti.ntile = 32; }
    return ti;
}
__device__ __forceinline__ f32x4 load_x4(const Params& p, int row, int j) {
    if (row < NPR) return __builtin_nontemporal_load((const f32x4*)(p.in[0] + (size_t)row * DM + j));
    const int r = row - NPR, t = r & 2047;
    f32x4 x = __builtin_nontemporal_load((const f32x4*)(p.in[1] + (size_t)r * DM + j));
    const float* tab = (j < 512) ? (const float*)(p.ws + WS_ROWTAB) + (t >> 6) * 512 + j : (const float*)(p.ws + WS_COLTAB) + (t & 63) * 512 + (j - 512);
    const f32x4 e = *(const f32x4*)tab;
    return x + e;
}
__device__ __forceinline__ float mod_val(const Params& p, int mrow, int col) {
    const float* mp = (const float*)(p.ws + WS_MODPART);
    float s = p.in[7][col];
#pragma unroll
    for (int ks = 0; ks < 16; ++ks) s += mp[(size_t)(ks * 9 + mrow) * 6144 + col];
    return s;
}

__device__ __forceinline__ f32x4 mm16(const bf16_t* A, int lda, const bf16_t* BT, int ldb, int K, int lane) {
    const int fr = lane & 15, fq = lane >> 4;
    f32x4 acc = {0.f, 0.f, 0.f, 0.f};
    for (int kk = 0; kk < K; kk += 32) {
        const bf16x8 a = *(const bf16x8*)(A + fr * lda + kk + 8 * fq);
        const bf16x8 b = *(const bf16x8*)(BT + (size_t)fr * ldb + kk + 8 * fq);
        acc = __builtin_amdgcn_mfma_f32_16x16x32_bf16(a, b, acc, 0, 0, 0);
    }
    return acc;
}

template <int ACT> struct EpiB16 {
    static constexpr bool PERM = true, AFTER_DRAIN = false;
    bf16_t* O; int ldc; int ncols;
    __device__ __forceinline__ void operator()(const f32x4 (&acc)[2][2][4][2], const pg8::Unit& u, int wr, int wc, int fr, int fq) const {
        const int row0 = u.pm * 256 + wr * 64 + fr; const int col0 = u.pn * 256 + wc * 32 + 8 * fq;
#pragma unroll
        for (int ai = 0; ai < 2; ++ai)
#pragma unroll
            for (int m = 0; m < 4; ++m) { bf16_t* rowp = O + (size_t)(row0 + ai * 128 + m * 16) * ldc + col0;
#pragma unroll
                for (int bj = 0; bj < 2; ++bj) { f32x4 v0 = acc[ai][bj][m][0], v1 = acc[ai][bj][m][1];
                    if (ACT == 1) {
#pragma unroll
                        for (int j = 0; j < 4; ++j) { const float a = fmaxf(v0[j], 0.f), b = fmaxf(v1[j], 0.f); v0[j] = a * a; v1[j] = b * b; } }
                    if (ACT == 2 && bj == 0) {
                        if (u.pn == 6) {
#pragma unroll
                            for (int j = 0; j < 4; ++j) { v0[j] = tanhf_(v0[j]); v1[j] = tanhf_(v1[j]); } }
                        if (u.pn == 7) {
#pragma unroll
                            for (int j = 0; j < 4; ++j) { v0[j] = sigmoidf_(v0[j]); v1[j] = sigmoidf_(v1[j]); } } }
                    u32x4 w; w.x = pg8::cvt_pk_bf16(v0[0], v0[1]); w.y = pg8::cvt_pk_bf16(v0[2], v0[3]); w.z = pg8::cvt_pk_bf16(v1[0], v1[1]); w.w = pg8::cvt_pk_bf16(v1[2], v1[3]);
                    if (col0 + bj * 128 < ncols) *(u32x4*)(rowp + bj * 128) = w; } }
    }
};
struct EpiSplitB16 {
    static constexpr bool PERM = true, AFTER_DRAIN = false;
    bf16_t* O; bf16_t* P;
    __device__ __forceinline__ void operator()(const f32x4 (&acc)[2][2][4][2], const pg8::Unit& u, int wr, int wc, int fr, int fq) const {
        const int row0 = u.pm * 256 + wr * 64 + fr; const int col0 = u.pn * 256 + wc * 32 + 8 * fq;
        bf16_t* base = (u.part < 0) ? O + (size_t)row0 * 1024 : P + ((size_t)u.part * 4096 + (row0 - 16384)) * 1024;
#pragma unroll
        for (int ai = 0; ai < 2; ++ai)
#pragma unroll
            for (int m = 0; m < 4; ++m) { bf16_t* rowp = base + (size_t)(ai * 128 + m * 16) * 1024 + col0;
#pragma unroll
                for (int bj = 0; bj < 2; ++bj) { const f32x4 v0 = acc[ai][bj][m][0], v1 = acc[ai][bj][m][1];
                    u32x4 w; w.x = pg8::cvt_pk_bf16(v0[0], v0[1]); w.y = pg8::cvt_pk_bf16(v0[2], v0[3]); w.z = pg8::cvt_pk_bf16(v1[0], v1[1]); w.w = pg8::cvt_pk_bf16(v1[2], v1[3]);
                    *(u32x4*)(rowp + bj * 128) = w; } }
    }
};
struct EpiF {
    static constexpr bool PERM = false, AFTER_DRAIN = false;
    float* C; int ldc;
    __device__ __forceinline__ void operator()(const f32x4 (&acc)[2][2][4][2], const pg8::Unit& u, int wr, int wc, int fr, int fq) const {
        const int row0 = u.pm * 256 + wr * 64 + fr, col0 = u.pn * 256 + wc * 32 + 4 * fq;
#pragma unroll
        for (int ai = 0; ai < 2; ++ai)
#pragma unroll
            for (int m = 0; m < 4; ++m) { float* rowp = C + (size_t)(row0 + ai * 128 + m * 16) * ldc + col0;
#pragma unroll
                for (int bj = 0; bj < 2; ++bj)
#pragma unroll
                    for (int n = 0; n < 2; ++n) *(f32x4*)(rowp + bj * 128 + n * 16) = acc[ai][bj][m][n]; }
    }
};

__device__ __forceinline__ void transpose_tile(const float* src, int N, int Nvalid, bf16_t* dst, int K, int n0, int k0, float* tile) {
    const int tid = threadIdx.x;
    {   const int r = tid >> 4, c4 = (tid & 15) * 4;
#pragma unroll
        for (int pss = 0; pss < 2; ++pss) { const int rr = r + pss * 32;
            f32x4 v = {0.f, 0.f, 0.f, 0.f};
            if (n0 < Nvalid) v = *(const f32x4*)(src + (size_t)(k0 + rr) * N + n0 + c4);
            tile[rr * 65 + c4 + 0] = v[0]; tile[rr * 65 + c4 + 1] = v[1]; tile[rr * 65 + c4 + 2] = v[2]; tile[rr * 65 + c4 + 3] = v[3]; } }
    __syncthreads();
    {   const int rr = tid >> 3, kc = (tid & 7) * 8; float f[8];
#pragma unroll
        for (int j = 0; j < 8; ++j) f[j] = tile[(kc + j) * 65 + rr];
        *(u32x4*)(dst + (size_t)(n0 + rr) * K + k0 + kc) = pack8(f); }
    __syncthreads();
}

__device__ __forceinline__ void phase0(const Params& p, unsigned char* shm) {
    float* tile = (float*)shm;
    const int tid = threadIdx.x;
    const bool defer = (gridDim.x == 256);
    constexpr int N_TR = 3072, N_MOD = 192, N_SW = 160, N_TAB = 24;
    for (int it0 = blockIdx.x; it0 < (defer ? 768 : N_TR) + N_MOD + N_SW + N_TAB; it0 += gridDim.x) {
        const int it = (defer && it0 >= 768) ? it0 + (N_TR - 768) : it0;
        if (it < N_TR) {
            if (it < 768) transpose_tile(p.in[12], DIN, DIN, (bf16_t*)(p.ws + WS_WINT), 1024, (it >> 4) * 64, (it & 15) * 64, tile);
            else if (it < 1024) { const int i = it - 768; transpose_tile(p.in[30], 1024, 1024, (bf16_t*)(p.ws + WS_WOUTT), 1024, (i >> 4) * 64, (i & 15) * 64, tile); }
            else if (it < 2048) { const int i = it - 1024; transpose_tile(p.in[31], 4096, 4096, (bf16_t*)(p.ws + WS_W1T), 1024, (i >> 4) * 64, (i & 15) * 64, tile); }
            else { const int i = it - 2048; transpose_tile(p.in[32], 1024, 1024, (bf16_t*)(p.ws + WS_W2T), 4096, (i >> 6) * 64, (i & 63) * 64, tile); }
        } else if (it < N_TR + N_MOD) {
            const int i = it - N_TR, cgp = i % 12, ks = i / 12, k0 = ks * 64;
            for (int e = tid; e < 576; e += 512) { const int b = e >> 6, kk = e & 63; const float cv = (b < 8) ? p.in[2][b * 1024 + k0 + kk] : p.in[5][k0 + kk]; tile[e] = cv * __builtin_amdgcn_rcpf(1.0f + __expf(-cv)); }
            __syncthreads();
            const int col = cgp * 512 + tid;
            float a0 = 0, a1 = 0, a2 = 0, a3 = 0, a4 = 0, a5 = 0, a6 = 0, a7 = 0, a8 = 0;
            const float* wm = p.in[6] + (size_t)k0 * 6144 + col;
#pragma unroll
            for (int hb = 0; hb < 2; ++hb) { float wv[32];
#pragma unroll
                for (int q = 0; q < 32; ++q) wv[q] = wm[(size_t)(hb * 32 + q) * 6144];
                __builtin_amdgcn_sched_barrier(0);
#pragma unroll
                for (int q = 0; q < 32; ++q) { const int kk = hb * 32 + q; const float w = wv[q];
                    a0 += tile[kk] * w; a1 += tile[64 + kk] * w; a2 += tile[128 + kk] * w; a3 += tile[192 + kk] * w; a4 += tile[256 + kk] * w;
                    a5 += tile[320 + kk] * w; a6 += tile[384 + kk] * w; a7 += tile[448 + kk] * w; a8 += tile[512 + kk] * w; } }
            float* mp = (float*)(p.ws + WS_MODPART) + (size_t)(ks * 9) * 6144 + col;
            mp[0] = a0; mp[6144] = a1; mp[2 * 6144] = a2; mp[3 * 6144] = a3; mp[4 * 6144] = a4; mp[5 * 6144] = a5; mp[6 * 6144] = a6; mp[7 * 6144] = a7; mp[8 * 6144] = a8;
            __syncthreads();
        } else if (it < N_TR + N_MOD + N_SW) {
            const int i = it - N_TR - N_MOD;
float vq[4]; bf16_t* dq[4]; int rq[4];
#pragma unroll
            for (int q = 0; q < 4; ++q) {
                const int e = i * 2048 + q * 512 + tid, which = e >> 16, r = e & 65535;
                float v; bf16_t* dst;
                if (which < 2) { const int d = r >> 15, n = (r >> 6) & 511, k = r & 63; v = p.in[which == 0 ? 14 : 16][d * 32768 + k * 512 + n]; dst = (bf16_t*)(p.ws + (which == 0 ? WS_WUPT : WS_AUPT)); }
                else if (which == 2) { const int n = r >> 7, k = r & 127; v = p.in[17][k * 512 + n]; dst = (bf16_t*)(p.ws + WS_GUPT); }
                else { const int dn = r >> 12, o = (r >> 6) & 63, c = r & 63; v = p.in[which == 3 ? 25 : 27][dn * 4096 + c * 64 + o]; dst = (bf16_t*)(p.ws + (which == 3 ? WS_WAT : WS_WXT)); }
                vq[q] = v; dq[q] = dst; rq[q] = r;
            }
#pragma unroll
            for (int q = 0; q < 4; ++q) dq[q][rq[q]] = f2bf(vq[q]);
        } else {
            const int i = it - N_TR - N_MOD - N_SW;
#pragma unroll
            for (int q = 0; q < 4; ++q) {
                const int e = i * 2048 + q * 512 + tid;
                const int isrow = e < 16384, e2 = isrow ? e : e - 16384, pos = e2 >> 9, j = e2 & 511, ii = j & 255;
                const float omega = 1.0f / powf(10000.0f, (float)ii / 256.0f);
                const float ang = (float)pos * omega;
                const float v = (j < 256) ? sinf(ang) : cosf(ang);
                ((float*)(p.ws + (isrow ? WS_ROWTAB : WS_COLTAB)))[e2] = v;
            }
        }
    }
}

__device__ __forceinline__ void deferred_transposes(const Params& p, unsigned char* shm, int which, int rank, int nranks) {
    float* tile = (float*)shm;
    if (which == 0) { for (int i = rank; i < 256; i += nranks) transpose_tile(p.in[30], 1024, 1024, (bf16_t*)(p.ws + WS_WOUTT), 1024, (i >> 4) * 64, (i & 15) * 64, tile); }
    else { for (int it = rank; it < 2048; it += nranks) {
            if (it < 1024) transpose_tile(p.in[31], 4096, 4096, (bf16_t*)(p.ws + WS_W1T), 1024, (it >> 4) * 64, (it & 15) * 64, tile);
            else { const int i = it - 1024; transpose_tile(p.in[32], 1024, 1024, (bf16_t*)(p.ws + WS_W2T), 4096, (i >> 6) * 64, (i & 63) * 64, tile); } } }
}

__device__ __forceinline__ void phase_h1(const Params& p, unsigned char* shm) {
    float* sm = (float*)shm;
    const int tid = threadIdx.x, wid = tid >> 6, lane = tid & 63;
    bf16_t* H = (bf16_t*)(p.ws + WS_ACT);
    for (int e = blockIdx.x * 512 + tid; e < 9 * 6144; e += gridDim.x * 512) ((float*)(p.ws + WS_MODF))[e] = mod_val(p, e / 6144, e % 6144);
    const int per16 = (NTOK / 16 + (int)gridDim.x - 1) / (int)gridDim.x; int cur_mrow = -1;
    auto body = [&](auto nr_tag, int row) { constexpr int NR = decltype(nr_tag)::value;
            f32x4 x[NR][4]; float ss[NR] = {};
            f32x4 g8[4];
#pragma unroll
            for (int i = 0; i < 4; ++i) g8[i] = *(const f32x4*)(p.in[8] + 4 * lane + 256 * i);
#pragma unroll
            for (int u = 0; u < NR; ++u)
#pragma unroll
                for (int i = 0; i < 4; ++i) x[u][i] = load_x4(p, row + (u >> 1) * 16 + (u & 1), 4 * lane + 256 * i);
#pragma unroll
            for (int u = 0; u < NR; ++u)
#pragma unroll
                for (int i = 0; i < 4; ++i) ss[u] += x[u][i][0] * x[u][i][0] + x[u][i][1] * x[u][i][1] + x[u][i][2] * x[u][i][2] + x[u][i][3] * x[u][i][3];
#pragma unroll
            for (int o = 32; o > 0; o >>= 1) {
#pragma unroll
                for (int u = 0; u < NR; ++u) ss[u] += __shfl_xor(ss[u], o); }
#pragma unroll
            for (int u = 0; u < NR; ++u) { const float rstd = rsqrtf(ss[u] * (1.0f / 1024.0f) + 1e-6f);
#pragma unroll
                for (int i = 0; i < 4; ++i) { const int j = 4 * lane + 256 * i;
                    const f32x4 g = g8[i]; float h[4];
#pragma unroll
                    for (int e = 0; e < 4; ++e) h[e] = x[u][i][e] * rstd * g[e] * (1.0f + sm[1024 + j + e]) + sm[j + e];
                    u32x2 w; w.x = pk2(h[0], h[1]); w.y = pk2(h[2], h[3]);
                    *(u32x2*)(H + (size_t)(row + (u >> 1) * 16 + (u & 1)) * DM + j) = w; } }
    };
    for (int k16 = 0; k16 < per16; ) {
        const int t16 = blockIdx.x * per16 + k16; if (t16 >= NTOK / 16) break;
        const int row = t16 * 16 + wid * 2, mrow = (t16 * 16 < NPR) ? 8 : ((t16 * 16 - NPR) >> 11);
        if (mrow != cur_mrow) { __syncthreads(); { float mv[4];
#pragma unroll
            for (int q = 0; q < 4; ++q) mv[q] = mod_val(p, mrow, tid + 512 * q);
#pragma unroll
            for (int q = 0; q < 4; ++q) sm[tid + 512 * q] = mv[q]; } __syncthreads(); cur_mrow = mrow; }
        const int t16b = t16 + 1; const bool pair = (k16 + 1 < per16) && (t16b < NTOK / 16) && (((t16b * 16 < NPR) ? 8 : ((t16b * 16 - NPR) >> 11)) == mrow);
        if (pair) { body(std::integral_constant<int, 4>{}, row); k16 += 2; } else { body(std::integral_constant<int, 2>{}, row); k16 += 1; }
    }
    __syncthreads();
}

constexpr int LO_O = 0;
constexpr int LO_XA = 87040;
constexpr int LO_PRM = 139264;
constexpr int LW_HALF = 26624 + 2 * 9216, LW_GB = 26624;
struct LruPre { u32x4 x[8]; u32x4 g[2]; };

template <int MODE>
__device__ __forceinline__ void lru_load_x(const Params& p, const TileInfo& ti, int j, int ht, LruPre& pre) {
    const bf16_t* Z = (const bf16_t*)(p.ws + WS_Z);
    const int t = ht >> 2, cq = ht & 3;
#pragma unroll
    for (int jj = 0; jj < 4; ++jj) { const int tt = ti.t0 + t + jj - 2; const bool ok = (tt >= 0) && (tt < ti.T);
        const bf16_t* src = Z + (size_t)(ti.seqrow0 + (ok ? tt : 0)) * DIN + ZXB + 64 * j + 16 * cq;
        const u32x4 z = {0u, 0u, 0u, 0u};
        pre.x[2 * jj] = ok ? *(const u32x4*)src : z; pre.x[2 * jj + 1] = ok ? *(const u32x4*)(src + 8) : z; }
    if (MODE == 1) { const bf16_t* src = Z + (size_t)(ti.row0 + t) * DIN + ZGB + 64 * j + 16 * cq; pre.g[0] = *(const u32x4*)src; pre.g[1] = *(const u32x4*)(src + 8); }
}

template <int MODE>
__device__ __forceinline__ void lru_wave_item(const Params& p, unsigned char* lh, const bf16_t* wt, const float* cp, const float (&pba)[2], const float (&pbx)[2], const float (&pc8)[2], int tile, int j, const TileInfo& ti, LruPre& pre, int ht, int next_tile, int par) {
    const bf16_t* Z = (const bf16_t*)(p.ws + WS_Z);
    bf16_t* xcb = (bf16_t*)lh; float* xcf = (float*)(lh + 9216); bf16_t* gbt = (bf16_t*)(lh + LW_GB + par * 9216);
    const int lane = ht & 63, nt = ht >> 6, fr = lane & 15, fq = lane >> 4, ch = 64 * j + 16 * nt + fr;
    {   const int t = ht >> 2, cq = ht & 3; float xc[16];
#pragma unroll
        for (int q = 0; q < 16; ++q) xc[q] = cp[4 * 64 + 16 * cq + q];
#pragma unroll
        for (int jj = 0; jj < 4; ++jj) { float f[16]; unpack8(pre.x[2 * jj], f); unpack8(pre.x[2 * jj + 1], f + 8); __builtin_amdgcn_sched_barrier(0);
#pragma unroll
            for (int q = 0; q < 16; ++q) xc[q] += f[q] * cp[jj * 64 + 16 * cq + q]; }
        *(u32x4*)(xcb + t * 72 + 16 * cq) = pack8(xc); *(u32x4*)(xcb + t * 72 + 16 * cq + 8) = pack8(xc + 8);
        if (MODE == 1) { *(u32x4*)(gbt + t * 72 + 16 * cq) = pre.g[0]; *(u32x4*)(gbt + t * 72 + 16 * cq + 8) = pre.g[1]; }
#pragma unroll
        for (int q = 0; q < 16; q += 4) *(f32x4*)(xcf + t * 68 + 16 * cq + q) = (f32x4){xc[q], xc[q + 1], xc[q + 2], xc[q + 3]}; }
    __builtin_amdgcn_sched_barrier(0);
    if (next_tile >= 0) { const TileInfo tn = tile_info(next_tile); lru_load_x<MODE>(p, tn, j, ht, pre); }
    __syncthreads();
    f32x4 A_[2][4], B_[2][4];
    bf16x8 bl[4][2];
#pragma unroll
    for (int o = 0; o < 4; ++o)
#pragma unroll
        for (int k2 = 0; k2 < 2; ++k2) bl[o][k2] = *(const bf16x8*)(wt + (o * 64 + 16 * nt + fr) * 72 + 32 * k2 + 8 * fq);
#pragma unroll
    for (int mt = 0; mt < 4; ++mt) {
        const bf16x8 a0 = *(const bf16x8*)(xcb + (16 * mt + fr) * 72 + 8 * fq), a1 = *(const bf16x8*)(xcb + (16 * mt + fr) * 72 + 32 + 8 * fq);
        f32x4 acc[4];
#pragma unroll
        for (int o = 0; o < 4; ++o) { acc[o] = (f32x4){0.f, 0.f, 0.f, 0.f};
            acc[o] = __builtin_amdgcn_mfma_f32_16x16x32_bf16(a0, bl[o][0], acc[o], 0, 0, 0); acc[o] = __builtin_amdgcn_mfma_f32_16x16x32_bf16(a1, bl[o][1], acc[o], 0, 0, 0); }
#pragma unroll
        for (int d = 0; d < 2; ++d)
#pragma unroll
            for (int e = 0; e < 4; ++e) {
                const float rg = sigmoidf_(acc[2 * d][e] + pba[d]), ig = sigmoidf_(acc[2 * d + 1][e] + pbx[d]);
                const float a = __expf(rg * pc8[d]);
                A_[d][mt][e] = a; B_[d][mt][e] = __builtin_amdgcn_sqrtf(fmaxf(1.0f - a * a, 0.0f)) * (ig * xcf[(16 * mt + 4 * fq + e) * 68 + 16 * nt + fr]); }
    }
    __syncthreads();
    float hin0 = 0.f, hin1 = 0.f;
    if (MODE == 1) {
        const int chain = lane & 31, dd = chain >> 4, part = lane >> 5;
        const float* car = (const float*)(p.ws + WS_CAR);
        float Pa = 1.0f, Ha = 0.0f;
#pragma unroll
        for (int hb = 0; hb < 2; ++hb) { float Pv[8], Hv[8];
#pragma unroll
            for (int i = 0; i < 8; ++i) { const int kk = part * 16 + hb * 8 + i; const int tl = dd ? (ti.tile0 + ti.ntile - 1 - kk) : (ti.tile0 + kk);
                const bool valid = (kk < ti.ntile) && (dd ? (tl > tile) : (tl < tile));
                const float* cc = car + (size_t)((tl * 8 + j) * 2 + dd) * 128 + 16 * nt + fr;
                Pv[i] = valid ? cc[0] : 1.0f; Hv[i] = valid ? cc[64] : 0.0f; }
#pragma unroll
            for (int i = 0; i < 8; ++i) { Ha = Pv[i] * Ha + Hv[i]; Pa = Pv[i] * Pa; }
            __builtin_amdgcn_sched_barrier(0); }
        const float P1 = __shfl(Pa, chain + 32), H1 = __shfl(Ha, chain + 32);
        const float P0 = __shfl(Pa, chain), H0 = __shfl(Ha, chain);
        float h0 = ti.sample ? p.in[4][ti.b * 1024 + dd * 512 + ch] : 0.f;
        h0 = P0 * h0 + H0; h0 = P1 * h0 + H1;
        hin0 = __shfl(h0, fr); hin1 = __shfl(h0, 16 + fr); }
    float hs[4][4];
#pragma unroll
    for (int d = 0; d < 2; ++d) {
        float R_P = 1.0f, R_H = 0.0f;
        float hin = d ? hin1 : hin0;
#pragma unroll
        for (int m_ = 0; m_ < 4; ++m_) { const int mt = d ? 3 - m_ : m_;
            float P = 1.0f, H = 0.0f;
#pragma unroll
            for (int e_ = 0; e_ < 4; ++e_) { const int e = d ? 3 - e_ : e_; H = A_[d][mt][e] * H + B_[d][mt][e]; P = A_[d][mt][e] * P; }
            const int sq = d ? 3 - fq : fq;
            {   const int src1 = d ? lane + 16 : lane - 16; const float Pp = __shfl(P, src1 & 63), Hp = __shfl(H, src1 & 63);
                if (sq >= 1) { H = P * Hp + H; P = P * Pp; } }
            {   const int src2 = d ? lane + 32 : lane - 32; const float Pp = __shfl(P, src2 & 63), Hp = __shfl(H, src2 & 63);
                if (sq >= 2) { H = P * Hp + H; P = P * Pp; } }
            const int lastl = d ? fr : 48 + fr; const float TP = __shfl(P, lastl), TH = __shfl(H, lastl);
            if (MODE == 1) {
                const int srcx = d ? lane + 16 : lane - 16; float EP = __shfl(P, srcx & 63), EH = __shfl(H, srcx & 63);
                if (sq == 0) { EP = 1.0f; EH = 0.0f; }
                float h = R_P * hin + R_H; h = EP * h + EH;
#pragma unroll
                for (int e_ = 0; e_ < 4; ++e_) { const int e = d ? 3 - e_ : e_; h = A_[d][mt][e] * h + B_[d][mt][e]; hs[mt][e] = (d == 0) ? h : hs[mt][e] + h; }
                if (!ti.sample) {
                    if (d == 0 && mt == 3 && fq == 3 && tile == ti.tile0 + ti.ntile - 1) p.out[OUT_LRU + ti.b * 1024 + ch] = h;
                    if (d == 1 && mt == 0 && fq == 0 && tile == ti.tile0) p.out[OUT_LRU + ti.b * 1024 + 512 + ch] = h; }
            }
            R_H = TP * R_H + TH; R_P = TP * R_P;
        }
        if (MODE == 0) { if (fq == 0) { float* car = (float*)(p.ws + WS_CAR) + (size_t)((tile * 8 + j) * 2 + d) * 128 + 16 * nt + fr; car[0] = R_P; car[64] = R_H; } }
    }
    if (MODE == 1) {
        bf16_t* Y = (bf16_t*)(p.ws + WS_ACT);
#pragma unroll
        for (int mt = 0; mt < 4; ++mt)
#pragma unroll
            for (int e = 0; e < 4; ++e) { const float x = bf2f(gbt[(16 * mt + 4 * fq + e) * 72 + 16 * nt + fr]);
                const float ge = 0.5f * x * (1.0f + tanhf_(0.7978845608028654f * (x + 0.044715f * x * x * x)));
                Y[(size_t)(ti.row0 + 16 * mt + 4 * fq + e) * DM + 512 + ch] = f2bf(hs[mt][e] * ge); }
    }
}

constexpr int LW_WT = 2 * LW_HALF, LW_CP = LW_WT + 4 * 64 * 72 * 2;
template <int MODE>
__device__ __forceinline__ void lru_phase(const Params& p, unsigned char* shm, int j, int tile0, int tstride, int ntiles_total) {
    const int tid = threadIdx.x, ht = tid & 255, half = tid >> 8, lane = tid & 63, nt = ht >> 6, fr = lane & 15;
    unsigned char* lh = shm + half * LW_HALF;
    bf16_t* wt = (bf16_t*)(shm + LW_WT); float* cp = (float*)(shm + LW_CP);
    {   u32x4 wv[4];
#pragma unroll
        for (int q = 0; q < 4; ++q) { const int e = tid + 512 * q, o = e >> 9, n = (e >> 3) & 63, k8 = e & 7;
            wv[q] = *(const u32x4*)((const bf16_t*)(p.ws + ((o & 1) ? WS_WXT : WS_WAT)) + (size_t)(((o >> 1) * 8 + j) * 64 + n) * 64 + 8 * k8); }
#pragma unroll
        for (int q = 0; q < 4; ++q) { const int e = tid + 512 * q, o = e >> 9, n = (e >> 3) & 63, k8 = e & 7; *(u32x4*)(wt + (o * 64 + n) * 72 + 8 * k8) = wv[q]; } }
    if (tid < 320) { const int idx = tid >> 6, c = tid & 63; cp[tid] = (idx < 4) ? p.in[23][idx * 512 + 64 * j + c] : p.in[24][64 * j + c]; }
    float pba[2], pbx[2], pc8[2];
    {   const int ch = 64 * j + 16 * nt + fr;
#pragma unroll
        for (int d = 0; d < 2; ++d) { pba[d] = p.in[26][d * 512 + ch]; pbx[d] = p.in[28][d * 512 + ch]; pc8[d] = -8.0f * softplusf_(-p.in[29][d * 512 + ch]); } }
    const int nmax = (ntiles_total + 1) / 2, n = (ntiles_total - half + 1) / 2;
    LruPre pre;
    if (n > 0) { const TileInfo ti = tile_info(tile0 + half * tstride); lru_load_x<MODE>(p, ti, j, ht, pre); }
    __syncthreads();
    for (int i = 0; i < nmax; ++i) {
        if (i < n) { const int tile = tile0 + (2 * i + half) * tstride; const TileInfo ti = tile_info(tile);
            lru_wave_item<MODE>(p, lh, wt, cp, pba, pbx, pc8, tile, j, ti, pre, ht, (i + 1 < n) ? tile + 2 * tstride : -1, i & 1); }
        else { __syncthreads(); __syncthreads(); } }
}

__device__ __forceinline__ void phase_prep(const Params& p, unsigned char* shm) {
    const int tid = threadIdx.x, wid = tid >> 6, lane = tid & 63;
    const bf16_t* Z = (const bf16_t*)(p.ws + WS_Z);
    float* O = (float*)(shm + LO_O);
    bf16_t* XW = (bf16_t*)(shm + LO_XA); bf16_t* XA = XW + 64 * 136; bf16_t* XG = XA + 64 * 136;
    bf16_t* SCAN = (bf16_t*)p.out;
    {
    const int h = blockIdx.x & 7, nbj = gridDim.x >> 3;
    bf16x8 bw[2][2], ba[2][2], bg[4];
    {   const int fr = lane & 15, fq = lane >> 4, nt = wid & 3;
#pragma unroll
        for (int d = 0; d < 2; ++d)
#pragma unroll
            for (int k2 = 0; k2 < 2; ++k2) { const size_t o = (size_t)(d * 512 + h * 64 + 16 * nt + fr) * 64 + 32 * k2 + 8 * fq;
                bw[d][k2] = *(const bf16x8*)((const bf16_t*)(p.ws + WS_WUPT) + o); ba[d][k2] = *(const bf16x8*)((const bf16_t*)(p.ws + WS_AUPT) + o); }
#pragma unroll
        for (int k4 = 0; k4 < 4; ++k4) bg[k4] = *(const bf16x8*)((const bf16_t*)(p.ws + WS_GUPT) + (size_t)(h * 64 + 16 * nt + fr) * 128 + 32 * k4 + 8 * fq); }
    float* PR = (float*)(shm + LO_PRM);
    if (tid < 448) { const int idx = tid >> 6, c = tid & 63, hc = h * 64 + c;
        PR[tid] = (idx < 2) ? p.in[13][idx * 512 + hc] : (idx < 4) ? p.in[15][(idx - 2) * 512 + hc] : (idx == 4) ? p.in[18][hc] : (idx == 5) ? p.in[19][hc] : p.in[20][hc]; }
    u32x4 nx[8];
    {   const int tile = blockIdx.x >> 3;
        if (tile < NTILE) { const int t = tid >> 3, seg = tid & 7; const size_t zr = (size_t)(tile * 64 + t) * DIN;
#pragma unroll
            for (int hh = 0; hh < 2; ++hh) { const int c0 = seg * 16 + hh * 8; nx[hh] = *(const u32x4*)(Z + zr + ZXW + c0); nx[2 + hh] = *(const u32x4*)(Z + zr + ZXA + c0); nx[4 + hh] = *(const u32x4*)(Z + zr + ZXG + c0); }
            nx[6] = *(const u32x4*)(Z + zr + h * 64 + 8 * seg + ZR); nx[7] = *(const u32x4*)(Z + zr + h * 64 + 8 * seg + ZK); } }
    __syncthreads();
    for (int tile = blockIdx.x >> 3; tile < NTILE; tile += nbj) {
        const TileInfo ti = tile_info(tile);
        u32x4 cx[8];
#pragma unroll
        for (int i = 0; i < 8; ++i) cx[i] = nx[i];
        if (tile + nbj < NTILE) { const int t = tid >> 3, seg = tid & 7; const size_t zr = (size_t)((tile + nbj) * 64 + t) * DIN;
#pragma unroll
            for (int hh = 0; hh < 2; ++hh) { const int c0 = seg * 16 + hh * 8; nx[hh] = *(const u32x4*)(Z + zr + ZXW + c0); nx[2 + hh] = *(const u32x4*)(Z + zr + ZXA + c0); nx[4 + hh] = *(const u32x4*)(Z + zr + ZXG + c0); }
            nx[6] = *(const u32x4*)(Z + zr + h * 64 + 8 * seg + ZR); nx[7] = *(const u32x4*)(Z + zr + h * 64 + 8 * seg + ZK); }
        {   const int t = tid >> 3, seg = tid & 7; float f[8];
#pragma unroll
            for (int hh = 0; hh < 2; ++hh) { const int c0 = seg * 16 + hh * 8;
                *(u32x4*)(XW + t * 136 + c0) = cx[hh]; *(u32x4*)(XA + t * 136 + c0) = cx[2 + hh]; *(u32x4*)(XG + t * 136 + c0) = cx[4 + hh]; } }
        __syncthreads();
        {   const int fr = lane & 15, fq = lane >> 4, nt = wid & 3, mtb = 2 * (wid >> 2);
#pragma unroll
            for (int mi = 0; mi < 2; ++mi) { const int mt = mtb + mi; const bf16_t* ar = XW + (16 * mt + fr) * 136 + 8 * fq;
#pragma unroll
                for (int d = 0; d < 2; ++d) { f32x4 aw = {0.f, 0.f, 0.f, 0.f}, aa = aw;
#pragma unroll
                    for (int k2 = 0; k2 < 2; ++k2) { aw = __builtin_amdgcn_mfma_f32_16x16x32_bf16(*(const bf16x8*)(ar + d * 64 + 32 * k2), bw[d][k2], aw, 0, 0, 0);
                        aa = __builtin_amdgcn_mfma_f32_16x16x32_bf16(*(const bf16x8*)(ar + 64 * 136 + d * 64 + 32 * k2), ba[d][k2], aa, 0, 0, 0); }
#pragma unroll
                    for (int i = 0; i < 4; ++i) { O[(d * 64 + 16 * mt + 4 * fq + i) * 68 + 16 * nt + fr] = aw[i]; O[((2 + d) * 64 + 16 * mt + 4 * fq + i) * 68 + 16 * nt + fr] = aa[i]; } }
                f32x4 ag = {0.f, 0.f, 0.f, 0.f};
#pragma unroll
                for (int k4 = 0; k4 < 4; ++k4) ag = __builtin_amdgcn_mfma_f32_16x16x32_bf16(*(const bf16x8*)(ar + 2 * 64 * 136 + 32 * k4), bg[k4], ag, 0, 0, 0);
#pragma unroll
                for (int i = 0; i < 4; ++i) O[(4 * 64 + 16 * mt + 4 * fq + i) * 68 + 16 * nt + fr] = ag[i]; } }
        __syncthreads();
        {   const int t = tid >> 3, cs = tid & 7, row = ti.row0 + t; const size_t zr = (size_t)row * DIN + h * 64 + 8 * cs;
            float ss = 0.f;
            float kaw[8], rkw[8];
            {   float k[8], kkw[8]; unpack8(cx[7], k);
                *(f32x4*)kkw = *(const f32x4*)(PR + 4 * 64 + 8 * cs); *(f32x4*)(kkw + 4) = *(const f32x4*)(PR + 4 * 64 + 8 * cs + 4);
                *(f32x4*)kaw = *(const f32x4*)(PR + 5 * 64 + 8 * cs); *(f32x4*)(kaw + 4) = *(const f32x4*)(PR + 5 * 64 + 8 * cs + 4);
                *(f32x4*)rkw = *(const f32x4*)(PR + 6 * 64 + 8 * cs); *(f32x4*)(rkw + 4) = *(const f32x4*)(PR + 6 * 64 + 8 * cs + 4);
#pragma unroll
                for (int q = 0; q < 8; ++q) { const float kk = k[q] * kkw[q]; ss += kk * kk; } }
            ss = sum8(ss);
            const float inv = __builtin_amdgcn_rcpf(fmaxf(__builtin_amdgcn_sqrtf(ss), 1e-12f));
            float bs = 0.f;
            float rf[8], kf[8]; unpack8(cx[6], rf); unpack8(cx[7], kf);
#pragma unroll 1
            for (int d = 0; d < 2; ++d) {
                bf16_t* sp = SCAN + ((size_t)(d * NTOK + row) * 8 + h) * 128 + 8 * cs;
                float oa[8], ow[8], pa[8], pw[8];
                *(f32x4*)oa = *(const f32x4*)(O + ((2 + d) * 64 + t) * 68 + 8 * cs); *(f32x4*)(oa + 4) = *(const f32x4*)(O + ((2 + d) * 64 + t) * 68 + 8 * cs + 4);
                *(f32x4*)ow = *(const f32x4*)(O + (d * 64 + t) * 68 + 8 * cs); *(f32x4*)(ow + 4) = *(const f32x4*)(O + (d * 64 + t) * 68 + 8 * cs + 4);
                *(f32x4*)pa = *(const f32x4*)(PR + (2 + d) * 64 + 8 * cs); *(f32x4*)(pa + 4) = *(const f32x4*)(PR + (2 + d) * 64 + 8 * cs + 4);
                *(f32x4*)pw = *(const f32x4*)(PR + d * 64 + 8 * cs); *(f32x4*)(pw + 4) = *(const f32x4*)(PR + d * 64 + 8 * cs + 4);
                float lw[8], aa[8];
#pragma unroll
                for (int q = 0; q < 8; ++q) { const float a = sigmoidf_(pa[q] + oa[q]);
                    bs += rf[q] * (kf[q] * (1.0f + (a - 1.0f) * kaw[q])) * rkw[q];
                    lw[q] = -0.60653065971f * sigmoidf_(pw[q] + ow[q]);
                    aa[q] = a; }
                *(u32x4*)sp = pack8(lw); *(u32x4*)(sp + 64) = pack8(aa); }
            bs = sum8(bs);
            if (cs == 0) { ((float*)(p.ws + WS_INV))[row * 8 + h] = inv; ((float*)(p.ws + WS_BON))[row * 8 + h] = bs; }
            float g[8];
            *(f32x4*)g = *(const f32x4*)(O + (4 * 64 + t) * 68 + 8 * cs); *(f32x4*)(g + 4) = *(const f32x4*)(O + (4 * 64 + t) * 68 + 8 * cs + 4);
            *(u32x4*)((bf16_t*)(p.ws + WS_G) + (size_t)row * 512 + h * 64 + 8 * cs) = pack8(g); }
    }
    __syncthreads();
    }
    {   const int G = gridDim.x, bid = blockIdx.x, nbj = G >> 3, t0 = bid >> 3;
        const int ntl = (t0 < NTILE) ? (NTILE - t0 + nbj - 1) / nbj : 0;
        lru_phase<0>(p, shm, bid & 7, t0, nbj, ntl); }
}

constexpr int CB_A = 0, CB_R = 2304, CB_BT = 4608, CB_KT = 6656, CB_VT = 8704, CB_T = 10752, CB_TK = 11264, CB_MT = 11776, CB_MK = 12288, CB_G = 12800, CB_BYTES = 13056;
constexpr int PS_B = 0, PS_K = 2304, PS_M = 4608  , PS_BYTES = 6144;
constexpr int LO_CB = 0, LO_PS = 8 * CB_BYTES;

__device__ __forceinline__ void wsync() { __builtin_amdgcn_wave_barrier(); asm volatile("s_waitcnt lgkmcnt(0)" ::: "memory"); __builtin_amdgcn_wave_barrier(); }
__device__ __forceinline__ bf16x8 mk8(unsigned a, unsigned b, unsigned c, unsigned d) { u32x4 w; w.x = a; w.y = b; w.z = c; w.w = d; return __builtin_bit_cast(bf16x8, w); }

__device__ __forceinline__ void produce_chunk(const Params& p, unsigned char* cb, unsigned char* ps, int seqrow0, int T, int d, int h, int tau0, int lane) {
    const bf16_t* Z = (const bf16_t*)(p.ws + WS_Z); const bf16_t* SCAN = (const bf16_t*)p.out; const float* INV = (const float*)(p.ws + WS_INV);
    bf16_t* At = (bf16_t*)(cb + CB_A); bf16_t* Rt = (bf16_t*)(cb + CB_R); bf16_t* Bs = (bf16_t*)(ps + PS_B); bf16_t* Ks = (bf16_t*)(ps + PS_K);
    const int k = lane, hc = h * 64 + k;
    const float kkw = p.in[18][hc], kaw = p.in[19][hc];
    float beta[16], kdv[16], cums[16]; unsigned short vraw[16], lwr[16], asr[16], rrw[16], krw[16]; float invv[16];
    float cum = 0.f, e_last = 1.0f;
#pragma unroll
    for (int i = 0; i < 16; ++i) {
        const int tau = tau0 + i, row = seqrow0 + (d ? T - 1 - tau : tau);
        const bf16_t* sp = SCAN + ((size_t)(d * NTOK + row) * 8 + h) * 128;
        const bf16_t* zr = Z + (size_t)row * DIN + h * 64 + k;
        lwr[i] = sp[k]; asr[i] = sp[64 + k]; rrw[i] = zr[ZR]; krw[i] = zr[ZK]; vraw[i] = zr[ZV]; invv[i] = INV[row * 8 + h];
    }
    __builtin_amdgcn_sched_barrier(0);
#pragma unroll
    for (int i = 0; i < 16; ++i) {
        const float lw = bf2f(lwr[i]), as = bf2f(asr[i]), r = bf2f(rrw[i]), kr = bf2f(krw[i]);
        const float kk = kr * kkw * invv[i], be = kk * as, kd = kr * (1.0f + (as - 1.0f) * kaw);
        const float e_prev = e_last; cum += lw; const float e_i = __expf(cum), e_neg = __builtin_amdgcn_rcpf(e_i); e_last = e_i;
        At[i * 72 + k] = f2bf(-kk * e_prev); Rt[i * 72 + k] = f2bf(r * e_i); Bs[i * 72 + k] = f2bf(be * e_neg); Ks[i * 72 + k] = f2bf(kd * e_neg);
        beta[i] = be * e_neg; kdv[i] = kd * e_neg; cums[i] = cum;
    }
    const float gam = e_last; ((float*)(cb + CB_G))[k] = gam;
    {   unsigned wb[8], wk[8], wv[8];
#pragma unroll
        for (int i = 0; i < 16; i += 2) {
            wb[i >> 1] = pk2(beta[i] * gam, beta[i + 1] * gam); wk[i >> 1] = pk2(kdv[i] * gam, kdv[i + 1] * gam); wv[i >> 1] = (unsigned)vraw[i] | ((unsigned)vraw[i + 1] << 16); }
        u32x4* bt = (u32x4*)(cb + CB_BT + k * 32); u32x4* kt = (u32x4*)(cb + CB_KT + k * 32); u32x4* vt = (u32x4*)(cb + CB_VT + k * 32);
        u32x4 w; w.x = wb[0]; w.y = wb[1]; w.z = wb[2]; w.w = wb[3]; bt[0] = w; w.x = wb[4]; w.y = wb[5]; w.z = wb[6]; w.w = wb[7]; bt[1] = w;
        w.x = wk[0]; w.y = wk[1]; w.z = wk[2]; w.w = wk[3]; kt[0] = w; w.x = wk[4]; w.y = wk[5]; w.z = wk[6]; w.w = wk[7]; kt[1] = w;
        w.x = wv[0]; w.y = wv[1]; w.z = wv[2]; w.w = wv[3]; vt[0] = w; w.x = wv[4]; w.y = wv[5]; w.z = wv[6]; w.w = wv[7]; vt[1] = w; }
    wsync();
    const int fr = lane & 15, fq = lane >> 4;
    {   f32x4 lab = {0.f, 0.f, 0.f, 0.f}, lak = lab, mrb = lab, mrk = lab;
#pragma unroll
        for (int m = 0; m < 2; ++m) {
            const bf16x8 aA = *(const bf16x8*)(At + fr * 72 + 32 * m + 8 * fq), aR = *(const bf16x8*)(Rt + fr * 72 + 32 * m + 8 * fq);
            const bf16x8 bB = *(const bf16x8*)(Bs + fr * 72 + 32 * m + 8 * fq), bK = *(const bf16x8*)(Ks + fr * 72 + 32 * m + 8 * fq);
            lab = __builtin_amdgcn_mfma_f32_16x16x32_bf16(aA, bB, lab, 0, 0, 0); lak = __builtin_amdgcn_mfma_f32_16x16x32_bf16(aA, bK, lak, 0, 0, 0);
            mrb = __builtin_amdgcn_mfma_f32_16x16x32_bf16(aR, bB, mrb, 0, 0, 0); mrk = __builtin_amdgcn_mfma_f32_16x16x32_bf16(aR, bK, mrk, 0, 0, 0); }
        bf16_t* oLK = (bf16_t*)(cb + CB_TK); bf16_t* oMB = (bf16_t*)(cb + CB_MT); bf16_t* oMK = (bf16_t*)(cb + CB_MK);
#pragma unroll
        for (int e = 0; e < 4; ++e) { const int i = 4 * fq + e, j = fr;
            oLK[i * 16 + j] = f2bf((j < i) ? lak[e] : 0.f); oMB[i * 16 + j] = f2bf((j <= i) ? mrb[e] : 0.f); oMK[i * 16 + j] = f2bf((j <= i) ? mrk[e] : 0.f); }
        float* Lab = (float*)(ps + PS_M);
#pragma unroll
        for (int e = 0; e < 4; ++e) Lab[(4 * fq + e) * 20 + fr] = lab[e];
        wsync();
        f32x4 Lr[16][4];
#pragma unroll
        for (int i = 1; i < 16; ++i)
#pragma unroll
            for (int j4 = 0; j4 < (i + 3) / 4; ++j4) Lr[i][j4] = *(const f32x4*)(Lab + i * 20 + 4 * j4);
        __builtin_amdgcn_sched_barrier(0);
        float Tc[16];
#pragma unroll
        for (int i = 0; i < 16; ++i) { float sacc = (i == fr) ? 1.0f : 0.0f;
#pragma unroll
            for (int j4 = 0; j4 < (i + 3) / 4; ++j4) {
#pragma unroll
                for (int e = 0; e < 4; ++e) if (4 * j4 + e < i) sacc += Lr[i][j4][e] * Tc[4 * j4 + e]; }
            Tc[i] = sacc; }
        bf16_t* oT = (bf16_t*)(cb + CB_T);
        if (fq == 0) {
#pragma unroll
            for (int i = 0; i < 16; ++i) oT[i * 16 + fr] = f2bf(Tc[i]); } }
}

__device__ __forceinline__ void consume_chunk(const unsigned char* cb, int vt, int lane, f32x4 (&S)[4], bf16_t* ybase  , int seqrow0, int T, int d, int tau0) {
    const int fr = lane & 15, fq = lane >> 4;
    const bf16_t* At = (const bf16_t*)(cb + CB_A); const bf16_t* Rt = (const bf16_t*)(cb + CB_R);
    const bf16x8 bS0 = mk8(pg8::cvt_pk_bf16(S[0][0], S[0][1]), pg8::cvt_pk_bf16(S[0][2], S[0][3]), pg8::cvt_pk_bf16(S[1][0], S[1][1]), pg8::cvt_pk_bf16(S[1][2], S[1][3]));
    const bf16x8 bS1 = mk8(pg8::cvt_pk_bf16(S[2][0], S[2][1]), pg8::cvt_pk_bf16(S[2][2], S[2][3]), pg8::cvt_pk_bf16(S[3][0], S[3][1]), pg8::cvt_pk_bf16(S[3][2], S[3][3]));
    const u32x2 a00 = *(const u32x2*)(At + fr * 72 + 4 * fq), a01 = *(const u32x2*)(At + fr * 72 + 16 + 4 * fq), a10 = *(const u32x2*)(At + fr * 72 + 32 + 4 * fq), a11 = *(const u32x2*)(At + fr * 72 + 48 + 4 * fq);
    const u32x2 r00 = *(const u32x2*)(Rt + fr * 72 + 4 * fq), r01 = *(const u32x2*)(Rt + fr * 72 + 16 + 4 * fq), r10 = *(const u32x2*)(Rt + fr * 72 + 32 + 4 * fq), r11 = *(const u32x2*)(Rt + fr * 72 + 48 + 4 * fq);
    const f32x4 zero = {0.f, 0.f, 0.f, 0.f};
    f32x4 A0 = __builtin_amdgcn_mfma_f32_16x16x32_bf16(mk8(a00.x, a00.y, a01.x, a01.y), bS0, zero, 0, 0, 0);
    A0 = __builtin_amdgcn_mfma_f32_16x16x32_bf16(mk8(a10.x, a10.y, a11.x, a11.y), bS1, A0, 0, 0, 0);
    f32x4 Y = __builtin_amdgcn_mfma_f32_16x16x32_bf16(mk8(r00.x, r00.y, r01.x, r01.y), bS0, zero, 0, 0, 0);
    Y = __builtin_amdgcn_mfma_f32_16x16x32_bf16(mk8(r10.x, r10.y, r11.x, r11.y), bS1, Y, 0, 0, 0);
    const u32x2 vf = *(const u32x2*)(cb + CB_VT + (16 * vt + fr) * 32 + 8 * fq);
    const u32x2 tt = *(const u32x2*)(cb + CB_T + fr * 32 + 8 * fq), lk = *(const u32x2*)(cb + CB_TK + fr * 32 + 8 * fq);
    const u32x2 mb = *(const u32x2*)(cb + CB_MT + fr * 32 + 8 * fq), mk = *(const u32x2*)(cb + CB_MK + fr * 32 + 8 * fq);
    const bf16x8 bAV = mk8(pg8::cvt_pk_bf16(A0[0], A0[1]), pg8::cvt_pk_bf16(A0[2], A0[3]), vf.x, vf.y);
    const f32x4 X = __builtin_amdgcn_mfma_f32_16x16x32_bf16(mk8(0u, 0u, lk.x, lk.y), bAV, A0, 0, 0, 0);
    const bf16x8 bXV = mk8(pg8::cvt_pk_bf16(X[0], X[1]), pg8::cvt_pk_bf16(X[2], X[3]), vf.x, vf.y);
    const f32x4 U = __builtin_amdgcn_mfma_f32_16x16x32_bf16(mk8(tt.x, tt.y, 0u, 0u), bXV, zero, 0, 0, 0);
    const bf16x8 bUV = mk8(pg8::cvt_pk_bf16(U[0], U[1]), pg8::cvt_pk_bf16(U[2], U[3]), vf.x, vf.y);
    Y = __builtin_amdgcn_mfma_f32_16x16x32_bf16(mk8(mb.x, mb.y, mk.x, mk.y), bUV, Y, 0, 0, 0);
#pragma unroll
    for (int kt = 0; kt < 4; ++kt) {
        const f32x4 g4 = *(const f32x4*)(cb + CB_G + (16 * kt + 4 * fq) * 4);
        const u32x2 bf = *(const u32x2*)(cb + CB_BT + (16 * kt + fr) * 32 + 8 * fq), kf = *(const u32x2*)(cb + CB_KT + (16 * kt + fr) * 32 + 8 * fq);
        S[kt] = __builtin_amdgcn_mfma_f32_16x16x32_bf16(mk8(bf.x, bf.y, kf.x, kf.y), bUV, S[kt] * g4, 0, 0, 0); }
#pragma unroll
    for (int e = 0; e < 4; ++e) { const int tau = tau0 + 4 * fq + e, row = seqrow0 + (d ? T - 1 - tau : tau); ybase[(size_t)row * 512] = f2bf(Y[e]); }
}

__device__ __forceinline__ void rwkv_scan_item(const Params& p, unsigned char* shm, int item) {
    const int tid = threadIdx.x, wid = tid >> 6, lane = tid & 63, fr = lane & 15, fq = lane >> 4;
    int sample, b, h, d;
    if (item < 128) { sample = 1; b = item >> 4; h = (item >> 1) & 7; d = item & 1; }
    else { const int ii = item - 128; sample = 0; b = ii >> 4; h = (ii >> 1) & 7; d = ii & 1; }
    const int T = sample ? 2048 : 256, seqrow0 = sample ? NPR + b * 2048 : b * 256, nsc = T / 64;
    const bool consumer = wid < 4; const int vt = wid & 3;
    f32x4 S[4];
    if (consumer) {
        if (sample) { const float* s0 = p.in[3] + ((size_t)((b * 2 + d) * 8 + h)) * 4096 + (16 * vt + fr) * 64 + 4 * fq;
#pragma unroll
            for (int kt = 0; kt < 4; ++kt) S[kt] = *(const f32x4*)(s0 + 16 * kt); }
        else {
#pragma unroll
            for (int kt = 0; kt < 4; ++kt) S[kt] = (f32x4){0.f, 0.f, 0.f, 0.f}; }
    }
    bf16_t* ybase = (bf16_t*)(p.ws + WS_YA) + (size_t)d * NTOK * 512 + h * 64 + 16 * vt + fr;
    for (int s = 0; s < nsc / 2; ++s) {
        produce_chunk(p, shm + LO_CB + wid * CB_BYTES, shm + LO_PS + wid * PS_BYTES, seqrow0, T, d, h, s * 128 + wid * 16, lane);
        __syncthreads();
        if (consumer) {
#pragma unroll 1
            for (int c = 0; c < 8; ++c) consume_chunk(shm + LO_CB + c * CB_BYTES, vt, lane, S, ybase, seqrow0, T, d, s * 128 + c * 16);
        }
        __syncthreads();
    }
    if (consumer && !sample) { float* so = p.out + OUT_RWKV + ((size_t)((b * 2 + d) * 8 + h)) * 4096 + (16 * vt + fr) * 64 + 4 * fq;
#pragma unroll
        for (int kt = 0; kt < 4; ++kt) *(f32x4*)(so + 16 * kt) = S[kt]; }
    __syncthreads();
}

__device__ __forceinline__ void phase_scan(const Params& p, unsigned char* shm) {
    const int bid = blockIdx.x, G = gridDim.x;
    if (G == 256) { if (bid < 128) rwkv_scan_item(p, shm, bid); else { rwkv_scan_item(p, shm, 128 + (bid - 128) * 2); rwkv_scan_item(p, shm, 129 + (bid - 128) * 2); } }
    else for (int item = bid; item < 384; item += G) rwkv_scan_item(p, shm, item);
    {   const int nlb = G >> 1, lb = bid - (G - nlb);
        if (lb >= 0) { const int nbj = nlb >> 3, t0 = lb >> 3; const int ntl = (t0 < NTILE) ? (NTILE - t0 + nbj - 1) / nbj : 0;
            lru_phase<1>(p, shm, lb & 7, t0, nbj, ntl); } }
}

__device__ __forceinline__ void phase_combine(const Params& p) {
    const int tid = threadIdx.x, wid = tid >> 6, lane = tid & 63, h = lane >> 3;
    const bf16_t* Z = (const bf16_t*)(p.ws + WS_Z); const bf16_t* YA = (const bf16_t*)(p.ws + WS_YA); const bf16_t* G = (const bf16_t*)(p.ws + WS_G);
    const float* BON = (const float*)(p.ws + WS_BON);
    bf16_t* Y = (bf16_t*)(p.ws + WS_ACT);
    float lg[8], lb[8];
#pragma unroll
    for (int q = 0; q < 8; ++q) { lg[q] = p.in[21][8 * lane + q]; lb[q] = p.in[22][8 * lane + q]; }
    const int per16 = (NTOK / 16 + (int)gridDim.x - 1) / (int)gridDim.x;
    for (int k16 = 0; k16 < per16; ++k16) { const int t16 = blockIdx.x * per16 + k16; if (t16 >= NTOK / 16) break;
        {
            u32x4 w0[2], w1[2], wv[2], wg[2]; float bon[2];
#pragma unroll
            for (int u = 0; u < 2; ++u) { const int row = t16 * 16 + wid * 2 + u;
                w0[u] = *(const u32x4*)(YA + (size_t)row * 512 + 8 * lane); w1[u] = *(const u32x4*)(YA + (size_t)(NTOK + row) * 512 + 8 * lane);
                wv[u] = *(const u32x4*)(Z + (size_t)row * DIN + ZV + 8 * lane); wg[u] = *(const u32x4*)(G + (size_t)row * 512 + 8 * lane); bon[u] = BON[row * 8 + h]; }
#pragma unroll
            for (int u = 0; u < 2; ++u) { const int row = t16 * 16 + wid * 2 + u;
                float a[8], b[8], vv[8], g[8], o[8]; unpack8(w0[u], a); unpack8(w1[u], b); unpack8(wv[u], vv); unpack8(wg[u], g);
                float s1 = 0.f;
#pragma unroll
                for (int q = 0; q < 8; ++q) { a[q] += b[q]; s1 += a[q]; }
                s1 = sum8(s1);
                const float mu = s1 * (1.0f / 64.0f);
                float s2 = 0.f;
#pragma unroll
                for (int q = 0; q < 8; ++q) { a[q] -= mu; s2 += a[q] * a[q]; }
                s2 = sum8(s2);
                const float rstd = rsqrtf(s2 * (1.0f / 64.0f) + 64e-5f);
#pragma unroll
                for (int q = 0; q < 8; ++q) o[q] = (a[q] * rstd * lg[q] + lb[q] + bon[u] * vv[q]) * g[q];
                *(u32x4*)(Y + (size_t)row * DM + 8 * lane) = pack8(o); }
        }
    }
}

__device__ __forceinline__ void phase_res1(const Params& p, unsigned char* shm) {
    float* sm = (float*)shm;
    const int tid = threadIdx.x, wid = tid >> 6, lane = tid & 63;
    const bf16_t* O1 = (const bf16_t*)(p.ws + WS_O1); const bf16_t* O1P = (const bf16_t*)(p.ws + WS_O1P); const bool split = false; bf16_t* H = (bf16_t*)(p.ws + WS_ACT);
    const int per16 = (NTOK / 16 + (int)gridDim.x - 1) / (int)gridDim.x; int cur_mrow = -1;
    auto body = [&](auto nr_tag, int row) { constexpr int NR = decltype(nr_tag)::value;
            f32x4 o[NR][4], x1[NR][4]; float ss[NR] = {}, s2[NR] = {};
            f32x4 g9[4], g10[4];
#pragma unroll
            for (int i = 0; i < 4; ++i) { g9[i] = *(const f32x4*)(p.in[9] + 4 * lane + 256 * i); g10[i] = *(const f32x4*)(p.in[10] + 4 * lane + 256 * i); }
#pragma unroll
            for (int u = 0; u < NR; ++u)
#pragma unroll
                for (int i = 0; i < 4; ++i) { const int r = row + (u >> 1) * 16 + (u & 1), j = 4 * lane + 256 * i;
                    if (!split || r < 16384) { const u32x2 w = *(const u32x2*)(O1 + (size_t)r * DM + j);
                        o[u][i] = (f32x4){__uint_as_float(w.x << 16), __uint_as_float(w.x & 0xffff0000u), __uint_as_float(w.y << 16), __uint_as_float(w.y & 0xffff0000u)}; }
                    else { f32x4 a = {0.f, 0.f, 0.f, 0.f};
#pragma unroll
                        for (int pp = 0; pp < 4; ++pp) { const u32x2 w = *(const u32x2*)(O1P + ((size_t)pp * 4096 + (r - 16384)) * DM + j);
                            a += (f32x4){__uint_as_float(w.x << 16), __uint_as_float(w.x & 0xffff0000u), __uint_as_float(w.y << 16), __uint_as_float(w.y & 0xffff0000u)}; }
                        o[u][i] = a; }
                    x1[u][i] = load_x4(p, r, j); }
#pragma unroll
            for (int u = 0; u < NR; ++u)
#pragma unroll
                for (int i = 0; i < 4; ++i) ss[u] += o[u][i][0] * o[u][i][0] + o[u][i][1] * o[u][i][1] + o[u][i][2] * o[u][i][2] + o[u][i][3] * o[u][i][3];
#pragma unroll
            for (int sh = 32; sh > 0; sh >>= 1) {
#pragma unroll
                for (int u = 0; u < NR; ++u) ss[u] += __shfl_xor(ss[u], sh); }
#pragma unroll
            for (int u = 0; u < NR; ++u) { const float rstd = rsqrtf(ss[u] * (1.0f / 1024.0f) + 1e-6f);
#pragma unroll
                for (int i = 0; i < 4; ++i) { const int j = 4 * lane + 256 * i; const f32x4 g = g9[i];
#pragma unroll
                    for (int e = 0; e < 4; ++e) { x1[u][i][e] += sm[j + e] * (o[u][i][e] * rstd * g[e]); s2[u] += x1[u][i][e] * x1[u][i][e]; }
                    __builtin_nontemporal_store(x1[u][i], (f32x4*)(p.out + (size_t)(row + (u >> 1) * 16 + (u & 1)) * DM + j)); } }
#pragma unroll
            for (int sh = 32; sh > 0; sh >>= 1) {
#pragma unroll
                for (int u = 0; u < NR; ++u) s2[u] += __shfl_xor(s2[u], sh); }
#pragma unroll
            for (int u = 0; u < NR; ++u) { const float rstd2 = rsqrtf(s2[u] * (1.0f / 1024.0f) + 1e-6f);
#pragma unroll
                for (int i = 0; i < 4; ++i) { const int j = 4 * lane + 256 * i; const f32x4 g = g10[i]; float h[4];
#pragma unroll
                    for (int e = 0; e < 4; ++e) h[e] = x1[u][i][e] * rstd2 * g[e] * (1.0f + sm[2048 + j + e]) + sm[1024 + j + e];
                    u32x2 w; w.x = pk2(h[0], h[1]); w.y = pk2(h[2], h[3]);
                    *(u32x2*)(H + (size_t)(row + (u >> 1) * 16 + (u & 1)) * DM + j) = w; } }
    };
    for (int k16 = 0; k16 < per16; ) {
        const int t16 = blockIdx.x * per16 + k16; if (t16 >= NTOK / 16) break;
        const int row = t16 * 16 + wid * 2, mrow = (t16 * 16 < NPR) ? 8 : ((t16 * 16 - NPR) >> 11);
        if (mrow != cur_mrow) { __syncthreads(); { float mv[6];
#pragma unroll
            for (int q = 0; q < 6; ++q) mv[q] = ((const float*)(p.ws + WS_MODF))[mrow * 6144 + 2048 + tid + 512 * q];
#pragma unroll
            for (int q = 0; q < 6; ++q) sm[tid + 512 * q] = mv[q]; } __syncthreads(); cur_mrow = mrow; }
        const int t16b = t16 + 1; const bool pair = (k16 + 1 < per16) && (t16b < NTOK / 16) && (((t16b * 16 < NPR) ? 8 : ((t16b * 16 - NPR) >> 11)) == mrow);
        if (pair) { body(std::integral_constant<int, 4>{}, row); k16 += 2; } else { body(std::integral_constant<int, 2>{}, row); k16 += 1; }
    }
    __syncthreads();
}

__device__ __forceinline__ void phase_final(const Params& p, unsigned char* shm) {
    float* sm = (float*)shm;
    const int tid = threadIdx.x, wid = tid >> 6, lane = tid & 63;
    const bf16_t* O2 = (const bf16_t*)(p.ws + WS_O2); const bf16_t* O2P = (const bf16_t*)(p.ws + WS_O2P); const bool split = (gridDim.x == 256);
    const int per16 = (NTOK / 16 + (int)gridDim.x - 1) / (int)gridDim.x; int cur_mrow = -1;
    auto body = [&](auto nr_tag, int row) { constexpr int NR = decltype(nr_tag)::value;
            f32x4 o[NR][4], x1[NR][4]; float ss[NR] = {};
            f32x4 g11[4];
#pragma unroll
            for (int i = 0; i < 4; ++i) g11[i] = *(const f32x4*)(p.in[11] + 4 * lane + 256 * i);
#pragma unroll
            for (int u = 0; u < NR; ++u)
#pragma unroll
                for (int i = 0; i < 4; ++i) { const int r = row + (u >> 1) * 16 + (u & 1), j = 4 * lane + 256 * i;
                    if (!split || r < 16384) { const u32x2 w = *(const u32x2*)(O2 + (size_t)r * DM + j);
                        o[u][i] = (f32x4){__uint_as_float(w.x << 16), __uint_as_float(w.x & 0xffff0000u), __uint_as_float(w.y << 16), __uint_as_float(w.y & 0xffff0000u)}; }
                    else { f32x4 a = {0.f, 0.f, 0.f, 0.f};
#pragma unroll
                        for (int pp = 0; pp < 4; ++pp) { const u32x2 w = *(const u32x2*)(O2P + ((size_t)pp * 4096 + (r - 16384)) * DM + j);
                            a += (f32x4){__uint_as_float(w.x << 16), __uint_as_float(w.x & 0xffff0000u), __uint_as_float(w.y << 16), __uint_as_float(w.y & 0xffff0000u)}; }
                        o[u][i] = a; }
                    x1[u][i] = *(const f32x4*)(p.out + (size_t)r * DM + j); }
#pragma unroll
            for (int u = 0; u < NR; ++u)
#pragma unroll
                for (int i = 0; i < 4; ++i) ss[u] += o[u][i][0] * o[u][i][0] + o[u][i][1] * o[u][i][1] + o[u][i][2] * o[u][i][2] + o[u][i][3] * o[u][i][3];
#pragma unroll
            for (int sh = 32; sh > 0; sh >>= 1) {
#pragma unroll
                for (int u = 0; u < NR; ++u) ss[u] += __shfl_xor(ss[u], sh); }
#pragma unroll
            for (int u = 0; u < NR; ++u) { const float rstd = rsqrtf(ss[u] * (1.0f / 1024.0f) + 1e-6f);
#pragma unroll
                for (int i = 0; i < 4; ++i) { const int j = 4 * lane + 256 * i; const f32x4 g = g11[i];
#pragma unroll
                    for (int e = 0; e < 4; ++e) x1[u][i][e] += sm[j + e] * (o[u][i][e] * rstd * g[e]);
                    __builtin_nontemporal_store(x1[u][i], (f32x4*)(p.out + (size_t)(row + (u >> 1) * 16 + (u & 1)) * DM + j)); } }
    };
    for (int k16 = 0; k16 < per16; ) {
        const int t16 = blockIdx.x * per16 + k16; if (t16 >= NTOK / 16) break;
        const int row = t16 * 16 + wid * 2, mrow = (t16 * 16 < NPR) ? 8 : ((t16 * 16 - NPR) >> 11);
        if (mrow != cur_mrow) { __syncthreads(); { float mv[2];
#pragma unroll
            for (int q = 0; q < 2; ++q) mv[q] = ((const float*)(p.ws + WS_MODF))[mrow * 6144 + 5120 + tid + 512 * q];
#pragma unroll
            for (int q = 0; q < 2; ++q) sm[tid + 512 * q] = mv[q]; } __syncthreads(); cur_mrow = mrow; }
        const int t16b = t16 + 1; const bool pair = (k16 + 1 < per16) && (t16b < NTOK / 16) && (((t16b * 16 < NPR) ? 8 : ((t16b * 16 - NPR) >> 11)) == mrow);
        if (pair) { body(std::integral_constant<int, 4>{}, row); k16 += 2; } else { body(std::integral_constant<int, 2>{}, row); k16 += 1; }
    }
    __syncthreads();
}

template <class Epi>
__device__ __forceinline__ void run_gemm(unsigned char* shm, const bf16_t* A, const bf16_t* Bt, int M, int N, int K, const Epi& E) {
    pg8::Gemm g; g.A = A; g.Bt = Bt; g.M = M; g.N = N; g.K = K;
    pg8::StaticOrder S; S.init(M, N, (int)gridDim.x, (int)blockIdx.x, K);
    pg8::gemm_phase<Epi, pg8::StaticOrder>((PG8_LAS unsigned char*)shm, g, S, E);
}

template <class Epi>
__device__ __forceinline__ void run_gemm_split(unsigned char* shm, const bf16_t* A, const bf16_t* Bt, int M, int N, int K, const Epi& E) {
    pg8::Gemm g; g.A = A; g.Bt = Bt; g.M = M; g.N = N; g.K = K;
    pg8::SplitTailOrder S; S.init((int)blockIdx.x, K);
    pg8::gemm_phase<Epi, pg8::SplitTailOrder>((PG8_LAS unsigned char*)shm, g, S, E);
}

__global__ void __launch_bounds__(512, 2) fwd_megakernel(Params p, int ph_lo, int ph_hi, int coop) {
    extern __shared__ __attribute__((aligned(16))) unsigned char shm[];
    cg::grid_group grid = cg::this_grid();
    volatile LAS unsigned* xbst = (volatile LAS unsigned*)(shm + LDS_BYTES - 16);
    if (threadIdx.x == 0) { xbst[0] = 0u; xbst[1] = 0u; }
    __syncthreads();
    XcdBarrier xb = xcd_barrier_post((unsigned*)(p.ws + WS_BAR), xbst);
    if (coop == 2) grid.sync();
#ifndef PH_MASK
#define PH_MASK 0x7ff
#endif
#define PH_ON(k) ((PH_MASK & (1 << (k))) && ph_lo <= (k) && (k) < ph_hi)
#define PH_R(k) ((PH_REP >> (k)) & 1)
#define PH_SYNC(k) do { if (coop && (k) + 1 < ph_hi && ph_lo <= (k)) { xcd_barrier(xb); } } while (0)
    if (PH_ON(0)) for (int rep = 0; rep <= PH_R(0); ++rep) phase0(p, shm);
    PH_SYNC(0);
    if (PH_ON(1)) for (int rep = 0; rep <= PH_R(1); ++rep) phase_h1(p, shm);
    PH_SYNC(1);
    if (PH_ON(2)) for (int rep = 0; rep <= PH_R(2); ++rep) { EpiB16<2> E; E.O = (bf16_t*)(p.ws + WS_Z); E.ldc = DIN; E.ncols = DIN;
        run_gemm(shm, (const bf16_t*)(p.ws + WS_ACT), (const bf16_t*)(p.ws + WS_WINT), NTOK, DINP, 1024, E);
        if (gridDim.x == 256 && blockIdx.x >= 192) deferred_transposes(p, shm, 0, (int)blockIdx.x - 192, 64); }
    PH_SYNC(2);
    if (PH_ON(3)) for (int rep = 0; rep <= PH_R(3); ++rep) phase_prep(p, shm);
    PH_SYNC(3);
    if (PH_ON(4)) for (int rep = 0; rep <= PH_R(4); ++rep) phase_scan(p, shm);
    PH_SYNC(4);
    if (PH_ON(5)) for (int rep = 0; rep <= PH_R(5); ++rep) phase_combine(p);
    PH_SYNC(5);
    if (PH_ON(6)) for (int rep = 0; rep <= PH_R(6); ++rep) { EpiSplitB16 E; E.O = (bf16_t*)(p.ws + WS_O1); E.P = (bf16_t*)(p.ws + WS_O1P);
        run_gemm(shm, (const bf16_t*)(p.ws + WS_ACT), (const bf16_t*)(p.ws + WS_WOUTT), NTOK, 1024, 1024, E);
        if (gridDim.x == 256 && blockIdx.x >= 64) deferred_transposes(p, shm, 1, (int)blockIdx.x - 64, 192); }
    PH_SYNC(6);
    if (PH_ON(7)) for (int rep = 0; rep <= PH_R(7); ++rep) phase_res1(p, shm);
    PH_SYNC(7);
    if (PH_ON(8)) for (int rep = 0; rep <= PH_R(8); ++rep) { EpiB16<1> E; E.O = (bf16_t*)(p.ws + WS_F); E.ldc = DFF; E.ncols = DFF;
        run_gemm(shm, (const bf16_t*)(p.ws + WS_ACT), (const bf16_t*)(p.ws + WS_W1T), NTOK, DFF, 1024, E); }
    PH_SYNC(8);
    if (PH_ON(9)) for (int rep = 0; rep <= PH_R(9); ++rep) { EpiSplitB16 E; E.O = (bf16_t*)(p.ws + WS_O2); E.P = (bf16_t*)(p.ws + WS_O2P);
        if (gridDim.x == 256) run_gemm_split(shm, (const bf16_t*)(p.ws + WS_F), (const bf16_t*)(p.ws + WS_W2T), NTOK, 1024, DFF, E);
        else run_gemm(shm, (const bf16_t*)(p.ws + WS_F), (const bf16_t*)(p.ws + WS_W2T), NTOK, 1024, DFF, E); }
    PH_SYNC(9);
    if (PH_ON(10)) phase_final(p, shm);
}
}

extern "C" void kernel_launch(void* const* d_in, const int* in_sizes, int n_in, void* d_out, int out_size, void* d_ws, size_t ws_size, hipStream_t stream) {
    static int grid_blocks = 0;
    if (grid_blocks == 0) {
        int dev = 0, cus = 0, per_cu = 0;
        hipGetDevice(&dev);
        hipDeviceGetAttribute(&cus, hipDeviceAttributeMultiprocessorCount, dev);
        if (hipFuncSetAttribute((const void*)fwd_megakernel, hipFuncAttributeMaxDynamicSharedMemorySize, LDS_BYTES) != hipSuccess) { fprintf(stderr, "hipFuncSetAttribute failed\n"); }
        if (hipOccupancyMaxActiveBlocksPerMultiprocessor(&per_cu, (const void*)fwd_megakernel, 512, LDS_BYTES) != hipSuccess || per_cu < 1) { fprintf(stderr, "occupancy query: %d\n", per_cu); per_cu = 1; }
        (void)hipGetLastError();
        grid_blocks = cus * per_cu;
        if (n_in != 33 || ws_size < 256 * MiB) fprintf(stderr, "unexpected n_in %d / ws_size %zu\n", n_in, ws_size);
    }
    Params p{};
    for (int i = 0; i < 33; ++i) p.in[i] = (const float*)d_in[i];
    p.out = (float*)d_out; p.ws = (unsigned char*)d_ws;
#if MK_LAUNCHES == 1
    (void)hipMemsetAsync((unsigned char*)d_ws + WS_BAR, 0, XCD_BAR_WORDS * sizeof(unsigned), stream);
    int lo = 0, hi = 11, coop = 1;
    void* args[] = {&p, &lo, &hi, &coop};
    hipError_t e = hipLaunchCooperativeKernel((const void*)fwd_megakernel, dim3(grid_blocks), dim3(512), args, LDS_BYTES, stream);
    if (e != hipSuccess) fprintf(stderr, "cooperative launch failed: %s (grid %d)\n", hipGetErrorString(e), grid_blocks);
#else
    for (int ph = 0; ph < 11; ++ph) for (int rep = 0; rep <= ((HOST_REP >> ph) & 1); ++rep) hipLaunchKernelGGL(fwd_megakernel, dim3(grid_blocks), dim3(512), LDS_BYTES, stream, p, ph, ph + 1, 0);
#endif
}
```
